# Optimizing an MI355X kernel written in HIP

```python
import jax, jax.numpy as jnp
from jax import lax
import numpy as np

D_MODEL = 2048
BATCH = 2
SEQ = 8192
DEPTH = 2

MEM_LEN = 256
N_MIXERS = 2
N_MLA_LAYERS = (DEPTH + 1) // 2
N_LRU_LAYERS = DEPTH // 2
HEAD_DIM = 128
MIX_WIDTH = D_MODEL
MEM_HEADS = 4
MEM_WIDTH = MEM_HEADS * HEAD_DIM
MIXER_WIDTH = MIX_WIDTH - MEM_WIDTH
MLA_HEADS = MIXER_WIDTH // HEAD_DIM
Q_LORA = 768
KV_LORA = 512
QK_NOPE = 128
QK_ROPE = 64
QK_DIM = QK_NOPE + QK_ROPE
V_DIM = 128
ROPE_THETA = 10000.0
LRU_WIDTH = MIXER_WIDTH
LRU_BLOCKS = 12
LRU_BLOCK_W = LRU_WIDTH // LRU_BLOCKS
LRU_C = 8.0
CONV_W = 4
D_FF = 4 * D_MODEL
Q_BLOCK = 128
EPS = 1e-6
MLA_IN = Q_LORA + KV_LORA + QK_ROPE + MEM_WIDTH
LRU_IN = 2 * LRU_WIDTH + MEM_WIDTH
NEG_INF = -1e30

kernel_name = 'hybrid_mla_rglru_memory_trunk'


def rms_norm(x, g):
    xf = x.astype(jnp.float32)
    y = xf * lax.rsqrt(jnp.mean(xf * xf, axis=-1, keepdims=True) + EPS)
    return (y * g.astype(jnp.float32)).astype(x.dtype)


def apply_rope(t, cos, sin):
    half = t.shape[-1] // 2
    t1, t2 = t[..., :half], t[..., half:]
    out = jnp.concatenate([t1 * cos - t2 * sin, t2 * cos + t1 * sin], axis=-1)
    return out.astype(t.dtype)


def causal_attention(q, k, v):
    B, S, H, Dq = q.shape
    Dv = v.shape[-1]
    nb = S // Q_BLOCK
    qb = q.reshape(B, nb, Q_BLOCK, H, Dq).transpose(1, 0, 2, 3, 4)
    key_idx = jnp.arange(S)
    scale = Dq ** -0.5

    def block(args):
        qi, bi = args
        s = jnp.einsum('bqhd,bkhd->bhqk', qi, k).astype(jnp.float32) * scale
        q_idx = bi * Q_BLOCK + jnp.arange(Q_BLOCK)
        mask = key_idx[None, :] <= q_idx[:, None]
        s = jnp.where(mask[None, None], s, NEG_INF)
        p = jax.nn.softmax(s, axis=-1).astype(v.dtype)
        return jnp.einsum('bhqk,bkhd->bqhd', p, v)

    o = lax.map(block, (qb, jnp.arange(nb)))
    return o.transpose(1, 0, 2, 3, 4).reshape(B, S, H * Dv)


def memory_attention(q, mem_k, mem_v):
    B, S = q.shape[0], q.shape[1]
    s = jnp.einsum('bshd,bmhd->bhsm', q, mem_k).astype(jnp.float32) * (HEAD_DIM ** -0.5)
    p = jax.nn.softmax(s, axis=-1).astype(mem_v.dtype)
    o = jnp.einsum('bhsm,bmhd->bshd', p, mem_v)
    return o.reshape(B, S, MEM_WIDTH)


def mla_branch(proj, cos, sin, q_lat_norm, w_q_up, kv_lat_norm, w_kv_up, q_norm, k_norm):
    B, S, _ = proj.shape
    q_lat = proj[..., :Q_LORA]
    kv_lat = proj[..., Q_LORA:Q_LORA + KV_LORA]
    k_rope = proj[..., Q_LORA + KV_LORA:]
    q = (rms_norm(q_lat, q_lat_norm) @ w_q_up).reshape(B, S, MLA_HEADS, QK_DIM)
    kv = (rms_norm(kv_lat, kv_lat_norm) @ w_kv_up).reshape(B, S, MLA_HEADS, QK_NOPE + V_DIM)
    k_nope, v = kv[..., :QK_NOPE], kv[..., QK_NOPE:]
    k_rope = jnp.broadcast_to(k_rope[:, :, None, :], (B, S, MLA_HEADS, QK_ROPE))
    k = jnp.concatenate([k_nope, k_rope], axis=-1)
    q = rms_norm(q, q_norm)
    k = rms_norm(k, k_norm)
    q = jnp.concatenate([q[..., :QK_NOPE], apply_rope(q[..., QK_NOPE:], cos, sin)], axis=-1)
    k = jnp.concatenate([k[..., :QK_NOPE], apply_rope(k[..., QK_NOPE:], cos, sin)], axis=-1)
    return causal_attention(q, k, v)


def rg_lru(xc, w_gate_a, b_gate_a, w_gate_i, b_gate_i, lru_lambda):
    B, S, C = xc.shape
    xr = xc.reshape(B, S, LRU_BLOCKS, LRU_BLOCK_W)
    r = jax.nn.sigmoid((jnp.einsum('bshi,hij->bshj', xr, w_gate_a).reshape(B, S, C) + b_gate_a).astype(jnp.float32))
    ig = jax.nn.sigmoid((jnp.einsum('bshi,hij->bshj', xr, w_gate_i).reshape(B, S, C) + b_gate_i).astype(jnp.float32))
    log_a = LRU_C * r * jax.nn.log_sigmoid(lru_lambda.astype(jnp.float32))
    a = jnp.exp(log_a)
    b = jnp.sqrt(-jnp.expm1(2.0 * log_a)) * ig * xc.astype(jnp.float32)

    def combine(left, right):
        a_l, b_l = left
        a_r, b_r = right
        return a_l * a_r, a_r * b_l + b_r

    _, h = lax.associative_scan(combine, (a, b), axis=1)
    return h.astype(xc.dtype)


def lru_branch(proj, conv_w, conv_b, w_gate_a, b_gate_a, w_gate_i, b_gate_i, lru_lambda):
    gate = jax.nn.gelu(proj[..., :LRU_WIDTH], approximate=True)
    xin = proj[..., LRU_WIDTH:]
    xc = lax.conv_general_dilated(
        xin, conv_w[:, None, :], window_strides=(1,), padding=[(CONV_W - 1, 0)],
        dimension_numbers=('NWC', 'WIO', 'NWC'), feature_group_count=LRU_WIDTH) + conv_b
    y = rg_lru(xc, w_gate_a, b_gate_a, w_gate_i, b_gate_i, lru_lambda)
    return y * gate


def setup_inputs(seed: int = 0) -> dict:
    key = jax.random.key(seed)
    k = jax.random.split(key, 27)
    f32 = jnp.float32

    def w(kk, shape, fan_in):
        return jax.random.normal(kk, shape, f32) * (fan_in ** -0.5)

    def gain(kk, shape):
        return 1.0 + 0.02 * jax.random.normal(kk, shape, f32)

    def bias(kk, shape):
        return 0.01 * jax.random.normal(kk, shape, f32)

    x = jax.random.normal(k[0], (BATCH, SEQ, D_MODEL), f32)
    mem = jax.random.normal(k[1], (BATCH, MEM_LEN, D_MODEL), f32)
    positions = jnp.arange(SEQ, dtype=jnp.int32)[None, :] + jax.random.randint(k[2], (BATCH, 1), 0, 1024, dtype=jnp.int32)
    u = jax.random.uniform(k[26], (N_LRU_LAYERS, LRU_WIDTH), f32, 0.9, 0.999)
    a0 = u ** (1.0 / LRU_C)
    lru_lambda = jnp.log(a0) - jnp.log1p(-a0)
    return {
        'x': x,
        'mem': mem,
        'positions': positions,
        'mix_norm': gain(k[3], (DEPTH, D_MODEL)),
        'mlp_norm': gain(k[4], (DEPTH, D_MODEL)),
        'w_out': w(k[5], (DEPTH, MIX_WIDTH, D_MODEL), MIX_WIDTH),
        'w_mlp_in': w(k[6], (DEPTH, D_MODEL, D_FF), D_MODEL),
        'w_mlp_out': w(k[7], (DEPTH, D_FF, D_MODEL), D_FF),
        'mem_norm': gain(k[8], (D_MODEL,)),
        'w_mem_kv': w(k[9], (D_MODEL, 2 * MEM_WIDTH), D_MODEL),
        'mem_k_norm': gain(k[10], (HEAD_DIM,)),
        'mem_q_norm': gain(k[11], (DEPTH, HEAD_DIM)),
        'w_in_mla': w(k[12], (N_MLA_LAYERS, D_MODEL, MLA_IN), D_MODEL),
        'q_lat_norm': gain(k[13], (N_MLA_LAYERS, Q_LORA)),
        'w_q_up': w(k[14], (N_MLA_LAYERS, Q_LORA, MLA_HEADS * QK_DIM), Q_LORA),
        'kv_lat_norm': gain(k[15], (N_MLA_LAYERS, KV_LORA)),
        'w_kv_up': w(k[16], (N_MLA_LAYERS, KV_LORA, MLA_HEADS * (QK_NOPE + V_DIM)), KV_LORA),
        'q_norm': gain(k[17], (N_MLA_LAYERS, QK_DIM)),
        'k_norm': gain(k[18], (N_MLA_LAYERS, QK_DIM)),
        'w_in_lru': w(k[19], (N_LRU_LAYERS, D_MODEL, LRU_IN), D_MODEL),
        'conv_w': w(k[20], (N_LRU_LAYERS, CONV_W, LRU_WIDTH), CONV_W),
        'conv_b': bias(k[21], (N_LRU_LAYERS, LRU_WIDTH)),
        'w_gate_a': w(k[22], (N_LRU_LAYERS, LRU_BLOCKS, LRU_BLOCK_W, LRU_BLOCK_W), LRU_BLOCK_W),
        'b_gate_a': bias(k[23], (N_LRU_LAYERS, LRU_WIDTH)),
        'w_gate_i': w(k[24], (N_LRU_LAYERS, LRU_BLOCKS, LRU_BLOCK_W, LRU_BLOCK_W), LRU_BLOCK_W),
        'b_gate_i': bias(k[25], (N_LRU_LAYERS, LRU_WIDTH)),
        'lru_lambda': lru_lambda,
    }


def reference(x, mem, positions, mix_norm, mlp_norm, w_out, w_mlp_in, w_mlp_out, mem_norm, w_mem_kv,
              mem_k_norm, mem_q_norm, w_in_mla, q_lat_norm, w_q_up, kv_lat_norm, w_kv_up, q_norm, k_norm,
              w_in_lru, conv_w, conv_b, w_gate_a, b_gate_a, w_gate_i, b_gate_i, lru_lambda):
    B, S, _ = x.shape
    M = mem.shape[1]
    inv_freq = ROPE_THETA ** (-jnp.arange(0, QK_ROPE, 2, dtype=jnp.float32) / QK_ROPE)
    ang = positions.astype(jnp.float32)[..., None] * inv_freq
    cos = jnp.cos(ang)[:, :, None, :]
    sin = jnp.sin(ang)[:, :, None, :]
    mkv = (rms_norm(mem, mem_norm) @ w_mem_kv).reshape(B, M, 2, MEM_HEADS, HEAD_DIM)
    mem_k = rms_norm(mkv[:, :, 0], mem_k_norm)
    mem_v = mkv[:, :, 1]

    for i in range(DEPTH):
        j = i // N_MIXERS
        h = rms_norm(x, mix_norm[i])
        if i % N_MIXERS == 0:
            proj = h @ w_in_mla[j]
            mixed = mla_branch(proj[..., :MLA_IN - MEM_WIDTH], cos, sin, q_lat_norm[j], w_q_up[j],
                               kv_lat_norm[j], w_kv_up[j], q_norm[j], k_norm[j])
        else:
            proj = h @ w_in_lru[j]
            mixed = lru_branch(proj[..., :LRU_IN - MEM_WIDTH], conv_w[j], conv_b[j], w_gate_a[j],
                               b_gate_a[j], w_gate_i[j], b_gate_i[j], lru_lambda[j])
        mq = rms_norm(proj[..., -MEM_WIDTH:].reshape(B, S, MEM_HEADS, HEAD_DIM), mem_q_norm[i])
        mem_out = memory_attention(mq, mem_k, mem_v)
        x = x + jnp.concatenate([mixed, mem_out], axis=-1) @ w_out[i]
        h = rms_norm(x, mlp_norm[i])
        x = x + jnp.square(jax.nn.relu(h @ w_mlp_in[i])) @ w_mlp_out[i]
    return x
```

```cpp
#include <hip/hip_runtime.h>
#include <hip/hip_cooperative_groups.h>
#include <cstdio>
#include <cstdint>
namespace cg = cooperative_groups;

#define LAS __attribute__((address_space(3)))
typedef unsigned short bf16_t;
typedef short bf16x8 __attribute__((ext_vector_type(8)));
typedef short s16x4 __attribute__((ext_vector_type(4)));
typedef float f32x4 __attribute__((ext_vector_type(4)));
typedef float f32x16 __attribute__((ext_vector_type(16)));
typedef unsigned u32x4 __attribute__((ext_vector_type(4)));
typedef unsigned u32x2 __attribute__((ext_vector_type(2)));

constexpr int DM = 2048, SEQ = 8192, NB = 2, T = NB * SEQ, MEML = 256;
constexpr int MLA_IN = 1856, MLA_INP = 2048, QLORA = 768, KVLORA = 512, NHEAD = 12, QKD = 192, LRU_W = 1536, LRU_IN = 3584, DFF = 8192;
constexpr int QW = NHEAD * QKD  , KVW = NHEAD * 256  ;
constexpr float EPS = 1e-6f;
constexpr int NCHUNK = 128, CHL = 64;

constexpr size_t MiB = 1u << 20;
constexpr size_t WS_CTL = 0;
constexpr size_t WS_SS = 256 * 1024;
constexpr size_t WS_WIN0 = 1 * MiB;
constexpr size_t WS_WQUP = WS_WIN0 + 8 * MiB;
constexpr size_t WS_WKVUP = WS_WQUP + 3456 * 1024;
constexpr size_t WS_WOUT = WS_WKVUP + 3 * MiB;
constexpr size_t WS_WLRU = WS_WOUT + 16 * MiB;
constexpr size_t WS_WMKV = WS_WLRU + 14 * MiB;
constexpr size_t WS_WG = WS_WMKV + 4 * MiB;
constexpr size_t WS_MEMN = WS_WG + 1 * MiB;
constexpr size_t WS_MKV = WS_MEMN + 2 * MiB;
constexpr size_t WS_MEMK = WS_MKV + 2 * MiB;
constexpr size_t WS_MEMV = WS_MEMK + 512 * 1024;
constexpr size_t WS_ROPE = WS_MEMV + 512 * 1024;
constexpr size_t WS_CARRY = WS_ROPE + 4 * MiB;
constexpr size_t WS_A0 = 64 * MiB;
constexpr size_t WS_A1 = 128 * MiB;
constexpr size_t WS_S1 = 192 * MiB;
static_assert(WS_CARRY + 3 * MiB <= WS_A0, "ws map");
constexpr size_t WS_U = 256 * MiB;
constexpr size_t WS_END = 512 * MiB;
constexpr size_t U_PROJ0 = WS_U;
constexpr size_t U_KV = WS_U + 64 * MiB;
constexpr size_t U_K = WS_U + 160 * MiB;
constexpr size_t U_GATE = WS_U;
constexpr size_t U_XIN = WS_U + 48 * MiB;
constexpr size_t U_MQ = WS_U + 96 * MiB;
constexpr size_t U_XC = WS_U + 112 * MiB;
constexpr size_t U_A = WS_U + 160 * MiB;

__device__ __forceinline__ unsigned cvt_pk_bf16(float lo, float hi) { unsigned r; asm volatile("v_cvt_pk_bf16_f32 %0, %1, %2" : "=v"(r) : "v"(lo), "v"(hi)); return r; }
__device__ __forceinline__ float bflo(unsigned u) { return __uint_as_float(u << 16); }
__device__ __forceinline__ float bfhi(unsigned u) { return __uint_as_float(u & 0xffff0000u); }
__device__ __forceinline__ float bf1(bf16_t u) { return __uint_as_float(((unsigned)u) << 16); }
__device__ __forceinline__ bf16_t f2bf(float f) { return (bf16_t)(cvt_pk_bf16(f, 0.f) & 0xffffu); }
__device__ __forceinline__ float wave_sum(float v) {
#pragma unroll
    for (int o = 1; o < 64; o <<= 1) v += __shfl_xor(v, o);
    return v;
}
__device__ __forceinline__ float half_sum(float v) {
#pragma unroll
    for (int o = 1; o < 32; o <<= 1) v += __shfl_xor(v, o);
    return v;
}
__device__ __forceinline__ int my_tid() { int t = threadIdx.x; asm volatile("" : "+v"(t)); return t; }
__device__ __forceinline__ float sigmoidf_(float x) { return __builtin_amdgcn_rcpf(1.f + __expf(-x)); }

namespace pg8 {
constexpr int BM = 256, BK = 64, HALF = 128, HTB = HALF * BK * 2, STAGE_BYTES = 8 * HTB, NXCD = 8, WGM = 8;
__host__ __device__ __forceinline__ int lds_byte(int r, int c) { const int st = (r >> 4) * 2 + (c >> 5), rr = r & 15, cc = c & 31, ob = rr * 64 + cc * 2; return st * 1024 + (ob ^ (((ob >> 9) & 1) << 5)); }
__host__ __device__ __forceinline__ void stage_rc(int b, int& R, int& C) { const int st = b / 1024, sb = b % 1024, swz = sb ^ (((sb >> 9) & 1) << 5); R = (st >> 1) * 16 + swz / 64; C = (st & 1) * 32 + (swz % 64) / 2; }
__host__ __device__ __forceinline__ int perm32(int rho) { const int n = rho >> 4, i = rho & 15; return 8 * (i >> 2) + 4 * n + (i & 3); }
struct Unit { int pm, pn; };
struct Gemm { const bf16_t* A; const bf16_t* Bt; int M, N, K, lda, ldb, acol; };
struct StaticOrder {
    int nM, nN, nwg, G, c;
    __host__ __device__ void init(int M, int N, int G_, int c_) { nM = M / BM; nN = N / BM; nwg = nM * nN; G = G_; c = c_; }
    __host__ __device__ bool next(int i, Unit& u) const {
        const long L = (long)i * G + c; if (L >= nwg) return false;
        int wgid = (int)L; { const int q = nwg / NXCD, r = nwg % NXCD, xcd = wgid % NXCD, off = wgid / NXCD; wgid = (xcd < r ? xcd * (q + 1) : r * (q + 1) + (xcd - r) * q) + off; }
        const int nig = WGM * nN, gid = wgid / nig, fm = gid * WGM, gsz = (nM - fm) < WGM ? (nM - fm) : WGM;
        u.pm = fm + ((wgid % nig) % gsz); u.pn = (wgid % nig) / gsz; return true;
    }
};
template <class Epi, bool ALIGN_EPI>
__device__ __forceinline__ void gemm_phase(LAS unsigned char* lds, const Gemm g, const StaticOrder& S, const Epi& E) {
    const int tid = my_tid(), wid = __builtin_amdgcn_readfirstlane(tid >> 6), lane = tid & 63, wr = wid >> 2, wc = wid & 3, fr = lane & 15, fq = lane >> 4;
    const int nt = g.K / BK;
    unsigned voffA[2], voffB[2];
#pragma unroll
    for (int i = 0; i < 2; ++i) { int R, C; stage_rc(tid * 16 + i * 8192, R, C); const int Rb = Epi::PERM ? ((R & ~31) + perm32(R & 31)) : R;
        voffA[i] = (unsigned)(R * g.lda + C) * 2u; voffB[i] = (unsigned)(Rb * g.ldb + C) * 2u; }
    const size_t kstep = (size_t)(BK * 2);
    const size_t hA = (size_t)HALF * g.lda * 2, hB = (size_t)HALF * g.ldb * 2;
    const size_t tA = 2 * hA, tB = 2 * hB;
    const unsigned ldsw = (unsigned)wid * 1024u;
    const int aoff = lds_byte(wr * 64 + fr, fq * 8), boff = lds_byte(wc * 32 + fr, fq * 8);
#define PG8_SA(b, h) (((b) * 2 + (h)) * HTB)
#define PG8_SB(b, h) ((4 + (b) * 2 + (h)) * HTB)
#define PG8_STAGE(bufoff, gbase, voff) do { _Pragma("unroll") for (int _i = 0; _i < 2; ++_i) \
        __builtin_amdgcn_global_load_lds((const unsigned*)((const char*)(gbase) + (voff)[_i]), (LAS unsigned*)(lds + (bufoff) + ldsw + _i * 8192), 16, 0, 0); } while (0)
#define PG8_LDA(dst, b, h) do { _Pragma("unroll") for (int m = 0; m < 4; ++m) _Pragma("unroll") for (int k = 0; k < 2; ++k) dst[m][k] = *(const LAS bf16x8*)(lds + PG8_SA(b, h) + aoff + m * 2048 + k * 1024); } while (0)
#define PG8_LDB(dst, b, h) do { _Pragma("unroll") for (int n = 0; n < 2; ++n) _Pragma("unroll") for (int k = 0; k < 2; ++k) dst[n][k] = *(const LAS bf16x8*)(lds + PG8_SB(b, h) + boff + n * 2048 + k * 1024); } while (0)
#define PG8_MMA(ai, bj, At, Bt) do { __builtin_amdgcn_s_setprio(1); _Pragma("unroll") for (int m = 0; m < 4; ++m) _Pragma("unroll") for (int n = 0; n < 2; ++n) _Pragma("unroll") for (int k = 0; k < 2; ++k) \
        acc[ai][bj][m][n] = __builtin_amdgcn_mfma_f32_16x16x32_bf16(Bt[n][k], At[m][k], acc[ai][bj][m][n], 0, 0, 0); __builtin_amdgcn_s_setprio(0); } while (0)
#define PG8_WAIT_V(n) asm volatile("s_waitcnt vmcnt(" #n ")" ::: "memory")
#define PG8_WAIT_L(n) asm volatile("s_waitcnt lgkmcnt(" #n ")" ::: "memory")
#define PG8_BAR __builtin_amdgcn_s_barrier()
#define PG8_SCHED __builtin_amdgcn_sched_barrier(0)
    Unit cur, nxt; int ui = 0;
    if (!S.next(0, cur)) return;
    float rsv[8], rsn[8];
    E.pre(cur, wr, fr, rsv); E.post(0, rsv);
    f32x4 acc[2][2][4][2];
#pragma unroll
    for (int a = 0; a < 2; ++a)
#pragma unroll
        for (int b = 0; b < 2; ++b)
#pragma unroll
            for (int m = 0; m < 4; ++m)
#pragma unroll
                for (int n = 0; n < 2; ++n) acc[a][b][m][n] = (f32x4){0.f, 0.f, 0.f, 0.f};
    bf16x8 At[4][2], B0[2][2], B1[2][2];
    const char* cA = (const char*)g.A + (size_t)cur.pm * tA + (size_t)cur.pn * g.acol; const char* cB = (const char*)g.Bt + (size_t)cur.pn * tB;
    PG8_STAGE(PG8_SB(0, 0), cB, voffB); PG8_STAGE(PG8_SB(0, 1), cB + hB, voffB); PG8_STAGE(PG8_SA(0, 0), cA, voffA); PG8_STAGE(PG8_SA(0, 1), cA + hA, voffA);
    if (wr == 1) PG8_BAR;
    PG8_WAIT_V(2); PG8_BAR;
    PG8_STAGE(PG8_SB(1, 0), cB + kstep, voffB); PG8_STAGE(PG8_SA(1, 0), cA + kstep, voffA); PG8_STAGE(PG8_SB(1, 1), cB + hB + kstep, voffB);
    PG8_WAIT_V(6); PG8_BAR;
    for (;;) {
        const bool has_next = S.next(ui + 1, nxt);
        const char* nA = has_next ? (const char*)g.A + (size_t)nxt.pm * tA + (size_t)nxt.pn * g.acol : cA; const char* nB = has_next ? (const char*)g.Bt + (size_t)nxt.pn * tB : cB;
        for (int t = 0; t < nt; t += 2) {
            const bool last = (t == nt - 2);
            const char* a1 = cA + (size_t)(t + 1) * kstep;
            const char* a2 = last ? nA : cA + (size_t)(t + 2) * kstep; const char* b2 = last ? nB : cB + (size_t)(t + 2) * kstep;
            const char* a3 = a2 + kstep; const char* b3 = b2 + kstep;
            PG8_LDB(B0, 0, 0); PG8_LDB(B1, 0, 1); PG8_SCHED; PG8_LDA(At, 0, 0); PG8_STAGE(PG8_SA(1, 1), a1 + hA, voffA);
            PG8_WAIT_V(8); PG8_WAIT_L(0); PG8_BAR; PG8_MMA(0, 0, At, B0); PG8_MMA(0, 1, At, B1); PG8_BAR; PG8_SCHED;
            PG8_LDA(At, 0, 1); PG8_STAGE(PG8_SB(0, 0), b2, voffB); PG8_STAGE(PG8_SB(0, 1), b2 + hB, voffB); PG8_STAGE(PG8_SA(0, 0), a2, voffA);
            PG8_WAIT_V(8); PG8_WAIT_L(0); PG8_BAR; PG8_MMA(1, 0, At, B0); PG8_MMA(1, 1, At, B1); PG8_BAR; PG8_SCHED;
            PG8_LDB(B0, 1, 0); PG8_LDB(B1, 1, 1); PG8_SCHED; PG8_LDA(At, 1, 0); PG8_STAGE(PG8_SA(0, 1), a2 + hA, voffA);
            PG8_WAIT_V(8); PG8_WAIT_L(0); PG8_BAR; PG8_MMA(0, 0, At, B0); PG8_MMA(0, 1, At, B1); PG8_BAR; PG8_SCHED;
            PG8_LDA(At, 1, 1); PG8_STAGE(PG8_SB(1, 0), b3, voffB); PG8_STAGE(PG8_SB(1, 1), b3 + hB, voffB); PG8_STAGE(PG8_SA(1, 0), a3, voffA);
            PG8_WAIT_V(8); PG8_WAIT_L(0); PG8_BAR; PG8_MMA(1, 0, At, B0); PG8_MMA(1, 1, At, B1); PG8_BAR; PG8_SCHED;
        }
        if constexpr (ALIGN_EPI) { if (wr == 0) PG8_BAR; }
        if (has_next) E.pre(nxt, wr, fr, rsn);
        E(acc, cur, wr, wc, fr, fq, ui, rsv);
        if (!has_next) break;
        E.post(ui + 1, rsn);
#pragma unroll
        for (int a = 0; a < 2; ++a)
#pragma unroll
            for (int b = 0; b < 2; ++b)
#pragma unroll
                for (int m = 0; m < 4; ++m)
#pragma unroll
                    for (int n = 0; n < 2; ++n) acc[a][b][m][n] = (f32x4){0.f, 0.f, 0.f, 0.f};
        cur = nxt; cA = nA; cB = nB; ++ui;
#pragma unroll
        for (int i_ = 0; i_ < 8; ++i_) rsv[i_] = rsn[i_];
        if constexpr (ALIGN_EPI) { if (wr == 1) PG8_BAR; }
    }
    PG8_WAIT_V(0);
    if constexpr (!ALIGN_EPI) { if (wr == 0) PG8_BAR; }
    PG8_BAR;
#undef PG8_SA
#undef PG8_SB
#undef PG8_STAGE
#undef PG8_LDA
#undef PG8_LDB
#undef PG8_MMA
#undef PG8_WAIT_V
#undef PG8_WAIT_L
#undef PG8_BAR
#undef PG8_SCHED
}

template <int ACT> struct EpiBf16 {
    static constexpr bool PERM = true;
    bf16_t* O0; bf16_t* O1; bf16_t* O2; int ld0, ld1, ld2, pn1, pn2; const float* ss;
    __device__ __forceinline__ void pre(const Unit& u, int wr, int fr, float (&rsv)[8]) const {
        const int row0 = u.pm * BM + wr * 64 + fr;
#pragma unroll
        for (int i = 0; i < 8; ++i) rsv[i] = ss ? ss[row0 + (i >> 2) * HALF + (i & 3) * 16] : 0.f;
    }
    __device__ __forceinline__ void post(int, const float (&)[8]) const {}
    __device__ __forceinline__ void operator()(const f32x4 (&acc)[2][2][4][2], const Unit& u, int wr, int wc, int fr, int fq, int, const float (&rsv_)[8]) const {
        bf16_t* base; int ldc, pnl; bool act2 = false;
        if (u.pn < pn1) { base = O0; ldc = ld0; pnl = u.pn; act2 = true; } else if (u.pn < pn2) { base = O1; ldc = ld1; pnl = u.pn - pn1; } else { base = O2; ldc = ld2; pnl = u.pn - pn2; }
        const int row0 = u.pm * BM + wr * 64 + fr; const int col0 = pnl * BM + wc * 32 + 8 * fq;
        float rsv[2][4];
#pragma unroll
        for (int ai = 0; ai < 2; ++ai)
#pragma unroll
            for (int m = 0; m < 4; ++m) rsv[ai][m] = ss ? rsqrtf(rsv_[ai * 4 + m] * (1.f / 2048.f) + EPS) : 1.f;
#pragma unroll
        for (int ai = 0; ai < 2; ++ai)
#pragma unroll
            for (int m = 0; m < 4; ++m) { bf16_t* rowp = base + (size_t)(row0 + ai * HALF + m * 16) * ldc + col0;
                const float rs = rsv[ai][m];
#pragma unroll
                for (int bj = 0; bj < 2; ++bj) { f32x4 v0 = acc[ai][bj][m][0] * rs, v1 = acc[ai][bj][m][1] * rs;
                    if (ACT == 1) {
#pragma unroll
                        for (int j = 0; j < 4; ++j) { const float a = fmaxf(v0[j], 0.f), b = fmaxf(v1[j], 0.f); v0[j] = a * a; v1[j] = b * b; } }
                    if (ACT == 2) { if (act2) {
#pragma unroll
                        for (int j = 0; j < 4; ++j) { float x = v0[j]; float z = 0.7978845608028654f * (x + 0.044715f * x * x * x); v0[j] = x / (1.f + __expf(-2.f * z));
                                                      x = v1[j]; z = 0.7978845608028654f * (x + 0.044715f * x * x * x); v1[j] = x / (1.f + __expf(-2.f * z)); } } }
                    u32x4 w; w.x = cvt_pk_bf16(v0[0], v0[1]); w.y = cvt_pk_bf16(v0[2], v0[3]); w.z = cvt_pk_bf16(v1[0], v1[1]); w.w = cvt_pk_bf16(v1[2], v1[3]);
                    { u32x4* dp_ = (u32x4*)(rowp + bj * HALF); asm volatile("global_store_dwordx4 %0, %1, off sc1\n\ts_nop 1" :: "v"(dp_), "v"(w) : "memory"); } } }
    }
};
struct EpiRes {
    static constexpr bool PERM = true;
    const float* basef; const bf16_t* baseb; float* outf; bf16_t* outb; float* ss; int ldc;
    __device__ __forceinline__ void pre(const Unit&, int, int, float (&)[8]) const {}
    __device__ __forceinline__ void post(int, const float (&)[8]) const {}
    __device__ __forceinline__ void operator()(const f32x4 (&acc)[2][2][4][2], const Unit& u, int wr, int wc, int fr, int fq, int, const float (&)[8]) const {
        const int col0 = u.pn * BM + wc * 32 + 8 * fq; const int row0 = u.pm * BM + wr * 64 + fr;
        float part[2][4];
        f32x4 c0[2], c1[2], n0[2], n1[2];
#define ER_LOAD(d0_, d1_, aim_) do { _Pragma("unroll") for (int bj = 0; bj < 2; ++bj) { const size_t off_ = (size_t)(row0 + ((aim_) >> 2) * HALF + ((aim_) & 3) * 16) * ldc + col0 + bj * HALF; \
            if (basef) { d0_[bj] = *(const f32x4*)(basef + off_); d1_[bj] = *(const f32x4*)(basef + off_ + 4); } \
            else if (baseb) { const u32x4 bw = *(const u32x4*)(baseb + off_); d0_[bj] = (f32x4){bflo(bw.x), bfhi(bw.x), bflo(bw.y), bfhi(bw.y)}; d1_[bj] = (f32x4){bflo(bw.z), bfhi(bw.z), bflo(bw.w), bfhi(bw.w)}; } \
            else { d0_[bj] = (f32x4){0.f, 0.f, 0.f, 0.f}; d1_[bj] = (f32x4){0.f, 0.f, 0.f, 0.f}; } } } while (0)
        ER_LOAD(c0, c1, 0);
#pragma unroll
        for (int aim = 0; aim < 8; ++aim) { const int ai = aim >> 2, m = aim & 3;
            if (aim < 7) ER_LOAD(n0, n1, aim + 1);
            asm volatile("" ::: "memory");
            float pp = 0.f;
#pragma unroll
            for (int bj = 0; bj < 2; ++bj) { const size_t off = (size_t)(row0 + ai * HALF + m * 16) * ldc + col0 + bj * HALF;
                const f32x4 v0 = acc[ai][bj][m][0] + c0[bj], v1 = acc[ai][bj][m][1] + c1[bj];
                if (outf) { *(f32x4*)(outf + off) = v0; *(f32x4*)(outf + off + 4) = v1; }
                if (outb) { u32x4 w; w.x = cvt_pk_bf16(v0[0], v0[1]); w.y = cvt_pk_bf16(v0[2], v0[3]); w.z = cvt_pk_bf16(v1[0], v1[1]); w.w = cvt_pk_bf16(v1[2], v1[3]); *(u32x4*)(outb + off) = w; }
                pp += (v0[0] * v0[0] + v0[1] * v0[1]) + (v0[2] * v0[2] + v0[3] * v0[3]) + (v1[0] * v1[0] + v1[1] * v1[1]) + (v1[2] * v1[2] + v1[3] * v1[3]); }
            part[ai][m] = pp;
            asm volatile("" ::: "memory");
#pragma unroll
            for (int bj = 0; bj < 2; ++bj) { c0[bj] = n0[bj]; c1[bj] = n1[bj]; } }
#undef ER_LOAD
        if (ss) {
#pragma unroll
            for (int ai = 0; ai < 2; ++ai)
#pragma unroll
                for (int m = 0; m < 4; ++m) { float pp = part[ai][m]; pp += __shfl_xor(pp, 16); pp += __shfl_xor(pp, 32); if (fq == 0) unsafeAtomicAdd(ss + row0 + ai * HALF + m * 16, pp); } }
    }
};
struct EpiGates {
    static constexpr bool PERM = false;
    const float* ba; const float* bi; const float* cl; bf16_t* Aout; bf16_t* Bout; LAS float* cbuf;
    __device__ __forceinline__ void pre(const Unit& u, int, int, float (&r)[8]) const { const int t = my_tid();
        unsigned long long p0 = (unsigned long long)cl, p1 = (unsigned long long)ba, p2 = (unsigned long long)bi;
        asm volatile("" : "+s"(p0), "+s"(p1), "+s"(p2));
        const unsigned long long ps = t < 128 ? p0 : (t < 256 ? p1 : p2); const float v = ((const float*)ps)[u.pn * 128 + (t & 127)];
#pragma unroll
        for (int i = 0; i < 8; ++i) r[i] = v; }
    __device__ __forceinline__ void post(int ui, const float (&r)[8]) const { const int t = my_tid(); if (t < 384) cbuf[(ui & 1) * 384 + t] = r[0]; }
    __device__ __forceinline__ void operator()(const f32x4 (&acc)[2][2][4][2], const Unit& u, int wr, int wc, int fr, int fq, int ui, const float (&)[8]) const {
        const int cc = wc * 32 + 4 * fq; const int ch0 = u.pn * 128 + cc; const int row0 = u.pm * BM + wr * 64 + fr; const LAS float* cb = cbuf + (ui & 1) * 384 + cc;
#pragma unroll
        for (int ai = 0; ai < 2; ++ai)
#pragma unroll
            for (int m = 0; m < 4; ++m) { const size_t off = (size_t)(row0 + ai * HALF + m * 16) * LRU_W + ch0;
#pragma unroll
                for (int n = 0; n < 2; ++n) { const f32x4 vcl = *(const LAS f32x4*)(cb + n * 16), vba = *(const LAS f32x4*)(cb + 128 + n * 16), vbi = *(const LAS f32x4*)(cb + 256 + n * 16);
                    const f32x4 va = acc[ai][0][m][n] + vba, vi = acc[ai][1][m][n] + vbi;
                    float a4[4]; float b4[4];
#pragma unroll
                    for (int j = 0; j < 4; ++j) { const float r = sigmoidf_(va[j]), ig = sigmoidf_(vi[j]); const float la = vcl[j] * r; a4[j] = 1.f - __expf(la); b4[j] = __builtin_amdgcn_sqrtf(a4[j] * (2.f - a4[j])) * ig; }
                    { u32x2 aw; aw.x = cvt_pk_bf16(a4[0], a4[1]); aw.y = cvt_pk_bf16(a4[2], a4[3]); *(u32x2*)(Aout + off + n * 16) = aw; }
                    u32x2 bw; bw.x = cvt_pk_bf16(b4[0], b4[1]); bw.y = cvt_pk_bf16(b4[2], b4[3]); *(u32x2*)(Bout + off + n * 16) = bw;
                    __builtin_amdgcn_sched_barrier(0); } }
    }
};
}

namespace att {
constexpr int NW = 8, QBLK = 32, KVBLK = 64, QB = 256;
constexpr int SHM_V = 16384, SHM_KN = 16384, SHM_KR = 8192, SHM_K = SHM_KN + SHM_KR;
constexpr int OFF_K = 3 * SHM_V, OFF_WS = OFF_K + 2 * SHM_K, OFF_QR = OFF_WS + NW * 64 * 4, LDS_BYTES = OFF_QR + NW * 4096;
constexpr float THR = 8.f;
#define KSWZF(row) ((((row) & 3) << 2) | (((row) >> 2) & 3))
#define KSWZ(row, colB) ((row) * 256 + ((colB) ^ (KSWZF(row) << 4)))
#define KRSWZ(row, colB) (SHM_KN + (row) * 128 + ((colB) ^ ((((row) >> 1) & 7) << 4)))
#define SBAR() __builtin_amdgcn_sched_barrier(0)
__device__ __forceinline__ int v_st(int k, int c) { const int kk = (k & ~0xC) | ((k & 4) << 1) | ((k & 8) >> 1); return ((kk >> 3) * 4 + (c >> 5)) * 512 + ((kk & 7) * 32 + (c & 31)) * 2; }
__device__ __forceinline__ int v_rd_base(int lane) { return ((lane & 3) << 3) | (((lane >> 2) & 3) << 6) | (((lane >> 4) & 1) << 5) | (((lane >> 5) & 1) << 8); }
constexpr int v_rd_off(int d0, int ks, int half) { return d0 * 512 + ks * 4096 + half * 2048; }
__device__ __forceinline__ int crow(int r, int hi) { return (r & 3) + 8 * (r >> 2) + 4 * hi; }
__device__ __forceinline__ void mask_tile(f32x16& p0, f32x16& p1, int dq) {
    const float NEG = -__builtin_inff();
#pragma unroll
    for (int r = 0; r < 16; ++r) { const int c = (r & 3) + 8 * (r >> 2); if (dq - c < 0) p0[r] = NEG; if (dq - c - 32 < 0) p1[r] = NEG; }
}
__device__ __forceinline__ void partialSM(f32x16& p0, f32x16& p1, float& m_reg, float& mn, float& alpha, float SCALE, float C2) {
    float pmax = p0[0];
#pragma unroll
    for (int r = 1; r < 16; ++r) pmax = fmaxf(pmax, p0[r]);
#pragma unroll
    for (int r = 0; r < 16; ++r) pmax = fmaxf(pmax, p1[r]);
    { auto rr = __builtin_amdgcn_permlane32_swap(__float_as_uint(pmax), __float_as_uint(pmax), false, false); pmax = fmaxf(__uint_as_float(rr[0]), __uint_as_float(rr[1])); }
    if (__builtin_expect(__all((pmax - m_reg) * SCALE <= THR), 1)) { mn = m_reg; alpha = 1.f; }
    else { mn = fmaxf(m_reg, pmax); alpha = __builtin_amdgcn_exp2f((m_reg - mn) * C2); m_reg = mn; }
    const float mnL = -mn * C2;
#pragma unroll
    for (int r = 0; r < 16; ++r) p0[r] = fmaf(p0[r], C2, mnL);
#pragma unroll
    for (int r = 0; r < 16; ++r) p1[r] = fmaf(p1[r], C2, mnL);
#pragma unroll
    for (int r = 0; r < 16; ++r) p0[r] = __builtin_amdgcn_exp2f(p0[r]);
}
__device__ __forceinline__ void finishSM(f32x16& p0, f32x16& p1, float alpha, float& l_reg, bf16x8& pa0, bf16x8& pa1, bf16x8& pa2, bf16x8& pa3) {
#pragma unroll
    for (int r = 0; r < 16; ++r) p1[r] = __builtin_amdgcn_exp2f(p1[r]);
    float ps = 0;
#pragma unroll
    for (int r = 0; r < 16; ++r) ps += p0[r];
#pragma unroll
    for (int r = 0; r < 16; ++r) ps += p1[r];
    { auto rr = __builtin_amdgcn_permlane32_swap(__float_as_uint(ps), __float_as_uint(ps), false, false); ps = __uint_as_float(rr[0]) + __uint_as_float(rr[1]); }
    l_reg = l_reg * alpha + ps;
#define PK4(P, B_, OUT) do { unsigned a0 = cvt_pk_bf16(P[B_+0], P[B_+1]), a1 = cvt_pk_bf16(P[B_+2], P[B_+3]);                          \
        unsigned b0 = cvt_pk_bf16(P[B_+4], P[B_+5]), b1 = cvt_pk_bf16(P[B_+6], P[B_+7]);                                             \
        auto r0 = __builtin_amdgcn_permlane32_swap(a0, b0, false, false); auto r1 = __builtin_amdgcn_permlane32_swap(a1, b1, false, false); \
        u32x4 w = {r0[0], r1[0], r0[1], r1[1]}; OUT = __builtin_bit_cast(bf16x8, w); } while (0)
    PK4(p0, 0, pa0); PK4(p0, 8, pa1); PK4(p1, 0, pa2); PK4(p1, 8, pa3);
#undef PK4
}
template <int DQ>
__device__ __forceinline__ void qkt(f32x16& p0, f32x16& p1, const LAS char* Kt, int r32, int hi, const bf16x8* qr, const LAS char* qrl) {
    constexpr int ND = DQ / 16, PF = 6;
    p0 = f32x16{}; p1 = f32x16{};
    const LAS char* kb[4]; const LAS char* kr[4];
#pragma unroll
    for (int dd = 0; dd < 4; ++dd) { kb[dd] = Kt + KSWZ(r32, (dd * 16 + hi * 8) * 2); kr[dd] = Kt + KRSWZ(r32, (dd * 16 + hi * 8) * 2); }
    const int koff = (r32 & 2) ? -128 : 128;
#define RDK(d, half) (*reinterpret_cast<const LAS bf16x8*>((d) < 8 ? kb[(d) & 3] + ((d) >> 2) * koff + (half) * 32 * 256 : kr[((d) - 8) & 3] + (half) * 32 * 128))
    bf16x8 k0[PF], k1[PF], qf[4];
    if constexpr (DQ == 192) {
#pragma unroll
        for (int dd = 0; dd < 4; ++dd) qf[dd] = *reinterpret_cast<const LAS bf16x8*>(qrl + dd * 1024);
    }
#pragma unroll
    for (int d = 0; d < PF; ++d) { k0[d] = RDK(d, 0); k1[d] = RDK(d, 1); }
    SBAR();
#pragma unroll
    for (int d = 0; d < ND; ++d) { const bf16x8 q = d < 8 ? qr[d & 7] : qf[(d - 8) & 3];
        p0 = __builtin_amdgcn_mfma_f32_32x32x16_bf16(k0[d % PF], q, p0, 0, 0, 0);
        p1 = __builtin_amdgcn_mfma_f32_32x32x16_bf16(k1[d % PF], q, p1, 0, 0, 0);
        if (d + PF < ND) { k0[d % PF] = RDK(d + PF, 0); k1[d % PF] = RDK(d + PF, 1); }
        SBAR(); }
#undef RDK
}
__device__ __forceinline__ void pv_tile(f32x16* o, int vb, bf16x8 pa0, bf16x8 pa1, bf16x8 pa2, bf16x8 pa3) {
#define TRRD(dst, off) asm volatile("ds_read_b64_tr_b16 %0, %1 offset:%2" : "=&v"(dst) : "v"(vb), "i"(off) : "memory")
#define RD8(L, H, d0) do { constexpr int b_ = v_rd_off(d0, 0, 0); TRRD(L[0], b_); TRRD(H[0], b_ + 2048); TRRD(L[1], b_ + 4096); TRRD(H[1], b_ + 6144); TRRD(L[2], b_ + 8192); TRRD(H[2], b_ + 10240); TRRD(L[3], b_ + 12288); TRRD(H[3], b_ + 14336); } while (0)
#define MM4(L, H, d0) do { \
        o[d0] = __builtin_amdgcn_mfma_f32_32x32x16_bf16(pa0, (bf16x8){L[0][0], L[0][1], L[0][2], L[0][3], H[0][0], H[0][1], H[0][2], H[0][3]}, o[d0], 0, 0, 0);   \
        o[d0] = __builtin_amdgcn_mfma_f32_32x32x16_bf16(pa1, (bf16x8){L[1][0], L[1][1], L[1][2], L[1][3], H[1][0], H[1][1], H[1][2], H[1][3]}, o[d0], 0, 0, 0);   \
        o[d0] = __builtin_amdgcn_mfma_f32_32x32x16_bf16(pa2, (bf16x8){L[2][0], L[2][1], L[2][2], L[2][3], H[2][0], H[2][1], H[2][2], H[2][3]}, o[d0], 0, 0, 0);   \
        o[d0] = __builtin_amdgcn_mfma_f32_32x32x16_bf16(pa3, (bf16x8){L[3][0], L[3][1], L[3][2], L[3][3], H[3][0], H[3][1], H[3][2], H[3][3]}, o[d0], 0, 0, 0); } while (0)
    s16x4 la[4], ha[4], lb[4], hb[4];
    RD8(la, ha, 0); RD8(lb, hb, 1);
    asm volatile("s_waitcnt lgkmcnt(8)" ::: "memory"); SBAR(); MM4(la, ha, 0); SBAR();
    RD8(la, ha, 2);
    asm volatile("s_waitcnt lgkmcnt(8)" ::: "memory"); SBAR(); MM4(lb, hb, 1); SBAR();
    RD8(lb, hb, 3);
    asm volatile("s_waitcnt lgkmcnt(8)" ::: "memory"); SBAR(); MM4(la, ha, 2); SBAR();
    asm volatile("s_waitcnt lgkmcnt(0)" ::: "memory"); SBAR(); MM4(lb, hb, 3);
#undef MM4
#undef RD8
#undef TRRD
}

template <int DQ, bool CAUSAL>
__device__ __forceinline__ void attn_block(const bf16_t* Q, int ldq, const bf16_t* Kh, int ldk, const bf16_t* Vh, int ldv, bf16_t* O, int ldo, int P0, int NT, float SCALE, LAS char* lds) {
    const float C2 = 1.4426950408889634f * SCALE;
    const int tid = my_tid(), wid = __builtin_amdgcn_readfirstlane(tid >> 6), lane = tid & 63, r32 = lane & 31, hi = lane >> 5;
    const int qlo = P0 + wid * QBLK, qm = qlo + r32 - 4 * hi;
    LAS char* V_lds = lds; LAS char* K_lds = lds + OFF_K;
    LAS float* ws = (LAS float*)(lds + OFF_WS) + wid * 64; LAS float* li_l = ws; LAS float* al_l = ws + 32;
    float m_reg = -1e30f, l_reg = 0; f32x16 o[4] = {};
    const int krow = 4 * wid + (lane >> 4);
    const unsigned goffK = (unsigned)krow * (unsigned)ldk + (unsigned)(((lane & 15) ^ KSWZF(krow)) * 8);
    const int rrow = 8 * wid + (lane >> 3);
    const unsigned goffR = (unsigned)rrow * (unsigned)ldk + 128u + (unsigned)(((lane & 7) ^ ((rrow >> 1) & 7)) * 8);
    const int vsub = 2 * wid + (lane >> 5), vkk = (vsub >> 2) * 8 + ((lane & 31) >> 2), vk = (vkk & ~0xC) | ((vkk & 4) << 1) | ((vkk & 8) >> 1);
    const unsigned goffV = (unsigned)vk * (unsigned)ldv + (unsigned)((vsub & 3) * 32 + (lane & 3) * 8);
    const int vb0 = (int)(uintptr_t)V_lds + v_rd_base(lane);
#define GLDS(gp, lp) __builtin_amdgcn_global_load_lds((const unsigned*)(gp), (LAS unsigned*)(lp), 16, 0, 0)
#define DMA_TILE(t, kslot, vslot) do { const bf16_t* kt_ = Kh + (size_t)(t) * KVBLK * ldk; const bf16_t* vt_ = Vh + (size_t)(t) * KVBLK * ldv; \
        LAS char* kd_ = K_lds + (kslot) * SHM_K + wid * 1024; LAS char* vd_ = V_lds + (vslot) * SHM_V + wid * 1024; \
        GLDS(kt_ + goffK, kd_); GLDS(kt_ + goffK + (size_t)32 * ldk, kd_ + 8192); \
        if constexpr (DQ == 192) GLDS(kt_ + goffR, kd_ + SHM_KN); \
        GLDS(vt_ + goffV, vd_); GLDS(vt_ + goffV + (size_t)32 * ldv, vd_ + 8192); } while (0)
#define RESC(a) do { if (__any((a) < 1.f)) { if (hi == 0) al_l[r32] = (a); asm volatile("s_waitcnt lgkmcnt(0)" ::: "memory");              \
                     _Pragma("unroll") for (int d_ = 0; d_ < 4; ++d_) _Pragma("unroll") for (int r = 0; r < 16; ++r) o[d_][r] *= al_l[crow(r, hi)]; } } while (0)
#define KBASE(t) ((t) * KVBLK)
#define MASKT(P0_, P1_, t) do { if constexpr (CAUSAL) { const int kb_ = KBASE(t); if (kb_ + KVBLK - 1 > qlo) mask_tile(P0_, P1_, qm - kb_); } } while (0)
    DMA_TILE(0, 0, 0);
    bf16x8 qr[8];
#pragma unroll
    for (int d0 = 0; d0 < 8; ++d0) qr[d0] = *(const bf16x8*)(Q + (size_t)(wid * QBLK + r32) * ldq + d0 * 16 + hi * 8);
    LAS char* qrl = lds + OFF_QR + wid * 4096 + lane * 16;
    if constexpr (DQ == 192) {
#pragma unroll
        for (int dd = 0; dd < 4; ++dd) *(LAS bf16x8*)(qrl + dd * 1024) = *(const bf16x8*)(Q + (size_t)(wid * QBLK + r32) * ldq + (8 + dd) * 16 + hi * 8);
    }
    __syncthreads();
    int vs_cur = 0, vs_next = 1;
#pragma unroll 1
    for (int t = 0; t < NT; ++t) {
        f32x16 p0, p1; float mn, al; bf16x8 pa0, pa1, pa2, pa3;
        SBAR(); qkt<DQ>(p0, p1, K_lds + (t & 1) * SHM_K, r32, hi, qr, qrl);
        SBAR(); if (t + 1 < NT) DMA_TILE(t + 1, (t + 1) & 1, vs_next);
        SBAR();
        MASKT(p0, p1, t); partialSM(p0, p1, m_reg, mn, al, SCALE, C2);
        RESC(al);
        finishSM(p0, p1, al, l_reg, pa0, pa1, pa2, pa3); SBAR();
        pv_tile(o, vb0 + vs_cur * SHM_V, pa0, pa1, pa2, pa3);
        __syncthreads();
        { const int t_ = vs_cur; vs_cur = vs_next; vs_next = t_; }
    }
    SBAR();
    if (hi == 0) li_l[r32] = l_reg; asm volatile("s_waitcnt lgkmcnt(0)" ::: "memory");
    float rli[16];
#pragma unroll
    for (int r = 0; r < 16; ++r) rli[r] = __builtin_amdgcn_rcpf(li_l[crow(r, hi)]);
    { LAS bf16_t* stg = (LAS bf16_t*)(lds + wid * 8192);
#pragma unroll
      for (int r = 0; r < 16; ++r) { const int orow = crow(r, hi);
#pragma unroll
          for (int d0 = 0; d0 < 4; ++d0) stg[orow * 128 + d0 * 32 + r32] = f2bf(o[d0][r] * rli[r]); }
      asm volatile("s_waitcnt lgkmcnt(0)" ::: "memory");
      bf16_t* Ow = O + (size_t)(wid * QBLK) * ldo;
#pragma unroll
      for (int i = 0; i < 8; ++i) { const int c = i * 64 + lane, row = c >> 4, ch = c & 15;
          const u32x4 v = *(const LAS u32x4*)(stg + row * 128 + ch * 8);
          *(u32x4*)(Ow + (size_t)row * ldo + ch * 8) = v; } }
    __syncthreads();
#undef GLDS
#undef DMA_TILE
#undef RESC
#undef KBASE
#undef MASKT
#undef HALF_STEP
}
}

struct Params {
    const float* x; const float* mem; const int* pos;
    const float *mix_norm, *mlp_norm, *w_out, *w_mlp_in, *w_mlp_out, *mem_norm, *w_mem_kv, *mem_k_norm, *mem_q_norm, *w_in_mla, *q_lat_norm, *w_q_up, *kv_lat_norm, *w_kv_up,
        *q_norm, *k_norm, *w_in_lru, *conv_w, *conv_b, *w_gate_a, *b_gate_a, *w_gate_i, *b_gate_i, *lru_lambda;
    float* out; unsigned char* ws; int ph_lo, ph_hi;
};
constexpr int LDS_MISC = 135168, LDS_TOTAL = LDS_MISC + 256 + 3072;
constexpr int NPHASE = 20;

constexpr int TR_STRIDE = 65, TR_SCR_BYTES = 64 * TR_STRIDE * 4;
struct TrSel { const float* W; bf16_t* WT; const float* gain; int N, ldt; };
__device__ __forceinline__ void tr_load(const TrSel& t, int lane, f32x4 (&v)[16], float (&g)[16]) {
#pragma unroll
    for (int i = 0; i < 16; ++i) { v[i] = *(const f32x4*)(t.W + (size_t)(4 * i + (lane >> 4)) * t.N + (lane & 15) * 4); g[i] = t.gain ? t.gain[4 * i + (lane >> 4)] : 1.f; }
}
__device__ __forceinline__ void tr_store(const TrSel& t, const f32x4 (&v)[16], const float (&g)[16], LAS float* scr, int lane) {
#pragma unroll
    for (int i = 0; i < 16; ++i) { const int kk = 4 * i + (lane >> 4); LAS float* d = scr + kk * TR_STRIDE + (lane & 15) * 4;
        d[0] = v[i].x * g[i]; d[1] = v[i].y * g[i]; d[2] = v[i].z * g[i]; d[3] = v[i].w * g[i]; }
    asm volatile("s_waitcnt lgkmcnt(0)" ::: "memory");
    const int c = lane & 7;
#pragma unroll
    for (int j = 0; j < 8; ++j) { const int n = (lane >> 3) + 8 * j; const LAS float* sp = scr + (8 * c) * TR_STRIDE + n;
        u32x4 o; o.x = cvt_pk_bf16(sp[0 * TR_STRIDE], sp[1 * TR_STRIDE]); o.y = cvt_pk_bf16(sp[2 * TR_STRIDE], sp[3 * TR_STRIDE]); o.z = cvt_pk_bf16(sp[4 * TR_STRIDE], sp[5 * TR_STRIDE]); o.w = cvt_pk_bf16(sp[6 * TR_STRIDE], sp[7 * TR_STRIDE]);
        *(u32x4*)(t.WT + (size_t)n * t.ldt + 8 * c) = o; }
    asm volatile("s_waitcnt lgkmcnt(0)" ::: "memory");
}
__device__ __forceinline__ bool tr_job(int& r, const float* W, int K, int N, bf16_t* WT, const float* gain, TrSel& t) {
    const int nblk = N / 64, items = (K / 64) * nblk;
    if (r >= items) { r -= items; return false; }
    const int kb = r / nblk, nb = r % nblk;
    t.W = W + (size_t)(64 * kb) * N + 64 * nb; t.N = N; t.WT = WT + (size_t)(64 * nb) * K + 64 * kb; t.ldt = K; t.gain = gain ? gain + 64 * kb : nullptr;
    return true;
}
__device__ __forceinline__ bool tr_gate_job(int& r, const float* W, int row_off, bf16_t* WT, TrSel& t) {
    const int items = 12 * 2 * 2;
    if (r >= items) { r -= items; return false; }
    const int blk = r / 4, kb = (r % 4) / 2, nb = r % 2;
    t.W = W + (size_t)blk * 16384 + (size_t)(64 * kb) * 128 + 64 * nb; t.N = 128; t.WT = WT + (size_t)blk * 32768 + (size_t)(row_off + 64 * nb) * 128 + 64 * kb; t.ldt = 128; t.gain = nullptr;
    return true;
}
__device__ __forceinline__ void cvt_rows(const float* X, bf16_t* out, float* ss, int rows, int gw, int NGW, int lane) {
    f32x4 v[8], nv[8]; int m = gw;
    if (m < rows) {
#pragma unroll
        for (int j = 0; j < 8; ++j) v[j] = ((const f32x4*)(X + (size_t)m * DM) + lane)[64 * j]; }
    for (; m < rows; m += NGW) {
        if (m + NGW < rows) {
#pragma unroll
            for (int j = 0; j < 8; ++j) nv[j] = ((const f32x4*)(X + (size_t)(m + NGW) * DM) + lane)[64 * j]; }
        asm volatile("" ::: "memory");
        float s = 0.f;
#pragma unroll
        for (int j = 0; j < 8; ++j) s += (v[j].x * v[j].x + v[j].y * v[j].y) + (v[j].z * v[j].z + v[j].w * v[j].w);
        s = wave_sum(s); if (lane == 0) ss[m] = s;
        u32x2* o8 = (u32x2*)(out + (size_t)m * DM) + lane;
#pragma unroll
        for (int j = 0; j < 8; ++j) { u32x2 w; w.x = cvt_pk_bf16(v[j].x, v[j].y); w.y = cvt_pk_bf16(v[j].z, v[j].w); o8[64 * j] = w; }
        asm volatile("" ::: "memory");
#pragma unroll
        for (int j = 0; j < 8; ++j) v[j] = nv[j];
    }
}

__device__ __forceinline__ void norm_rows(const float* X, const float* g, bf16_t* out, int rows, int gw, int NGW, int lane) {
    f32x4 gv[8];
#pragma unroll
    for (int j = 0; j < 8; ++j) gv[j] = ((const f32x4*)g)[lane + 64 * j];
    for (int m = gw; m < rows; m += NGW) {
        const f32x4* xr = (const f32x4*)(X + (size_t)m * DM) + lane; f32x4 v[8]; float s = 0.f;
#pragma unroll
        for (int j = 0; j < 8; ++j) { v[j] = xr[64 * j]; s += (v[j].x * v[j].x + v[j].y * v[j].y) + (v[j].z * v[j].z + v[j].w * v[j].w); }
        const float rstd = rsqrtf(wave_sum(s) * (1.f / DM) + EPS);
        u32x2* o8 = (u32x2*)(out + (size_t)m * DM) + lane;
#pragma unroll
        for (int j = 0; j < 8; ++j) { u32x2 w; w.x = cvt_pk_bf16(v[j].x * rstd * gv[j].x, v[j].y * rstd * gv[j].y); w.y = cvt_pk_bf16(v[j].z * rstd * gv[j].z, v[j].w * rstd * gv[j].w); o8[64 * j] = w; }
    }
}
template <int NJ, bool HEADS>
__device__ __forceinline__ void seg_norm(bf16_t* seg, const float* g, int n, int lane) {
    u32x2 w[NJ]; float s[NJ]; float tot = 0.f;
#pragma unroll
    for (int j = 0; j < NJ; ++j) { w[j] = ((const u32x2*)seg)[lane + 64 * j]; const float a = bflo(w[j].x), b = bfhi(w[j].x), c = bflo(w[j].y), d = bfhi(w[j].y); s[j] = (a * a + b * b) + (c * c + d * d); tot += s[j]; }
    float rs[NJ];
    if (HEADS) {
#pragma unroll
        for (int j = 0; j < NJ; ++j) rs[j] = rsqrtf(half_sum(s[j]) * (1.f / 128.f) + EPS);
    } else { const float r = rsqrtf(wave_sum(tot) / (float)n + EPS);
#pragma unroll
        for (int j = 0; j < NJ; ++j) rs[j] = r; }
#pragma unroll
    for (int j = 0; j < NJ; ++j) { const int gi = HEADS ? ((lane & 31) * 4) : (lane + 64 * j) * 4; const f32x4 gv = *(const f32x4*)(g + gi);
        u32x2 o; o.x = cvt_pk_bf16(bflo(w[j].x) * rs[j] * gv.x, bfhi(w[j].x) * rs[j] * gv.y); o.y = cvt_pk_bf16(bflo(w[j].y) * rs[j] * gv.z, bfhi(w[j].y) * rs[j] * gv.w);
        ((u32x2*)seg)[lane + 64 * j] = o; }
}

__device__ __forceinline__ u32x4 qk_head(u32x4 w, const float (&g)[8], bool r1, bool r2, int partner, const float (&cs)[8], const float (&sn)[8]) {
    float x[8] = {bflo(w.x), bfhi(w.x), bflo(w.y), bfhi(w.y), bflo(w.z), bfhi(w.z), bflo(w.w), bfhi(w.w)};
    float ss = 0.f;
#pragma unroll
    for (int j = 0; j < 8; ++j) ss += x[j] * x[j];
    const float rstd = rsqrtf(half_sum(ss) * (1.f / 192.f) + EPS);
#pragma unroll
    for (int j = 0; j < 8; ++j) x[j] = x[j] * rstd * g[j];
#pragma unroll
    for (int j = 0; j < 8; ++j) { const float pj = __shfl(x[j], partner); if (r1) x[j] = x[j] * cs[j] - pj * sn[j]; else if (r2) x[j] = x[j] * cs[j] + pj * sn[j]; }
    u32x4 o; o.x = cvt_pk_bf16(x[0], x[1]); o.y = cvt_pk_bf16(x[2], x[3]); o.z = cvt_pk_bf16(x[4], x[5]); o.w = cvt_pk_bf16(x[6], x[7]);
    return o;
}

#define XB_TMO      128
#define XB_XCNT(j)  (256  + 64 * (j))
#define XB_XSUB(j)  (1280 + 64 * (j))
#define XB_XGEN(j)  (2304 + 64 * (j))
#define XB_TOP      3328
#define XB_TOPGEN   3392
#define XCD_BAR_WORDS 3456
#define XB_SPIN_CAP (1u << 18)
__device__ __forceinline__ unsigned xb_ld(unsigned* p)              { return __hip_atomic_load(p, __ATOMIC_RELAXED, __HIP_MEMORY_SCOPE_AGENT); }
__device__ __forceinline__ unsigned xb_add(unsigned* p, unsigned v) { return __hip_atomic_fetch_add(p, v, __ATOMIC_RELAXED, __HIP_MEMORY_SCOPE_AGENT); }
__device__ __forceinline__ unsigned xb_xcc_id() { return (unsigned)__builtin_amdgcn_s_getreg((3 << 11) | 20) & 0xFu; }
#define XB_SPIN(cond, bar) do { unsigned _sp = 0; while (cond) { __builtin_amdgcn_s_sleep(1); \
    if ((++_sp & 255u) == 0u) { if (xb_ld(&(bar)[XB_TMO])) break; if (_sp > XB_SPIN_CAP) { atomicAdd(&(bar)[XB_TMO], 1u); break; } } } } while (0)
struct XcdBarrier { unsigned* bar; unsigned x; volatile LAS unsigned* st; };
__device__ __forceinline__ void xcd_barrier_complete(unsigned* bar, unsigned x, unsigned& nloc, unsigned& nx) {
    const unsigned G = gridDim.x * gridDim.y * gridDim.z;
    unsigned sum, cnt, mine, sp = 0u;
    for (;;) {
        sum = 0u; cnt = 0u; mine = 0u;
#pragma unroll
        for (unsigned j = 0; j < 16; ++j) { const unsigned c = xb_ld(&bar[XB_XCNT(j)]); sum += c; cnt += (c > 0u) ? 1u : 0u; mine = (j == x) ? c : mine; }
        if (sum == G) break;
        __builtin_amdgcn_s_sleep(1);
        if ((++sp & 255u) == 0u) { if (xb_ld(&bar[XB_TMO])) break; if (sp > XB_SPIN_CAP) { atomicAdd(&bar[XB_TMO], 1u); break; } }
    }
    nloc = mine > 0u ? mine : 1u; nx = cnt > 0u ? cnt : 1u;
}
__device__ __forceinline__ void xcd_barrier(const XcdBarrier& b) {
    asm volatile("s_waitcnt vmcnt(0)" ::: "memory");
    __syncthreads();
    if (threadIdx.x == 0) {
        unsigned* bar = b.bar;
        __builtin_amdgcn_s_waitcnt(0);
        unsigned nloc = b.st[0], nx = b.st[1];
        if (nloc == 0u) { xcd_barrier_complete(bar, b.x, nloc, nx); b.st[0] = nloc; b.st[1] = nx; }
        const unsigned old = xb_add(&bar[XB_XSUB(b.x)], 1u);
        const unsigned gen = old / nloc;
        if (old + 1u == (gen + 1u) * nloc) {
            __builtin_amdgcn_fence(__ATOMIC_RELEASE, "agent");
            asm volatile("s_waitcnt vmcnt(0)" ::: "memory");
            const unsigned og = xb_add(&bar[XB_TOP], 1u);
            const unsigned tg = og / nx;
            if (og + 1u == (tg + 1u) * nx) xb_add(&bar[XB_TOPGEN], 1u);
            else XB_SPIN(xb_ld(&bar[XB_TOPGEN]) == tg, bar);
            __builtin_amdgcn_fence(__ATOMIC_ACQUIRE, "agent");
            xb_add(&bar[XB_XGEN(b.x)], 1u);
            asm volatile("s_waitcnt vmcnt(0)" ::: "memory");
        } else {
            XB_SPIN(xb_ld(&bar[XB_XGEN(b.x)]) == gen, bar);
            __builtin_amdgcn_fence(__ATOMIC_ACQUIRE, "agent");
            asm volatile("s_waitcnt vmcnt(0)" ::: "memory");
        }
    }
    __syncthreads();
}
typedef __attribute__((address_space(4))) const Params CParams;
#define PHASE_BEGIN \
    CParams* P = (CParams*)__builtin_amdgcn_kernarg_segment_ptr(); asm volatile("" : "+s"(P)); \
    const int tid = my_tid(), lane = tid & 63, wave = __builtin_amdgcn_readfirstlane(tid >> 6); \
    const int G = gridDim.x, bx = blockIdx.x; const int gw = bx * 8 + wave, NGW = G * 8; \
    (void)lane; (void)gw; (void)NGW; \
    unsigned char* ws = P->ws; \
    unsigned* ctl = (unsigned*)(ws + WS_CTL); \
    bf16_t* Win0_t = (bf16_t*)(ws + WS_WIN0); bf16_t* Wqup_t = (bf16_t*)(ws + WS_WQUP); bf16_t* Wkvup_t = (bf16_t*)(ws + WS_WKVUP); bf16_t* Wout_t = (bf16_t*)(ws + WS_WOUT); \
    bf16_t* Wmi0_t = (bf16_t*)(ws + WS_A0); bf16_t* Wmo0_t = (bf16_t*)(ws + WS_A0 + 32 * MiB); bf16_t* Wmi1_t = (bf16_t*)(ws + WS_A1); bf16_t* Wmo1_t = (bf16_t*)(ws + WS_A1 + 32 * MiB); bf16_t* Wlru_t = (bf16_t*)(ws + WS_WLRU); bf16_t* Wmkv_t = (bf16_t*)(ws + WS_WMKV); bf16_t* Wg_t = (bf16_t*)(ws + WS_WG); \
    bf16_t* memn = (bf16_t*)(ws + WS_MEMN); float* mkv = (float*)(ws + WS_MKV); bf16_t* memK = (bf16_t*)(ws + WS_MEMK); bf16_t* memV = (bf16_t*)(ws + WS_MEMV); \
    float* rope = (float*)(ws + WS_ROPE); float* carryP = (float*)(ws + WS_CARRY); float* carryH = carryP + NB * NCHUNK * LRU_W; \
    bf16_t* xb = (bf16_t*)(ws + WS_S1); bf16_t* mixed0 = (bf16_t*)(ws + WS_A1); bf16_t* mixed1 = (bf16_t*)(ws + WS_A0); \
    float* ss0 = (float*)(ws + WS_SS); float* ss1 = ss0 + T; float* ss2 = ss1 + T; float* ss3 = ss2 + T; \
    bf16_t* proj0 = (bf16_t*)(ws + U_PROJ0); bf16_t* kvb = (bf16_t*)(ws + U_KV); bf16_t* Kb = (bf16_t*)(ws + U_K); bf16_t* Qb = (bf16_t*)P->out; \
    bf16_t* gateb = (bf16_t*)(ws + U_GATE); bf16_t* xinb = (bf16_t*)(ws + U_XIN); bf16_t* bscan = xinb; bf16_t* mqb = (bf16_t*)(ws + U_MQ); bf16_t* xcb = (bf16_t*)(ws + U_XC); bf16_t* ascan = (bf16_t*)(ws + U_A); \
    bf16_t* ub = (bf16_t*)(ws + WS_U); \
    float* clam = (float*)(ws + WS_CTL + 8192); \
    (void)0
__global__ void __launch_bounds__(512, 2) fwd_kernel(Params p) {
    extern __shared__ __attribute__((aligned(16))) unsigned char lds_raw[];
    LAS unsigned char* lds = (LAS unsigned char*)lds_raw;
    LAS int* s_item = (LAS int*)(lds + LDS_MISC);
    if (threadIdx.x < 64) ((LAS unsigned*)(lds + LDS_MISC))[threadIdx.x] = 0u;
    __syncthreads();
    cg::grid_group grid = cg::this_grid();
    const int lo = p.ph_lo, hi = p.ph_hi;
    if (hi > NPHASE + 7) grid.sync();
    if (hi - lo > 1 && threadIdx.x == 0) (void)xb_add((unsigned*)(p.ws + WS_CTL) + 4096 + XB_XCNT(xb_xcc_id()), 1u);
#ifndef PHMASK
#define PHMASK 0xFFFFF
#endif
#ifndef REPMASK
#define REPMASK 0
#endif
#define PH(k) if (((PHMASK >> (k)) & 1) && lo <= (k) && (k) < hi) for (int rep_ = 0; rep_ < 1 + ((REPMASK >> (k)) & 1); ++rep_)
#define SEAM(k) do { if (lo <= (k) && (k) + 1 < hi) { CParams* P_ = (CParams*)__builtin_amdgcn_kernarg_segment_ptr(); asm volatile("" : "+s"(P_)); \
        XcdBarrier b_; b_.bar = (unsigned*)(P_->ws + WS_CTL) + 4096; b_.x = xb_xcc_id(); b_.st = (volatile LAS unsigned*)(lds + LDS_MISC + 32); xcd_barrier(b_); } } while (0)

    PH(0) { PHASE_BEGIN; if (rep_) grid.sync();
        if (bx == 0 && tid < 64) ctl[tid] = 0u;
        if (bx == 1) for (int c = tid; c < LRU_W; c += 512) clam[c] = -8.0f * log1pf(expf(-P->lru_lambda[c]));
        LAS float* scr = (LAS float*)(lds + wave * TR_SCR_BYTES);
        constexpr int NITEMS = 2 * (2048 / 64) * (8192 / 64) + (2048 / 64) * (1856 / 64) + (768 / 64) * (2304 / 64) + (512 / 64) * (3072 / 64) + 2 * (2048 / 64) * (2048 / 64)
                             + (2048 / 64) * (3584 / 64) + (2048 / 64) * (1024 / 64) + 2 * 48;
#define P0_SELECT(it_, t) do { int r = (it_); \
            if (tr_job(r, P->w_mlp_in, 2048, 8192, Wmi0_t, P->mlp_norm, t)) {} \
            else if (tr_job(r, P->w_mlp_out, 8192, 2048, Wmo0_t, nullptr, t)) {} \
            else if (tr_job(r, P->w_in_mla, 2048, 1856, Win0_t, P->mix_norm, t)) {} \
            else if (tr_job(r, P->w_q_up, 768, 2304, Wqup_t, nullptr, t)) {} \
            else if (tr_job(r, P->w_kv_up, 512, 3072, Wkvup_t, nullptr, t)) {} \
            else if (tr_job(r, P->w_out, 2048, 2048, Wout_t, nullptr, t)) {} \
            else if (tr_job(r, P->w_out + (size_t)2048 * 2048, 2048, 2048, Wout_t + (size_t)2048 * 2048, nullptr, t)) {} \
            else if (tr_job(r, P->w_in_lru, 2048, 3584, Wlru_t, P->mix_norm + DM, t)) {} \
            else if (tr_job(r, P->w_mem_kv, 2048, 1024, Wmkv_t, nullptr, t)) {} \
            else if (tr_gate_job(r, P->w_gate_a, 0, Wg_t, t)) {} \
            else tr_gate_job(r, P->w_gate_i, 128, Wg_t, t); } while (0)
        { int it = gw; TrSel cur, nx; f32x4 v[16], nv[16]; float gg[16], ng[16];
          if (it < NITEMS) { P0_SELECT(it, cur); tr_load(cur, lane, v, gg); }
          while (it < NITEMS) { const int nit = it + NGW;
              if (nit < NITEMS) { P0_SELECT(nit, nx); tr_load(nx, lane, nv, ng); }
              asm volatile("" ::: "memory");
              tr_store(cur, v, gg, scr, lane);
              asm volatile("" ::: "memory");
              cur = nx; it = nit;
#pragma unroll
              for (int i = 0; i < 16; ++i) { v[i] = nv[i]; gg[i] = ng[i]; } } }
#undef P0_SELECT
        { u32x4* z = (u32x4*)(Win0_t + (size_t)MLA_IN * 2048); const int n16 = (MLA_INP - MLA_IN) * 2048 * 2 / 16;
          for (int i = bx * 512 + tid; i < n16; i += G * 512) z[i] = (u32x4){0u, 0u, 0u, 0u}; }
        for (int i = bx * 512 + tid; i < 3 * T; i += G * 512) ss1[i] = 0.f;
        cvt_rows(P->x, xb, ss0, T, gw, NGW, lane);
        norm_rows(P->mem, P->mem_norm, memn, NB * MEML, gw, NGW, lane);
        for (int i = bx * 512 + tid; i < T * 32; i += G * 512) { const int m = i >> 5, f = i & 31; const float inv = powf(10000.f, -(float)f / 32.f); const float ang = (float)P->pos[m] * inv;
            rope[(size_t)m * 64 + f] = cosf(ang); rope[(size_t)m * 64 + 32 + f] = sinf(ang); }
    }
    SEAM(0);
    PH(1) { PHASE_BEGIN;
        pg8::Gemm g{xb, Win0_t, T, MLA_INP, 2048, 2048, 2048, 0}; pg8::StaticOrder S; S.init(T, MLA_INP, G, bx);
        pg8::EpiBf16<0> E{proj0, proj0, proj0, 2048, 2048, 2048, 1 << 20, 1 << 20, ss0};
        pg8::gemm_phase<pg8::EpiBf16<0>, true>(lds, g, S, E);
    }
    SEAM(1);
    PH(2) { PHASE_BEGIN;
        f32x4 gq_[3], gkv_[2]; const f32x4 gm_ = *(const f32x4*)(P->mem_q_norm + (lane & 31) * 4);
#pragma unroll
        for (int j = 0; j < 3; ++j) gq_[j] = *(const f32x4*)(P->q_lat_norm + (lane + 64 * j) * 4);
#pragma unroll
        for (int j = 0; j < 2; ++j) gkv_[j] = *(const f32x4*)(P->kv_lat_norm + (lane + 64 * j) * 4);
        u32x2 w[7], nw[7]; int m = gw;
#define P2_LOAD(dst, mm) do { const u32x2* r_ = (const u32x2*)(proj0 + (size_t)(mm) * 2048); \
            dst[0] = r_[lane]; dst[1] = r_[lane + 64]; dst[2] = r_[lane + 128]; dst[3] = r_[192 + lane]; dst[4] = r_[192 + lane + 64]; dst[5] = r_[336 + lane]; dst[6] = r_[336 + lane + 64]; } while (0)
        if (m < T) P2_LOAD(w, m);
        for (; m < T; m += NGW) {
            if (m + NGW < T) P2_LOAD(nw, m + NGW);
            asm volatile("" ::: "memory");
            float sq[7];
#pragma unroll
            for (int j = 0; j < 7; ++j) { const float a = bflo(w[j].x), b = bfhi(w[j].x), c = bflo(w[j].y), d = bfhi(w[j].y); sq[j] = (a * a + b * b) + (c * c + d * d); }
            const float rq = rsqrtf(wave_sum(sq[0] + sq[1] + sq[2]) * (1.f / 768.f) + EPS), rkv = rsqrtf(wave_sum(sq[3] + sq[4]) * (1.f / 512.f) + EPS);
            const float rm0 = rsqrtf(half_sum(sq[5]) * (1.f / 128.f) + EPS), rm1 = rsqrtf(half_sum(sq[6]) * (1.f / 128.f) + EPS);
            u32x2* r_ = (u32x2*)(proj0 + (size_t)m * 2048);
#define P2_ST(idx, j, rs, gv) do { u32x2 o_; o_.x = cvt_pk_bf16(bflo(w[j].x) * (rs) * (gv).x, bfhi(w[j].x) * (rs) * (gv).y); o_.y = cvt_pk_bf16(bflo(w[j].y) * (rs) * (gv).z, bfhi(w[j].y) * (rs) * (gv).w); r_[idx] = o_; } while (0)
            P2_ST(lane, 0, rq, gq_[0]); P2_ST(lane + 64, 1, rq, gq_[1]); P2_ST(lane + 128, 2, rq, gq_[2]);
            P2_ST(192 + lane, 3, rkv, gkv_[0]); P2_ST(192 + lane + 64, 4, rkv, gkv_[1]);
            P2_ST(336 + lane, 5, rm0, gm_); P2_ST(336 + lane + 64, 6, rm1, gm_);
            asm volatile("" ::: "memory");
#pragma unroll
            for (int j = 0; j < 7; ++j) w[j] = nw[j];
        }
#undef P2_LOAD
#undef P2_ST
    }
    SEAM(2);
    PH(3) { PHASE_BEGIN;
        { pg8::Gemm g{proj0 + QLORA, Wkvup_t, T, KVW, KVLORA, 2048, KVLORA, 0}; pg8::StaticOrder S; S.init(T, KVW, G, bx);
          pg8::EpiBf16<0> E{kvb, kvb, kvb, KVW, KVW, KVW, 1 << 20, 1 << 20, nullptr}; pg8::gemm_phase<pg8::EpiBf16<0>, true>(lds, g, S, E); }
        { pg8::Gemm g{proj0, Wqup_t, T, QW, QLORA, 2048, QLORA, 0}; pg8::StaticOrder S; S.init(T, QW, G, bx);
          pg8::EpiBf16<0> E{Qb, Qb, Qb, QW, QW, QW, 1 << 20, 1 << 20, nullptr}; pg8::gemm_phase<pg8::EpiBf16<0>, true>(lds, g, S, E); }
        { pg8::Gemm g{memn, Wmkv_t, NB * MEML, 1024, 2048, 2048, 2048, 0}; pg8::StaticOrder S; S.init(NB * MEML, 1024, G, (bx + G - 64) % G);
          pg8::EpiRes E{nullptr, nullptr, mkv, nullptr, nullptr, 1024}; pg8::gemm_phase<pg8::EpiRes, true>(lds, g, S, E); }
    }
    SEAM(3);
    PH(4) { PHASE_BEGIN;
        const int half = lane >> 5, L = lane & 31; const bool act = L < 24, r1 = (L >= 16 && L < 20), r2 = (L >= 20 && L < 24);
        const int partner = r1 ? lane + 4 : (r2 ? lane - 4 : lane);
        float gq[8], gk[8];
#pragma unroll
        for (int j = 0; j < 8; ++j) { gq[j] = act ? P->q_norm[L * 8 + j] : 0.f; gk[j] = act ? P->k_norm[L * 8 + j] : 0.f; }
        for (int m = gw; m < T; m += NGW) {
            float cs[8], sn[8];
            { const int i0 = ((L - 16) & 3) * 8;
#pragma unroll
              for (int j = 0; j < 8; ++j) { cs[j] = rope[(size_t)m * 64 + i0 + j]; sn[j] = rope[(size_t)m * 64 + 32 + i0 + j]; } }
            bf16_t* qrow = Qb + (size_t)m * QW + L * 8; bf16_t* krow = Kb + (size_t)m * QW + L * 8;
            const bf16_t* ksrc = (L < 16) ? kvb + (size_t)m * KVW + L * 8 : proj0 + (size_t)m * 2048 + 1280 + (L - 16) * 8; const int kstep = (L < 16) ? 256 : 0;
            const u32x4 zero4 = {0u, 0u, 0u, 0u};
            u32x4 wq = act ? *(const u32x4*)(qrow + half * QKD) : zero4, wk = act ? *(const u32x4*)(ksrc + half * kstep) : zero4;
#pragma unroll 1
            for (int i = 0; i < 6; ++i) { const int h = 2 * i + half; u32x4 nq = zero4, nk = zero4;
                if (i < 5 && act) { nq = *(const u32x4*)(qrow + (h + 2) * QKD); nk = *(const u32x4*)(ksrc + (h + 2) * kstep); }
                asm volatile("" ::: "memory");
                const u32x4 oq = qk_head(wq, gq, r1, r2, partner, cs, sn), ok = qk_head(wk, gk, r1, r2, partner, cs, sn);
                if (act) { *(u32x4*)(qrow + h * QKD) = oq; *(u32x4*)(krow + h * QKD) = ok; }
                asm volatile("" ::: "memory");
                wq = nq; wk = nk; }
        }
        for (int m = gw; m < NB * MEML; m += NGW) { const float* r = mkv + (size_t)m * 1024;
            const f32x4 k0 = *(const f32x4*)(r + lane * 8), k1 = *(const f32x4*)(r + lane * 8 + 4), v0 = *(const f32x4*)(r + 512 + lane * 8), v1 = *(const f32x4*)(r + 512 + lane * 8 + 4);
            float ss = (k0.x * k0.x + k0.y * k0.y) + (k0.z * k0.z + k0.w * k0.w) + (k1.x * k1.x + k1.y * k1.y) + (k1.z * k1.z + k1.w * k1.w);
#pragma unroll
            for (int o = 1; o < 16; o <<= 1) ss += __shfl_xor(ss, o);
            const float rstd = rsqrtf(ss * (1.f / 128.f) + EPS); const float* gk2 = P->mem_k_norm + (lane & 15) * 8;
            u32x4 ok, ov; ok.x = cvt_pk_bf16(k0.x * rstd * gk2[0], k0.y * rstd * gk2[1]); ok.y = cvt_pk_bf16(k0.z * rstd * gk2[2], k0.w * rstd * gk2[3]);
            ok.z = cvt_pk_bf16(k1.x * rstd * gk2[4], k1.y * rstd * gk2[5]); ok.w = cvt_pk_bf16(k1.z * rstd * gk2[6], k1.w * rstd * gk2[7]);
            ov.x = cvt_pk_bf16(v0.x, v0.y); ov.y = cvt_pk_bf16(v0.z, v0.w); ov.z = cvt_pk_bf16(v1.x, v1.y); ov.w = cvt_pk_bf16(v1.z, v1.w);
            *(u32x4*)(memK + (size_t)m * 512 + lane * 8) = ok; *(u32x4*)(memV + (size_t)m * 512 + lane * 8) = ov; }
    }
    SEAM(4);
    PH(5) { PHASE_BEGIN; if (rep_) grid.sync();
        const int x0 = (int)(xb_xcc_id() & 7u);
        for (int qi = 0; qi < 8; ++qi) { const int q = (x0 + qi) & 7;
            for (;;) {
                if (tid == 0) *s_item = (int)atomicAdd(ctl + 8 * q, 1u);
                __syncthreads(); const int li = *s_item; __syncthreads();
                if (li >= 128) break;
                if (li < 96) { const int qb = 31 - li / 3, bh = q + 8 * (li % 3), b = bh / NHEAD, h = bh % NHEAD; const size_t r0 = (size_t)b * SEQ;
                    att::attn_block<192, true>(Qb + (r0 + qb * 256) * QW + h * QKD, QW, Kb + r0 * QW + h * QKD, QW, kvb + r0 * KVW + h * 256 + 128, KVW,
                                               mixed0 + (r0 + qb * 256) * DM + h * 128, DM, qb * 256, 4 * (qb + 1), 0.07216878364870322f, (LAS char*)lds);
                } else { const int i2 = q * 32 + (li - 96), qb = i2 & 31, mh = (i2 >> 5) & 3, b = i2 >> 7; const size_t r0 = (size_t)b * SEQ;
                    att::attn_block<128, false>(proj0 + (r0 + qb * 256) * 2048 + 1344 + mh * 128, 2048, memK + (size_t)b * MEML * 512 + mh * 128, 512, memV + (size_t)b * MEML * 512 + mh * 128, 512,
                                                mixed0 + (r0 + qb * 256) * DM + LRU_W + mh * 128, DM, 0, 4, 0.08838834764831845f, (LAS char*)lds); }
            } }
    }
    SEAM(5);
    PH(6) { PHASE_BEGIN;
        pg8::Gemm g{mixed0, Wout_t, T, DM, DM, DM, DM, 0}; pg8::StaticOrder S; S.init(T, DM, G, bx);
        pg8::EpiRes E{P->x, nullptr, nullptr, xb, ss1, DM}; pg8::gemm_phase<pg8::EpiRes, true>(lds, g, S, E);
    }
    SEAM(6);
    PH(8) { PHASE_BEGIN; if (rep_) grid.sync();
        pg8::Gemm g{xb, Wmi0_t, T, DFF, DM, DM, DM, 0}; pg8::StaticOrder S; S.init(T, DFF, G, bx);
        pg8::EpiBf16<1> E{ub, ub, ub, DFF, DFF, DFF, 1 << 20, 1 << 20, ss1}; pg8::gemm_phase<pg8::EpiBf16<1>, true>(lds, g, S, E);
    }
    SEAM(8);
    PH(9) { PHASE_BEGIN;
        pg8::Gemm g{ub, Wmo0_t, T, DM, DFF, DFF, DFF, 0}; pg8::StaticOrder S; S.init(T, DM, G, bx);
        pg8::EpiRes E{nullptr, xb, nullptr, xb, ss2, DM}; pg8::gemm_phase<pg8::EpiRes, true>(lds, g, S, E);
    }
    SEAM(9);
    PH(11) { PHASE_BEGIN;
        pg8::Gemm g{xb, Wlru_t, T, LRU_IN, DM, DM, DM, 0}; pg8::StaticOrder S; S.init(T, LRU_IN, G, bx);
        pg8::EpiBf16<2> E{gateb, xinb, mqb, LRU_W, LRU_W, 512, 6, 12, ss2}; pg8::gemm_phase<pg8::EpiBf16<2>, true>(lds, g, S, E);
    }
    SEAM(11);
    PH(12) { PHASE_BEGIN;
        { LAS float* scr = (LAS float*)(lds + wave * TR_SCR_BYTES); constexpr int NIT1 = 2 * (2048 / 64) * (8192 / 64);
#define P12_SELECT(it_, t) do { int r = (it_); if (tr_job(r, P->w_mlp_in + (size_t)2048 * 8192, 2048, 8192, Wmi1_t, P->mlp_norm + DM, t)) {} \
              else tr_job(r, P->w_mlp_out + (size_t)2048 * 8192, 8192, 2048, Wmo1_t, nullptr, t); } while (0)
          int it = gw; TrSel cur, nx; f32x4 v[16], nv[16]; float gg[16], ng[16];
          if (it < NIT1) { P12_SELECT(it, cur); tr_load(cur, lane, v, gg); }
          while (it < NIT1) { const int nit = it + NGW;
              if (nit < NIT1) { P12_SELECT(nit, nx); tr_load(nx, lane, nv, ng); }
              asm volatile("" ::: "memory");
              tr_store(cur, v, gg, scr, lane);
              asm volatile("" ::: "memory");
              cur = nx; it = nit;
#pragma unroll
              for (int i = 0; i < 16; ++i) { v[i] = nv[i]; gg[i] = ng[i]; } } }
#undef P12_SELECT
        for (int item = gw; item < (T / 32) * 3; item += NGW) { const int third = item % 3, m0 = (item / 3) * 32; const int c0 = third * 512 + lane * 8;
            float wt[4][8], bs[8];
#pragma unroll
            for (int k = 0; k < 4; ++k) { const f32x4 w0 = *(const f32x4*)(P->conv_w + k * LRU_W + c0), w1 = *(const f32x4*)(P->conv_w + k * LRU_W + c0 + 4);
                wt[k][0] = w0.x; wt[k][1] = w0.y; wt[k][2] = w0.z; wt[k][3] = w0.w; wt[k][4] = w1.x; wt[k][5] = w1.y; wt[k][6] = w1.z; wt[k][7] = w1.w; }
            { const f32x4 b0 = *(const f32x4*)(P->conv_b + c0), b1 = *(const f32x4*)(P->conv_b + c0 + 4); bs[0] = b0.x; bs[1] = b0.y; bs[2] = b0.z; bs[3] = b0.w; bs[4] = b1.x; bs[5] = b1.y; bs[6] = b1.z; bs[7] = b1.w; }
            const bf16_t* xp = xinb + c0; u32x4 win[3], cur[4], nxt[4];
#pragma unroll
            for (int k = 0; k < 3; ++k) { const int mm = m0 - 3 + k; win[k] = *(const u32x4*)(xp + (size_t)(mm < 0 ? 0 : mm) * LRU_W); }
#pragma unroll
            for (int k = 0; k < 4; ++k) cur[k] = *(const u32x4*)(xp + (size_t)(m0 + k) * LRU_W);
#pragma unroll 1
            for (int g = 0; g < 8; ++g) { const int mg = m0 + 4 * g;
                if (g < 7) {
#pragma unroll
                    for (int k = 0; k < 4; ++k) nxt[k] = *(const u32x4*)(xp + (size_t)(mg + 4 + k) * LRU_W); }
                asm volatile("" ::: "memory");
                u32x4 outv[4];
#pragma unroll
                for (int r = 0; r < 4; ++r) { const int sidx = (mg + r) & (SEQ - 1); float acc[8];
#pragma unroll
                    for (int e = 0; e < 8; ++e) acc[e] = bs[e];
#pragma unroll
                    for (int k = 0; k < 4; ++k) { const int wi = r + k; const u32x4 xv = wi < 3 ? win[wi] : cur[wi - 3];
                        if (sidx - 3 + k >= 0) { acc[0] += wt[k][0] * bflo(xv.x); acc[1] += wt[k][1] * bfhi(xv.x); acc[2] += wt[k][2] * bflo(xv.y); acc[3] += wt[k][3] * bfhi(xv.y);
                                                 acc[4] += wt[k][4] * bflo(xv.z); acc[5] += wt[k][5] * bfhi(xv.z); acc[6] += wt[k][6] * bflo(xv.w); acc[7] += wt[k][7] * bfhi(xv.w); } }
                    outv[r].x = cvt_pk_bf16(acc[0], acc[1]); outv[r].y = cvt_pk_bf16(acc[2], acc[3]); outv[r].z = cvt_pk_bf16(acc[4], acc[5]); outv[r].w = cvt_pk_bf16(acc[6], acc[7]); }
#pragma unroll
                for (int r = 0; r < 4; ++r) *(u32x4*)(xcb + (size_t)(mg + r) * LRU_W + c0) = outv[r];
                asm volatile("" ::: "memory");
                win[0] = cur[1]; win[1] = cur[2]; win[2] = cur[3];
#pragma unroll
                for (int k = 0; k < 4; ++k) cur[k] = nxt[k]; } }
        { const f32x4 gm_ = *(const f32x4*)(P->mem_q_norm + 128 + (lane & 31) * 4); u32x2 w0, w1, n0, n1; int m = gw;
          if (m < T) { const u32x2* r_ = (const u32x2*)(mqb + (size_t)m * 512); w0 = r_[lane]; w1 = r_[lane + 64]; }
          for (; m < T; m += NGW) {
              if (m + NGW < T) { const u32x2* r_ = (const u32x2*)(mqb + (size_t)(m + NGW) * 512); n0 = r_[lane]; n1 = r_[lane + 64]; }
              asm volatile("" ::: "memory");
              float s0, s1; { const float a = bflo(w0.x), b = bfhi(w0.x), c = bflo(w0.y), d = bfhi(w0.y); s0 = (a * a + b * b) + (c * c + d * d); }
              { const float a = bflo(w1.x), b = bfhi(w1.x), c = bflo(w1.y), d = bfhi(w1.y); s1 = (a * a + b * b) + (c * c + d * d); }
              const float r0 = rsqrtf(half_sum(s0) * (1.f / 128.f) + EPS), r1 = rsqrtf(half_sum(s1) * (1.f / 128.f) + EPS);
              u32x2* r_ = (u32x2*)(mqb + (size_t)m * 512); u32x2 o;
              o.x = cvt_pk_bf16(bflo(w0.x) * r0 * gm_.x, bfhi(w0.x) * r0 * gm_.y); o.y = cvt_pk_bf16(bflo(w0.y) * r0 * gm_.z, bfhi(w0.y) * r0 * gm_.w); r_[lane] = o;
              o.x = cvt_pk_bf16(bflo(w1.x) * r1 * gm_.x, bfhi(w1.x) * r1 * gm_.y); o.y = cvt_pk_bf16(bflo(w1.y) * r1 * gm_.z, bfhi(w1.y) * r1 * gm_.w); r_[lane + 64] = o;
              asm volatile("" ::: "memory");
              w0 = n0; w1 = n1; } }
    }
    SEAM(12);
    PH(13) { PHASE_BEGIN;
        pg8::Gemm g{xcb, Wg_t, T, 12 * 256, 128, LRU_W, 128, 256}; pg8::StaticOrder S; S.init(T, 12 * 256, G, bx);
        pg8::EpiGates E{P->b_gate_a, P->b_gate_i, clam, ascan, bscan, (LAS float*)(lds + LDS_MISC + 256)}; pg8::gemm_phase<pg8::EpiGates, true>(lds, g, S, E);
    }
    SEAM(13);
    PH(14) { PHASE_BEGIN;
        for (int it = bx; it < NB * NCHUNK; it += G) { const int ch = it % NCHUNK, b = it / NCHUNK;
            if (tid < LRU_W / 4) { const int c = tid * 4; const size_t base = ((size_t)b * SEQ + (size_t)ch * CHL) * LRU_W + c; float h[4] = {0.f, 0.f, 0.f, 0.f}, Pp[4] = {1.f, 1.f, 1.f, 1.f};
#pragma unroll 8
                for (int s = 0; s < CHL; ++s) { const u32x2 aw = *(const u32x2*)(ascan + base + (size_t)s * LRU_W), bw = *(const u32x2*)(bscan + base + (size_t)s * LRU_W), xw = *(const u32x2*)(xcb + base + (size_t)s * LRU_W);
                    const float av[4] = {1.f - bflo(aw.x), 1.f - bfhi(aw.x), 1.f - bflo(aw.y), 1.f - bfhi(aw.y)}, bv[4] = {bflo(bw.x) * bflo(xw.x), bfhi(bw.x) * bfhi(xw.x), bflo(bw.y) * bflo(xw.y), bfhi(bw.y) * bfhi(xw.y)};
#pragma unroll
                    for (int j = 0; j < 4; ++j) { h[j] = av[j] * h[j] + bv[j]; Pp[j] *= av[j]; } }
                *(f32x4*)(carryP + ((size_t)b * NCHUNK + ch) * LRU_W + c) = (f32x4){Pp[0], Pp[1], Pp[2], Pp[3]}; *(f32x4*)(carryH + ((size_t)b * NCHUNK + ch) * LRU_W + c) = (f32x4){h[0], h[1], h[2], h[3]}; } }
        for (int i2 = bx; i2 < NB * 4 * 32; i2 += G) { const int qb = i2 & 31, mh = (i2 >> 5) & 3, b = i2 >> 7; const size_t r0 = (size_t)b * SEQ;
            att::attn_block<128, false>(mqb + (r0 + qb * 256) * 512 + mh * 128, 512, memK + (size_t)b * MEML * 512 + mh * 128, 512, memV + (size_t)b * MEML * 512 + mh * 128, 512,
                                        mixed1 + (r0 + qb * 256) * DM + LRU_W + mh * 128, DM, 0, 4, 0.08838834764831845f, (LAS char*)lds); }
    }
    SEAM(14);
    PH(15) { PHASE_BEGIN;
        for (int it = bx; it < NB * NCHUNK; it += G) { const int ch = it % NCHUNK, b = it / NCHUNK;
            if (tid < LRU_W / 4) { const int c = tid * 4; float h[4] = {0.f, 0.f, 0.f, 0.f};
#pragma unroll 4
                for (int j = 0; j < ch; ++j) { const size_t ci = ((size_t)b * NCHUNK + j) * LRU_W + c; const f32x4 cp = *(const f32x4*)(carryP + ci), chh = *(const f32x4*)(carryH + ci);
                    h[0] = cp.x * h[0] + chh.x; h[1] = cp.y * h[1] + chh.y; h[2] = cp.z * h[2] + chh.z; h[3] = cp.w * h[3] + chh.w; }
                const size_t row0 = (size_t)b * SEQ + (size_t)ch * CHL;
                u32x2 ca[8], cb[8], cg_[8], cx[8], na[8], nb[8], ng[8], nx_[8];
#pragma unroll
                for (int j = 0; j < 8; ++j) { const size_t off = (row0 + j) * LRU_W + c; ca[j] = *(const u32x2*)(ascan + off); cb[j] = *(const u32x2*)(bscan + off); cg_[j] = *(const u32x2*)(gateb + off); cx[j] = *(const u32x2*)(xcb + off); }
#pragma unroll 1
                for (int s0 = 0; s0 < CHL; s0 += 8) {
                    if (s0 + 8 < CHL) {
#pragma unroll
                        for (int j = 0; j < 8; ++j) { const size_t off = (row0 + s0 + 8 + j) * LRU_W + c; na[j] = *(const u32x2*)(ascan + off); nb[j] = *(const u32x2*)(bscan + off); ng[j] = *(const u32x2*)(gateb + off); nx_[j] = *(const u32x2*)(xcb + off); } }
                    asm volatile("" ::: "memory");
                    u32x2 y[8];
#pragma unroll
                    for (int j = 0; j < 8; ++j) { h[0] = (1.f - bflo(ca[j].x)) * h[0] + bflo(cb[j].x) * bflo(cx[j].x); h[1] = (1.f - bfhi(ca[j].x)) * h[1] + bfhi(cb[j].x) * bfhi(cx[j].x);
                        h[2] = (1.f - bflo(ca[j].y)) * h[2] + bflo(cb[j].y) * bflo(cx[j].y); h[3] = (1.f - bfhi(ca[j].y)) * h[3] + bfhi(cb[j].y) * bfhi(cx[j].y);
                        y[j].x = cvt_pk_bf16(h[0] * bflo(cg_[j].x), h[1] * bfhi(cg_[j].x)); y[j].y = cvt_pk_bf16(h[2] * bflo(cg_[j].y), h[3] * bfhi(cg_[j].y)); }
#pragma unroll
                    for (int j = 0; j < 8; ++j) *(u32x2*)(mixed1 + (row0 + s0 + j) * DM + c) = y[j];
                    asm volatile("" ::: "memory");
#pragma unroll
                    for (int j = 0; j < 8; ++j) { ca[j] = na[j]; cb[j] = nb[j]; cg_[j] = ng[j]; cx[j] = nx_[j]; }
                } } }
    }
    SEAM(15);
    PH(16) { PHASE_BEGIN;
        pg8::Gemm g{mixed1, Wout_t + (size_t)DM * DM, T, DM, DM, DM, DM, 0}; pg8::StaticOrder S; S.init(T, DM, G, bx);
        pg8::EpiRes E{nullptr, xb, nullptr, xb, ss3, DM}; pg8::gemm_phase<pg8::EpiRes, true>(lds, g, S, E);
    }
    SEAM(16);
    PH(18) { PHASE_BEGIN;
        pg8::Gemm g{xb, Wmi1_t, T, DFF, DM, DM, DM, 0}; pg8::StaticOrder S; S.init(T, DFF, G, bx);
        pg8::EpiBf16<1> E{ub, ub, ub, DFF, DFF, DFF, 1 << 20, 1 << 20, ss3}; pg8::gemm_phase<pg8::EpiBf16<1>, true>(lds, g, S, E);
    }
    SEAM(18);
    PH(19) { PHASE_BEGIN;
        pg8::Gemm g{ub, Wmo1_t, T, DM, DFF, DFF, DFF, 0}; pg8::StaticOrder S; S.init(T, DM, G, bx);
        pg8::EpiRes E{nullptr, xb, P->out, nullptr, nullptr, DM}; pg8::gemm_phase<pg8::EpiRes, true>(lds, g, S, E);
    }
#undef PH
#undef SEAM
}

#ifndef ONE_LAUNCH
#define ONE_LAUNCH 1
#endif
extern "C" void kernel_launch(void* const* d_in, const int* in_sizes, int n_in, void* d_out, int out_size, void* d_ws, size_t ws_size, hipStream_t stream) {
    static int grid = 0;
    if (grid == 0) {
        if (n_in != 27 || ws_size < WS_END) { fprintf(stderr, "kernel_launch: unexpected n_in %d / ws_size %zu\n", n_in, ws_size); grid = -1; return; }
        int dev = 0, cus = 0, per_cu = 0;
        hipGetDevice(&dev); hipDeviceGetAttribute(&cus, hipDeviceAttributeMultiprocessorCount, dev);
        hipFuncSetAttribute((const void*)fwd_kernel, hipFuncAttributeMaxDynamicSharedMemorySize, LDS_TOTAL);
        hipOccupancyMaxActiveBlocksPerMultiprocessor(&per_cu, (const void*)fwd_kernel, 512, LDS_TOTAL);
        if (per_cu < 1) { fprintf(stderr, "kernel_launch: occupancy query says %d blocks per CU\n", per_cu); per_cu = 1; }
        (void)hipGetLastError();
        grid = cus;
    }
    if (grid < 0) return;
    Params p{};
    p.x = (const float*)d_in[0]; p.mem = (const float*)d_in[1]; p.pos = (const int*)d_in[2];
    p.mix_norm = (const float*)d_in[3]; p.mlp_norm = (const float*)d_in[4]; p.w_out = (const float*)d_in[5]; p.w_mlp_in = (const float*)d_in[6]; p.w_mlp_out = (const float*)d_in[7];
    p.mem_norm = (const float*)d_in[8]; p.w_mem_kv = (const float*)d_in[9]; p.mem_k_norm = (const float*)d_in[10]; p.mem_q_norm = (const float*)d_in[11]; p.w_in_mla = (const float*)d_in[12];
    p.q_lat_norm = (const float*)d_in[13]; p.w_q_up = (const float*)d_in[14]; p.kv_lat_norm = (const float*)d_in[15]; p.w_kv_up = (const float*)d_in[16]; p.q_norm = (const float*)d_in[17];
    p.k_norm = (const float*)d_in[18]; p.w_in_lru = (const float*)d_in[19]; p.conv_w = (const float*)d_in[20]; p.conv_b = (const float*)d_in[21]; p.w_gate_a = (const float*)d_in[22];
    p.b_gate_a = (const float*)d_in[23]; p.w_gate_i = (const float*)d_in[24]; p.b_gate_i = (const float*)d_in[25]; p.lru_lambda = (const float*)d_in[26];
    p.out = (float*)d_out; p.ws = (unsigned char*)d_ws;
#if ONE_LAUNCH
    (void)hipMemsetAsync((char*)d_ws + WS_CTL + 16384, 0, 16384, stream);
    p.ph_lo = 0; p.ph_hi = NPHASE;
    void* args[] = {&p};
    hipError_t e = hipLaunchCooperativeKernel((const void*)fwd_kernel, dim3(grid), dim3(512), args, LDS_TOTAL, stream);
    if (e != hipSuccess) fprintf(stderr, "cooperative launch failed: %s (grid %d)\n", hipGetErrorString(e), grid);
#else
    for (int k = 0; k < NPHASE; ++k) { p.ph_lo = k; p.ph_hi = k + 1; hipLaunchKernelGGL(fwd_kernel, dim3(grid), dim3(512), LDS_TOTAL, stream, p); }
#endif
}
```

```cpp
#include <hip/hip_runtime.h>
#include <hip/hip_cooperative_groups.h>
#include <cstdio>
#include <cstdint>
namespace cg = cooperative_groups;

#define LAS __attribute__((address_space(3)))
typedef unsigned short bf16_t;
typedef short bf16x8 __attribute__((ext_vector_type(8)));
typedef short s16x4 __attribute__((ext_vector_type(4)));
typedef float f32x4 __attribute__((ext_vector_type(4)));
typedef float f32x16 __attribute__((ext_vector_type(16)));
typedef unsigned u32x4 __attribute__((ext_vector_type(4)));
typedef unsigned u32x2 __attribute__((ext_vector_type(2)));

constexpr int DM = 2048, SEQ = 8192, NB = 2, T = NB * SEQ, MEML = 256;
constexpr int MLA_IN = 1856, MLA_INP = 2048, QLORA = 768, KVLORA = 512, NHEAD = 12, QKD = 192, LRU_W = 1536, LRU_IN = 3584, DFF = 8192;
constexpr int QW = NHEAD * QKD  , KVW = NHEAD * 256  ;
constexpr float EPS = 1e-6f;
constexpr int NCHUNK = 128, CHL = 64;

constexpr size_t MiB = 1u << 20;
constexpr size_t WS_CTL = 0;
constexpr size_t WS_SS = 256 * 1024;
constexpr size_t WS_WIN0 = 1 * MiB;
constexpr size_t WS_WQUP = WS_WIN0 + 8 * MiB;
constexpr size_t WS_WKVUP = WS_WQUP + 3456 * 1024;
constexpr size_t WS_WOUT = WS_WKVUP + 3 * MiB;
constexpr size_t WS_WLRU = WS_WOUT + 16 * MiB;
constexpr size_t WS_WMKV = WS_WLRU + 14 * MiB;
constexpr size_t WS_WG = WS_WMKV + 4 * MiB;
constexpr size_t WS_MEMN = WS_WG + 1 * MiB;
constexpr size_t WS_MKV = WS_MEMN + 2 * MiB;
constexpr size_t WS_MEMK = WS_MKV + 2 * MiB;
constexpr size_t WS_MEMV = WS_MEMK + 512 * 1024;
constexpr size_t WS_ROPE = WS_MEMV + 512 * 1024;
constexpr size_t WS_CARRY = WS_ROPE + 4 * MiB;
constexpr size_t WS_A0 = 64 * MiB;
constexpr size_t WS_A1 = 128 * MiB;
constexpr size_t WS_S1 = 192 * MiB;
static_assert(WS_CARRY + 3 * MiB <= WS_A0, "ws map");
constexpr size_t WS_U = 256 * MiB;
constexpr size_t WS_END = 512 * MiB;
constexpr size_t U_PROJ0 = WS_U;
constexpr size_t U_KV = WS_U + 64 * MiB;
constexpr size_t U_K = WS_U + 160 * MiB;
constexpr size_t U_GATE = WS_U;
constexpr size_t U_XIN = WS_U + 48 * MiB;
constexpr size_t U_MQ = WS_U + 96 * MiB;
constexpr size_t U_XC = WS_U + 112 * MiB;
constexpr size_t U_A = WS_U + 160 * MiB;

__device__ __forceinline__ unsigned cvt_pk_bf16(float lo, float hi) { unsigned r; asm volatile("v_cvt_pk_bf16_f32 %0, %1, %2" : "=v"(r) : "v"(lo), "v"(hi)); return r; }
__device__ __forceinline__ float bflo(unsigned u) { return __uint_as_float(u << 16); }
__device__ __forceinline__ float bfhi(unsigned u) { return __uint_as_float(u & 0xffff0000u); }
__device__ __forceinline__ float bf1(bf16_t u) { return __uint_as_float(((unsigned)u) << 16); }
__device__ __forceinline__ bf16_t f2bf(float f) { return (bf16_t)(cvt_pk_bf16(f, 0.f) & 0xffffu); }
__device__ __forceinline__ float wave_sum(float v) {
#pragma unroll
    for (int o = 1; o < 64; o <<= 1) v += __shfl_xor(v, o);
    return v;
}
__device__ __forceinline__ float half_sum(float v) {
#pragma unroll
    for (int o = 1; o < 32; o <<= 1) v += __shfl_xor(v, o);
    return v;
}
__device__ __forceinline__ int my_tid() { int t = threadIdx.x; asm volatile("" : "+v"(t)); return t; }
__device__ __forceinline__ float sigmoidf_(float x) { return __builtin_amdgcn_rcpf(1.f + __expf(-x)); }

namespace pg8 {
constexpr int BM = 256, BK = 64, HALF = 128, HTB = HALF * BK * 2, STAGE_BYTES = 8 * HTB, NXCD = 8, WGM = 8;
__host__ __device__ __forceinline__ int lds_byte(int r, int c) { const int st = (r >> 4) * 2 + (c >> 5), rr = r & 15, cc = c & 31, ob = rr * 64 + cc * 2; return st * 1024 + (ob ^ (((ob >> 9) & 1) << 5)); }
__host__ __device__ __forceinline__ void stage_rc(int b, int& R, int& C) { const int st = b / 1024, sb = b % 1024, swz = sb ^ (((sb >> 9) & 1) << 5); R = (st >> 1) * 16 + swz / 64; C = (st & 1) * 32 + (swz % 64) / 2; }
__host__ __device__ __forceinline__ int perm32(int rho) { const int n = rho >> 4, i = rho & 15; return 8 * (i >> 2) + 4 * n + (i & 3); }
struct Unit { int pm, pn; };
struct Gemm { const bf16_t* A; const bf16_t* Bt; int M, N, K, lda, ldb, acol; };
struct StaticOrder {
    int nM, nN, nwg, G, c;
    __host__ __device__ void init(int M, int N, int G_, int c_) { nM = M / BM; nN = N / BM; nwg = nM * nN; G = G_; c = c_; }
    __host__ __device__ bool next(int i, Unit& u) const {
        const long L = (long)i * G + c; if (L >= nwg) return false;
        int wgid = (int)L; { const int q = nwg / NXCD, r = nwg % NXCD, xcd = wgid % NXCD, off = wgid / NXCD; wgid = (xcd < r ? xcd * (q + 1) : r * (q + 1) + (xcd - r) * q) + off; }
        const int nig = WGM * nN, gid = wgid / nig, fm = gid * WGM, gsz = (nM - fm) < WGM ? (nM - fm) : WGM;
        u.pm = fm + ((wgid % nig) % gsz); u.pn = (wgid % nig) / gsz; return true;
    }
};
template <class Epi, bool ALIGN_EPI>
__device__ __forceinline__ void gemm_phase(LAS unsigned char* lds, const Gemm g, const StaticOrder& S, const Epi& E) {
    const int tid = my_tid(), wid = __builtin_amdgcn_readfirstlane(tid >> 6), lane = tid & 63, wr = wid >> 2, wc = wid & 3, fr = lane & 15, fq = lane >> 4;
    const int nt = g.K / BK;
    unsigned voffA[2], voffB[2];
#pragma unroll
    for (int i = 0; i < 2; ++i) { int R, C; stage_rc(tid * 16 + i * 8192, R, C); const int Rb = Epi::PERM ? ((R & ~31) + perm32(R & 31)) : R;
        voffA[i] = (unsigned)(R * g.lda + C) * 2u; voffB[i] = (unsigned)(Rb * g.ldb + C) * 2u; }
    const size_t kstep = (size_t)(BK * 2);
    const size_t hA = (size_t)HALF * g.lda * 2, hB = (size_t)HALF * g.ldb * 2;
    const size_t tA = 2 * hA, tB = 2 * hB;
    const unsigned ldsw = (unsigned)wid * 1024u;
    const int aoff = lds_byte(wr * 64 + fr, fq * 8), boff = lds_byte(wc * 32 + fr, fq * 8);
#define PG8_SA(b, h) (((b) * 2 + (h)) * HTB)
#define PG8_SB(b, h) ((4 + (b) * 2 + (h)) * HTB)
#define PG8_STAGE(bufoff, gbase, voff) do { _Pragma("unroll") for (int _i = 0; _i < 2; ++_i) \
        __builtin_amdgcn_global_load_lds((const unsigned*)((const char*)(gbase) + (voff)[_i]), (LAS unsigned*)(lds + (bufoff) + ldsw + _i * 8192), 16, 0, 0); } while (0)
#define PG8_LDA(dst, b, h) do { _Pragma("unroll") for (int m = 0; m < 4; ++m) _Pragma("unroll") for (int k = 0; k < 2; ++k) dst[m][k] = *(const LAS bf16x8*)(lds + PG8_SA(b, h) + aoff + m * 2048 + k * 1024); } while (0)
#define PG8_LDB(dst, b, h) do { _Pragma("unroll") for (int n = 0; n < 2; ++n) _Pragma("unroll") for (int k = 0; k < 2; ++k) dst[n][k] = *(const LAS bf16x8*)(lds + PG8_SB(b, h) + boff + n * 2048 + k * 1024); } while (0)
#define PG8_MMA(ai, bj, At, Bt) do { __builtin_amdgcn_s_setprio(1); _Pragma("unroll") for (int m = 0; m < 4; ++m) _Pragma("unroll") for (int n = 0; n < 2; ++n) _Pragma("unroll") for (int k = 0; k < 2; ++k) \
        acc[ai][bj][m][n] = __builtin_amdgcn_mfma_f32_16x16x32_bf16(Bt[n][k], At[m][k], acc[ai][bj][m][n], 0, 0, 0); __builtin_amdgcn_s_setprio(0); } while (0)
#define PG8_WAIT_V(n) asm volatile("s_waitcnt vmcnt(" #n ")" ::: "memory")
#define PG8_WAIT_L(n) asm volatile("s_waitcnt lgkmcnt(" #n ")" ::: "memory")
#define PG8_BAR __builtin_amdgcn_s_barrier()
#define PG8_SCHED __builtin_amdgcn_sched_barrier(0)
    Unit cur, nxt; int ui = 0;
    if (!S.next(0, cur)) return;
    float rsv[8], rsn[8];
    E.pre(cur, wr, fr, rsv); E.post(0, rsv);
    f32x4 acc[2][2][4][2];
#pragma unroll
    for (int a = 0; a < 2; ++a)
#pragma unroll
        for (int b = 0; b < 2; ++b)
#pragma unroll
            for (int m = 0; m < 4; ++m)
#pragma unroll
                for (int n = 0; n < 2; ++n) acc[a][b][m][n] = (f32x4){0.f, 0.f, 0.f, 0.f};
    bf16x8 At[4][2], B0[2][2], B1[2][2];
    const char* cA = (const char*)g.A + (size_t)cur.pm * tA + (size_t)cur.pn * g.acol; const char* cB = (const char*)g.Bt + (size_t)cur.pn * tB;
    PG8_STAGE(PG8_SB(0, 0), cB, voffB); PG8_STAGE(PG8_SB(0, 1), cB + hB, voffB); PG8_STAGE(PG8_SA(0, 0), cA, voffA); PG8_STAGE(PG8_SA(0, 1), cA + hA, voffA);
    if (wr == 1) PG8_BAR;
    PG8_WAIT_V(2); PG8_BAR;
    PG8_STAGE(PG8_SB(1, 0), cB + kstep, voffB); PG8_STAGE(PG8_SA(1, 0), cA + kstep, voffA); PG8_STAGE(PG8_SB(1, 1), cB + hB + kstep, voffB);
    PG8_WAIT_V(6); PG8_BAR;
    for (;;) {
        const bool has_next = S.next(ui + 1, nxt);
        const char* nA = has_next ? (const char*)g.A + (size_t)nxt.pm * tA + (size_t)nxt.pn * g.acol : cA; const char* nB = has_next ? (const char*)g.Bt + (size_t)nxt.pn * tB : cB;
        for (int t = 0; t < nt; t += 2) {
            const bool last = (t == nt - 2);
            const char* a1 = cA + (size_t)(t + 1) * kstep;
            const char* a2 = last ? nA : cA + (size_t)(t + 2) * kstep; const char* b2 = last ? nB : cB + (size_t)(t + 2) * kstep;
            const char* a3 = a2 + kstep; const char* b3 = b2 + kstep;
            PG8_LDB(B0, 0, 0); PG8_LDB(B1, 0, 1); PG8_SCHED; PG8_LDA(At, 0, 0); PG8_STAGE(PG8_SA(1, 1), a1 + hA, voffA);
            PG8_WAIT_V(8); PG8_WAIT_L(0); PG8_BAR; PG8_MMA(0, 0, At, B0); PG8_MMA(0, 1, At, B1); PG8_BAR; PG8_SCHED;
            PG8_LDA(At, 0, 1); PG8_STAGE(PG8_SB(0, 0), b2, voffB); PG8_STAGE(PG8_SB(0, 1), b2 + hB, voffB); PG8_STAGE(PG8_SA(0, 0), a2, voffA);
            PG8_WAIT_V(8); PG8_WAIT_L(0); PG8_BAR; PG8_MMA(1, 0, At, B0); PG8_MMA(1, 1, At, B1); PG8_BAR; PG8_SCHED;
            PG8_LDB(B0, 1, 0); PG8_LDB(B1, 1, 1); PG8_SCHED; PG8_LDA(At, 1, 0); PG8_STAGE(PG8_SA(0, 1), a2 + hA, voffA);
            PG8_WAIT_V(8); PG8_WAIT_L(0); PG8_BAR; PG8_MMA(0, 0, At, B0); PG8_MMA(0, 1, At, B1); PG8_BAR; PG8_SCHED;
            PG8_LDA(At, 1, 1); PG8_STAGE(PG8_SB(1, 0), b3, voffB); PG8_STAGE(PG8_SB(1, 1), b3 + hB, voffB); PG8_STAGE(PG8_SA(1, 0), a3, voffA);
            PG8_WAIT_V(8); PG8_WAIT_L(0); PG8_BAR; PG8_MMA(1, 0, At, B0); PG8_MMA(1, 1, At, B1); PG8_BAR; PG8_SCHED;
        }
        if constexpr (ALIGN_EPI) { if (wr == 0) PG8_BAR; }
        if (has_next) E.pre(nxt, wr, fr, rsn);
        E(acc, cur, wr, wc, fr, fq, ui, rsv);
        if (!has_next) break;
        E.post(ui + 1, rsn);
#pragma unroll
        for (int a = 0; a < 2; ++a)
#pragma unroll
            for (int b = 0; b < 2; ++b)
#pragma unroll
                for (int m = 0; m < 4; ++m)
#pragma unroll
                    for (int n = 0; n < 2; ++n) acc[a][b][m][n] = (f32x4){0.f, 0.f, 0.f, 0.f};
        cur = nxt; cA = nA; cB = nB; ++ui;
#pragma unroll
        for (int i_ = 0; i_ < 8; ++i_) rsv[i_] = rsn[i_];
        if constexpr (ALIGN_EPI) { if (wr == 1) PG8_BAR; }
    }
    PG8_WAIT_V(0);
    if constexpr (!ALIGN_EPI) { if (wr == 0) PG8_BAR; }
    PG8_BAR;
#undef PG8_SA
#undef PG8_SB
#undef PG8_STAGE
#undef PG8_LDA
#undef PG8_LDB
#undef PG8_MMA
#undef PG8_WAIT_V
#undef PG8_WAIT_L
#undef PG8_BAR
#undef PG8_SCHED
}

template <int ACT> struct EpiBf16 {
    static constexpr bool PERM = true;
    bf16_t* O0; bf16_t* O1; bf16_t* O2; int ld0, ld1, ld2, pn1, pn2; const float* ss;
    __device__ __forceinline__ void pre(const Unit& u, int wr, int fr, float (&rsv)[8]) const {
        const int row0 = u.pm * BM + wr * 64 + fr;
#pragma unroll
        for (int i = 0; i < 8; ++i) rsv[i] = ss ? ss[row0 + (i >> 2) * HALF + (i & 3) * 16] : 0.f;
    }
    __device__ __forceinline__ void post(int, const float (&)[8]) const {}
    __device__ __forceinline__ void operator()(const f32x4 (&acc)[2][2][4][2], const Unit& u, int wr, int wc, int fr, int fq, int, const float (&rsv_)[8]) const {
        bf16_t* base; int ldc, pnl; bool act2 = false;
        if (u.pn < pn1) { base = O0; ldc = ld0; pnl = u.pn; act2 = true; } else if (u.pn < pn2) { base = O1; ldc = ld1; pnl = u.pn - pn1; } else { base = O2; ldc = ld2; pnl = u.pn - pn2; }
        const int row0 = u.pm * BM + wr * 64 + fr; const int col0 = pnl * BM + wc * 32 + 8 * fq;
        float rsv[2][4];
#pragma unroll
        for (int ai = 0; ai < 2; ++ai)
#pragma unroll
            for (int m = 0; m < 4; ++m) rsv[ai][m] = ss ? rsqrtf(rsv_[ai * 4 + m] * (1.f / 2048.f) + EPS) : 1.f;
#pragma unroll
        for (int ai = 0; ai < 2; ++ai)
#pragma unroll
            for (int m = 0; m < 4; ++m) { bf16_t* rowp = base + (size_t)(row0 + ai * HALF + m * 16) * ldc + col0;
                const float rs = rsv[ai][m];
#pragma unroll
                for (int bj = 0; bj < 2; ++bj) { f32x4 v0 = acc[ai][bj][m][0] * rs, v1 = acc[ai][bj][m][1] * rs;
                    if (ACT == 1) {
#pragma unroll
                        for (int j = 0; j < 4; ++j) { const float a = fmaxf(v0[j], 0.f), b = fmaxf(v1[j], 0.f); v0[j] = a * a; v1[j] = b * b; } }
                    if (ACT == 2) { if (act2) {
#pragma unroll
                        for (int j = 0; j < 4; ++j) { float x = v0[j]; float z = 0.7978845608028654f * (x + 0.044715f * x * x * x); v0[j] = x / (1.f + __expf(-2.f * z));
                                                      x = v1[j]; z = 0.7978845608028654f * (x + 0.044715f * x * x * x); v1[j] = x / (1.f + __expf(-2.f * z)); } } }
                    u32x4 w; w.x = cvt_pk_bf16(v0[0], v0[1]); w.y = cvt_pk_bf16(v0[2], v0[3]); w.z = cvt_pk_bf16(v1[0], v1[1]); w.w = cvt_pk_bf16(v1[2], v1[3]);
                    { u32x4* dp_ = (u32x4*)(rowp + bj * HALF); asm volatile("global_store_dwordx4 %0, %1, off sc1\n\ts_nop 1" :: "v"(dp_), "v"(w) : "memory"); } } }
    }
};
struct EpiRes {
    static constexpr bool PERM = true;
    const float* basef; const bf16_t* baseb; float* outf; bf16_t* outb; float* ss; int ldc;
    __device__ __forceinline__ void pre(const Unit&, int, int, float (&)[8]) const {}
    __device__ __forceinline__ void post(int, const float (&)[8]) const {}
    __device__ __forceinline__ void operator()(const f32x4 (&acc)[2][2][4][2], const Unit& u, int wr, int wc, int fr, int fq, int, const float (&)[8]) const {
        const int col0 = u.pn * BM + wc * 32 + 8 * fq; const int row0 = u.pm * BM + wr * 64 + fr;
        float part[2][4];
        f32x4 c0[2], c1[2], n0[2], n1[2];
#define ER_LOAD(d0_, d1_, aim_) do { _Pragma("unroll") for (int bj = 0; bj < 2; ++bj) { const size_t off_ = (size_t)(row0 + ((aim_) >> 2) * HALF + ((aim_) & 3) * 16) * ldc + col0 + bj * HALF; \
            if (basef) { d0_[bj] = *(const f32x4*)(basef + off_); d1_[bj] = *(const f32x4*)(basef + off_ + 4); } \
            else if (baseb) { const u32x4 bw = *(const u32x4*)(baseb + off_); d0_[bj] = (f32x4){bflo(bw.x), bfhi(bw.x), bflo(bw.y), bfhi(bw.y)}; d1_[bj] = (f32x4){bflo(bw.z), bfhi(bw.z), bflo(bw.w), bfhi(bw.w)}; } \
            else { d0_[bj] = (f32x4){0.f, 0.f, 0.f, 0.f}; d1_[bj] = (f32x4){0.f, 0.f, 0.f, 0.f}; } } } while (0)
        ER_LOAD(c0, c1, 0);
#pragma unroll
        for (int aim = 0; aim < 8; ++aim) { const int ai = aim >> 2, m = aim & 3;
            if (aim < 7) ER_LOAD(n0, n1, aim + 1);
            asm volatile("" ::: "memory");
            float pp = 0.f;
#pragma unroll
            for (int bj = 0; bj < 2; ++bj) { const size_t off = (size_t)(row0 + ai * HALF + m * 16) * ldc + col0 + bj * HALF;
                const f32x4 v0 = acc[ai][bj][m][0] + c0[bj], v1 = acc[ai][bj][m][1] + c1[bj];
                if (outf) { *(f32x4*)(outf + off) = v0; *(f32x4*)(outf + off + 4) = v1; }
                if (outb) { u32x4 w; w.x = cvt_pk_bf16(v0[0], v0[1]); w.y = cvt_pk_bf16(v0[2], v0[3]); w.z = cvt_pk_bf16(v1[0], v1[1]); w.w = cvt_pk_bf16(v1[2], v1[3]); *(u32x4*)(outb + off) = w; }
                pp += (v0[0] * v0[0] + v0[1] * v0[1]) + (v0[2] * v0[2] + v0[3] * v0[3]) + (v1[0] * v1[0] + v1[1] * v1[1]) + (v1[2] * v1[2] + v1[3] * v1[3]); }
            part[ai][m] = pp;
            asm volatile("" ::: "memory");
#pragma unroll
            for (int bj = 0; bj < 2; ++bj) { c0[bj] = n0[bj]; c1[bj] = n1[bj]; } }
#undef ER_LOAD
        if (ss) {
#pragma unroll
            for (int ai = 0; ai < 2; ++ai)
#pragma unroll
                for (int m = 0; m < 4; ++m) { float pp = part[ai][m]; pp += __shfl_xor(pp, 16); pp += __shfl_xor(pp, 32); if (fq == 0) unsafeAtomicAdd(ss + row0 + ai * HALF + m * 16, pp); } }
    }
};
struct EpiGates {
    static constexpr bool PERM = false;
    const float* ba; const float* bi; const float* cl; bf16_t* Aout; bf16_t* Bout; LAS float* cbuf;
    __device__ __forceinline__ void pre(const Unit& u, int, int, float (&r)[8]) const { const int t = my_tid();
        unsigned long long p0 = (unsigned long long)cl, p1 = (unsigned long long)ba, p2 = (unsigned long long)bi;
        asm volatile("" : "+s"(p0), "+s"(p1), "+s"(p2));
        const unsigned long long ps = t < 128 ? p0 : (t < 256 ? p1 : p2); const float v = ((const float*)ps)[u.pn * 128 + (t & 127)];
#pragma unroll
        for (int i = 0; i < 8; ++i) r[i] = v; }
    __device__ __forceinline__ void post(int ui, const float (&r)[8]) const { const int t = my_tid(); if (t < 384) cbuf[(ui & 1) * 384 + t] = r[0]; }
    __device__ __forceinline__ void operator()(const f32x4 (&acc)[2][2][4][2], const Unit& u, int wr, int wc, int fr, int fq, int ui, const float (&)[8]) const {
        const int cc = wc * 32 + 4 * fq; const int ch0 = u.pn * 128 + cc; const int row0 = u.pm * BM + wr * 64 + fr; const LAS float* cb = cbuf + (ui & 1) * 384 + cc;
#pragma unroll
        for (int ai = 0; ai < 2; ++ai)
#pragma unroll
            for (int m = 0; m < 4; ++m) { const size_t off = (size_t)(row0 + ai * HALF + m * 16) * LRU_W + ch0;
#pragma unroll
                for (int n = 0; n < 2; ++n) { const f32x4 vcl = *(const LAS f32x4*)(cb + n * 16), vba = *(const LAS f32x4*)(cb + 128 + n * 16), vbi = *(const LAS f32x4*)(cb + 256 + n * 16);
                    const f32x4 va = acc[ai][0][m][n] + vba, vi = acc[ai][1][m][n] + vbi;
                    float a4[4]; float b4[4];
#pragma unroll
                    for (int j = 0; j < 4; ++j) { const float r = sigmoidf_(va[j]), ig = sigmoidf_(vi[j]); const float la = vcl[j] * r; a4[j] = 1.f - __expf(la); b4[j] = __builtin_amdgcn_sqrtf(a4[j] * (2.f - a4[j])) * ig; }
                    { u32x2 aw; aw.x = cvt_pk_bf16(a4[0], a4[1]); aw.y = cvt_pk_bf16(a4[2], a4[3]); *(u32x2*)(Aout + off + n * 16) = aw; }
                    u32x2 bw; bw.x = cvt_pk_bf16(b4[0], b4[1]); bw.y = cvt_pk_bf16(b4[2], b4[3]); *(u32x2*)(Bout + off + n * 16) = bw;
                    __builtin_amdgcn_sched_barrier(0); } }
    }
};
}

namespace att {
constexpr int NW = 8, QBLK = 32, KVBLK = 64, QB = 256;
constexpr int SHM_V = 16384, SHM_KN = 16384, SHM_KR = 8192, SHM_K = SHM_KN + SHM_KR;
constexpr int OFF_K = 3 * SHM_V, OFF_WS = OFF_K + 2 * SHM_K, OFF_QR = OFF_WS + NW * 64 * 4, LDS_BYTES = OFF_QR + NW * 4096;
constexpr float THR = 8.f;
#define KSWZF(row) ((((row) & 3) << 2) | (((row) >> 2) & 3))
#define KSWZ(row, colB) ((row) * 256 + ((colB) ^ (KSWZF(row) << 4)))
#define KRSWZ(row, colB) (SHM_KN + (row) * 128 + ((colB) ^ ((((row) >> 1) & 7) << 4)))
#define SBAR() __builtin_amdgcn_sched_barrier(0)
__device__ __forceinline__ int v_st(int k, int c) { const int kk = (k & ~0xC) | ((k & 4) << 1) | ((k & 8) >> 1); return ((kk >> 3) * 4 + (c >> 5)) * 512 + ((kk & 7) * 32 + (c & 31)) * 2; }
__device__ __forceinline__ int v_rd_base(int lane) { return ((lane & 3) << 3) | (((lane >> 2) & 3) << 6) | (((lane >> 4) & 1) << 5) | (((lane >> 5) & 1) << 8); }
constexpr int v_rd_off(int d0, int ks, int half) { return d0 * 512 + ks * 4096 + half * 2048; }
__device__ __forceinline__ int crow(int r, int hi) { return (r & 3) + 8 * (r >> 2) + 4 * hi; }
__device__ __forceinline__ void mask_tile(f32x16& p0, f32x16& p1, int dq) {
    const float NEG = -__builtin_inff();
#pragma unroll
    for (int r = 0; r < 16; ++r) { const int c = (r & 3) + 8 * (r >> 2); if (dq - c < 0) p0[r] = NEG; if (dq - c - 32 < 0) p1[r] = NEG; }
}
__device__ __forceinline__ void partialSM(f32x16& p0, f32x16& p1, float& m_reg, float& mn, float& alpha, float SCALE, float C2) {
    float pmax = p0[0];
#pragma unroll
    for (int r = 1; r < 16; ++r) pmax = fmaxf(pmax, p0[r]);
#pragma unroll
    for (int r = 0; r < 16; ++r) pmax = fmaxf(pmax, p1[r]);
    { auto rr = __builtin_amdgcn_permlane32_swap(__float_as_uint(pmax), __float_as_uint(pmax), false, false); pmax = fmaxf(__uint_as_float(rr[0]), __uint_as_float(rr[1])); }
    if (__builtin_expect(__all((pmax - m_reg) * SCALE <= THR), 1)) { mn = m_reg; alpha = 1.f; }
    else { mn = fmaxf(m_reg, pmax); alpha = __builtin_amdgcn_exp2f((m_reg - mn) * C2); m_reg = mn; }
    const float mnL = -mn * C2;
#pragma unroll
    for (int r = 0; r < 16; ++r) p0[r] = fmaf(p0[r], C2, mnL);
#pragma unroll
    for (int r = 0; r < 16; ++r) p1[r] = fmaf(p1[r], C2, mnL);
#pragma unroll
    for (int r = 0; r < 16; ++r) p0[r] = __builtin_amdgcn_exp2f(p0[r]);
}
__device__ __forceinline__ void finishSM(f32x16& p0, f32x16& p1, float alpha, float& l_reg, bf16x8& pa0, bf16x8& pa1, bf16x8& pa2, bf16x8& pa3) {
#pragma unroll
    for (int r = 0; r < 16; ++r) p1[r] = __builtin_amdgcn_exp2f(p1[r]);
    float ps = 0;
#pragma unroll
    for (int r = 0; r < 16; ++r) ps += p0[r];
#pragma unroll
    for (int r = 0; r < 16; ++r) ps += p1[r];
    { auto rr = __builtin_amdgcn_permlane32_swap(__float_as_uint(ps), __float_as_uint(ps), false, false); ps = __uint_as_float(rr[0]) + __uint_as_float(rr[1]); }
    l_reg = l_reg * alpha + ps;
#define PK4(P, B_, OUT) do { unsigned a0 = cvt_pk_bf16(P[B_+0], P[B_+1]), a1 = cvt_pk_bf16(P[B_+2], P[B_+3]);                          \
        unsigned b0 = cvt_pk_bf16(P[B_+4], P[B_+5]), b1 = cvt_pk_bf16(P[B_+6], P[B_+7]);                                             \
        auto r0 = __builtin_amdgcn_permlane32_swap(a0, b0, false, false); auto r1 = __builtin_amdgcn_permlane32_swap(a1, b1, false, false); \
        u32x4 w = {r0[0], r1[0], r0[1], r1[1]}; OUT = __builtin_bit_cast(bf16x8, w); } while (0)
    PK4(p0, 0, pa0); PK4(p0, 8, pa1); PK4(p1, 0, pa2); PK4(p1, 8, pa3);
#undef PK4
}
template <int DQ>
__device__ __forceinline__ void qkt(f32x16& p0, f32x16& p1, const LAS char* Kt, int r32, int hi, const bf16x8* qr, const LAS char* qrl) {
    constexpr int ND = DQ / 16, PF = 6;
    p0 = f32x16{}; p1 = f32x16{};
    const LAS char* kb[4]; const LAS char* kr[4];
#pragma unroll
    for (int dd = 0; dd < 4; ++dd) { kb[dd] = Kt + KSWZ(r32, (dd * 16 + hi * 8) * 2); kr[dd] = Kt + KRSWZ(r32, (dd * 16 + hi * 8) * 2); }
    const int koff = (r32 & 2) ? -128 : 128;
#define RDK(d, half) (*reinterpret_cast<const LAS bf16x8*>((d) < 8 ? kb[(d) & 3] + ((d) >> 2) * koff + (half) * 32 * 256 : kr[((d) - 8) & 3] + (half) * 32 * 128))
    bf16x8 k0[PF], k1[PF], qf[4];
    if constexpr (DQ == 192) {
#pragma unroll
        for (int dd = 0; dd < 4; ++dd) qf[dd] = *reinterpret_cast<const LAS bf16x8*>(qrl + dd * 1024);
    }
#pragma unroll
    for (int d = 0; d < PF; ++d) { k0[d] = RDK(d, 0); k1[d] = RDK(d, 1); }
    SBAR();
#pragma unroll
    for (int d = 0; d < ND; ++d) { const bf16x8 q = d < 8 ? qr[d & 7] : qf[(d - 8) & 3];
        p0 = __builtin_amdgcn_mfma_f32_32x32x16_bf16(k0[d % PF], q, p0, 0, 0, 0);
        p1 = __builtin_amdgcn_mfma_f32_32x32x16_bf16(k1[d % PF], q, p1, 0, 0, 0);
        if (d + PF < ND) { k0[d % PF] = RDK(d + PF, 0); k1[d % PF] = RDK(d + PF, 1); }
        SBAR(); }
#undef RDK
}
__device__ __forceinline__ void pv_tile(f32x16* o, int vb, bf16x8 pa0, bf16x8 pa1, bf16x8 pa2, bf16x8 pa3) {
#define TRRD(dst, off) asm volatile("ds_read_b64_tr_b16 %0, %1 offset:%2" : "=&v"(dst) : "v"(vb), "i"(off) : "memory")
#define RD8(L, H, d0) do { constexpr int b_ = v_rd_off(d0, 0, 0); TRRD(L[0], b_); TRRD(H[0], b_ + 2048); TRRD(L[1], b_ + 4096); TRRD(H[1], b_ + 6144); TRRD(L[2], b_ + 8192); TRRD(H[2], b_ + 10240); TRRD(L[3], b_ + 12288); TRRD(H[3], b_ + 14336); } while (0)
#define MM4(L, H, d0) do { \
        o[d0] = __builtin_amdgcn_mfma_f32_32x32x16_bf16(pa0, (bf16x8){L[0][0], L[0][1], L[0][2], L[0][3], H[0][0], H[0][1], H[0][2], H[0][3]}, o[d0], 0, 0, 0);   \
        o[d0] = __builtin_amdgcn_mfma_f32_32x32x16_bf16(pa1, (bf16x8){L[1][0], L[1][1], L[1][2], L[1][3], H[1][0], H[1][1], H[1][2], H[1][3]}, o[d0], 0, 0, 0);   \
        o[d0] = __builtin_amdgcn_mfma_f32_32x32x16_bf16(pa2, (bf16x8){L[2][0], L[2][1], L[2][2], L[2][3], H[2][0], H[2][1], H[2][2], H[2][3]}, o[d0], 0, 0, 0);   \
        o[d0] = __builtin_amdgcn_mfma_f32_32x32x16_bf16(pa3, (bf16x8){L[3][0], L[3][1], L[3][2], L[3][3], H[3][0], H[3][1], H[3][2], H[3][3]}, o[d0], 0, 0, 0); } while (0)
    s16x4 la[4], ha[4], lb[4], hb[4];
    RD8(la, ha, 0); RD8(lb, hb, 1);
    asm volatile("s_waitcnt lgkmcnt(8)" ::: "memory"); SBAR(); MM4(la, ha, 0); SBAR();
    RD8(la, ha, 2);
    asm volatile("s_waitcnt lgkmcnt(8)" ::: "memory"); SBAR(); MM4(lb, hb, 1); SBAR();
    RD8(lb, hb, 3);
    asm volatile("s_waitcnt lgkmcnt(8)" ::: "memory"); SBAR(); MM4(la, ha, 2); SBAR();
    asm volatile("s_waitcnt lgkmcnt(0)" ::: "memory"); SBAR(); MM4(lb, hb, 3);
#undef MM4
#undef RD8
#undef TRRD
}

template <int DQ, bool CAUSAL>
__device__ __forceinline__ void attn_block(const bf16_t* Q, int ldq, const bf16_t* Kh, int ldk, const bf16_t* Vh, int ldv, bf16_t* O, int ldo, int P0, int NT, float SCALE, LAS char* lds) {
    const float C2 = 1.4426950408889634f * SCALE;
    const int tid = my_tid(), wid = __builtin_amdgcn_readfirstlane(tid >> 6), lane = tid & 63, r32 = lane & 31, hi = lane >> 5;
    const int qlo = P0 + wid * QBLK, qm = qlo + r32 - 4 * hi;
    LAS char* V_lds = lds; LAS char* K_lds = lds + OFF_K;
    LAS float* ws = (LAS float*)(lds + OFF_WS) + wid * 64; LAS float* li_l = ws; LAS float* al_l = ws + 32;
    float m_reg = -1e30f, l_reg = 0; f32x16 o[4] = {};
    const int krow = 4 * wid + (lane >> 4);
    const unsigned goffK = (unsigned)krow * (unsigned)ldk + (unsigned)(((lane & 15) ^ KSWZF(krow)) * 8);
    const int rrow = 8 * wid + (lane >> 3);
    const unsigned goffR = (unsigned)rrow * (unsigned)ldk + 128u + (unsigned)(((lane & 7) ^ ((rrow >> 1) & 7)) * 8);
    const int vsub = 2 * wid + (lane >> 5), vkk = (vsub >> 2) * 8 + ((lane & 31) >> 2), vk = (vkk & ~0xC) | ((vkk & 4) << 1) | ((vkk & 8) >> 1);
    const unsigned goffV = (unsigned)vk * (unsigned)ldv + (unsigned)((vsub & 3) * 32 + (lane & 3) * 8);
    const int vb0 = (int)(uintptr_t)V_lds + v_rd_base(lane);
#define GLDS(gp, lp) __builtin_amdgcn_global_load_lds((const unsigned*)(gp), (LAS unsigned*)(lp), 16, 0, 0)
#define DMA_K(t, kslot) do { const bf16_t* kt_ = Kh + (size_t)(t) * KVBLK * ldk; LAS char* kd_ = K_lds + (kslot) * SHM_K + wid * 1024; \
        GLDS(kt_ + goffK, kd_); GLDS(kt_ + goffK + (size_t)32 * ldk, kd_ + 8192); \
        if constexpr (DQ == 192) GLDS(kt_ + goffR, kd_ + SHM_KN); } while (0)
#define DMA_V(t, vslot) do { const bf16_t* vt_ = Vh + (size_t)(t) * KVBLK * ldv; LAS char* vd_ = V_lds + (vslot) * SHM_V + wid * 1024; \
        GLDS(vt_ + goffV, vd_); GLDS(vt_ + goffV + (size_t)32 * ldv, vd_ + 8192); } while (0)
#define DMA_TILE(t, kslot, vslot) do { DMA_K(t, kslot); DMA_V(t, vslot); } while (0)
#define RESC(a) do { if (__any((a) < 1.f)) { if (hi == 0) al_l[r32] = (a); asm volatile("s_waitcnt lgkmcnt(0)" ::: "memory");              \
                     _Pragma("unroll") for (int d_ = 0; d_ < 4; ++d_) _Pragma("unroll") for (int r = 0; r < 16; ++r) o[d_][r] *= al_l[crow(r, hi)]; } } while (0)
#define KBASE(t) ((t) * KVBLK)
#define MASKT(P0_, P1_, t) do { if constexpr (CAUSAL) { const int kb_ = KBASE(t); if (kb_ + KVBLK - 1 > qlo) mask_tile(P0_, P1_, qm - kb_); } } while (0)
    DMA_TILE(0, 0, 0);
    bf16x8 qr[8];
#pragma unroll
    for (int d0 = 0; d0 < 8; ++d0) qr[d0] = *(const bf16x8*)(Q + (size_t)(wid * QBLK + r32) * ldq + d0 * 16 + hi * 8);
    LAS char* qrl = lds + OFF_QR + wid * 4096 + lane * 16;
    if constexpr (DQ == 192) {
#pragma unroll
        for (int dd = 0; dd < 4; ++dd) *(LAS bf16x8*)(qrl + dd * 1024) = *(const bf16x8*)(Q + (size_t)(wid * QBLK + r32) * ldq + (8 + dd) * 16 + hi * 8);
    }
    __syncthreads();
    int vs_cur = 0, vs_next = 1;
#pragma unroll 1
    for (int t = 0; t < NT; ++t) {
        if (t + 1 < NT) DMA_K(t + 1, (t + 1) & 1);
        f32x16 p0, p1; float mn, al; bf16x8 pa0, pa1, pa2, pa3;
        SBAR(); qkt<DQ>(p0, p1, K_lds + (t & 1) * SHM_K, r32, hi, qr, qrl);
        MASKT(p0, p1, t); partialSM(p0, p1, m_reg, mn, al, SCALE, C2);
        RESC(al);
        SBAR(); if (t + 1 < NT) DMA_V(t + 1, vs_next);
        SBAR();
        finishSM(p0, p1, al, l_reg, pa0, pa1, pa2, pa3); SBAR();
        pv_tile(o, vb0 + vs_cur * SHM_V, pa0, pa1, pa2, pa3);
        __syncthreads();
        { const int t_ = vs_cur; vs_cur = vs_next; vs_next = t_; }
    }
    SBAR();
    if (hi == 0) li_l[r32] = l_reg; asm volatile("s_waitcnt lgkmcnt(0)" ::: "memory");
    float rli[16];
#pragma unroll
    for (int r = 0; r < 16; ++r) rli[r] = __builtin_amdgcn_rcpf(li_l[crow(r, hi)]);
    { LAS bf16_t* stg = (LAS bf16_t*)(lds + wid * 8192);
#pragma unroll
      for (int r = 0; r < 16; ++r) { const int orow = crow(r, hi);
#pragma unroll
          for (int d0 = 0; d0 < 4; ++d0) stg[orow * 128 + d0 * 32 + r32] = f2bf(o[d0][r] * rli[r]); }
      asm volatile("s_waitcnt lgkmcnt(0)" ::: "memory");
      bf16_t* Ow = O + (size_t)(wid * QBLK) * ldo;
#pragma unroll
      for (int i = 0; i < 8; ++i) { const int c = i * 64 + lane, row = c >> 4, ch = c & 15;
          const u32x4 v = *(const LAS u32x4*)(stg + row * 128 + ch * 8);
          *(u32x4*)(Ow + (size_t)row * ldo + ch * 8) = v; } }
    __syncthreads();
#undef GLDS
#undef DMA_TILE
#undef DMA_K
#undef DMA_V
#undef RESC
#undef KBASE
#undef MASKT
#undef HALF_STEP
}
}

struct Params {
    const float* x; const float* mem; const int* pos;
    const float *mix_norm, *mlp_norm, *w_out, *w_mlp_in, *w_mlp_out, *mem_norm, *w_mem_kv, *mem_k_norm, *mem_q_norm, *w_in_mla, *q_lat_norm, *w_q_up, *kv_lat_norm, *w_kv_up,
        *q_norm, *k_norm, *w_in_lru, *conv_w, *conv_b, *w_gate_a, *b_gate_a, *w_gate_i, *b_gate_i, *lru_lambda;
    float* out; unsigned char* ws; int ph_lo, ph_hi;
};
constexpr int LDS_MISC = 135168, LDS_TOTAL = LDS_MISC + 256 + 3072;
constexpr int NPHASE = 20;

constexpr int TR_STRIDE = 65, TR_SCR_BYTES = 64 * TR_STRIDE * 4;
struct TrSel { const float* W; bf16_t* WT; const float* gain; int N, ldt; };
__device__ __forceinline__ void tr_load(const TrSel& t, int lane, f32x4 (&v)[16], float (&g)[16]) {
#pragma unroll
    for (int i = 0; i < 16; ++i) { v[i] = *(const f32x4*)(t.W + (size_t)(4 * i + (lane >> 4)) * t.N + (lane & 15) * 4); g[i] = t.gain ? t.gain[4 * i + (lane >> 4)] : 1.f; }
}
__device__ __forceinline__ void tr_store(const TrSel& t, const f32x4 (&v)[16], const float (&g)[16], LAS float* scr, int lane) {
#pragma unroll
    for (int i = 0; i < 16; ++i) { const int kk = 4 * i + (lane >> 4); LAS float* d = scr + kk * TR_STRIDE + (lane & 15) * 4;
        d[0] = v[i].x * g[i]; d[1] = v[i].y * g[i]; d[2] = v[i].z * g[i]; d[3] = v[i].w * g[i]; }
    asm volatile("s_waitcnt lgkmcnt(0)" ::: "memory");
    const int c = lane & 7;
#pragma unroll
    for (int j = 0; j < 8; ++j) { const int n = (lane >> 3) + 8 * j; const LAS float* sp = scr + (8 * c) * TR_STRIDE + n;
        u32x4 o; o.x = cvt_pk_bf16(sp[0 * TR_STRIDE], sp[1 * TR_STRIDE]); o.y = cvt_pk_bf16(sp[2 * TR_STRIDE], sp[3 * TR_STRIDE]); o.z = cvt_pk_bf16(sp[4 * TR_STRIDE], sp[5 * TR_STRIDE]); o.w = cvt_pk_bf16(sp[6 * TR_STRIDE], sp[7 * TR_STRIDE]);
        *(u32x4*)(t.WT + (size_t)n * t.ldt + 8 * c) = o; }
    asm volatile("s_waitcnt lgkmcnt(0)" ::: "memory");
}
__device__ __forceinline__ bool tr_job(int& r, const float* W, int K, int N, bf16_t* WT, const float* gain, TrSel& t) {
    const int nblk = N / 64, items = (K / 64) * nblk;
    if (r >= items) { r -= items; return false; }
    const int kb = r / nblk, nb = r % nblk;
    t.W = W + (size_t)(64 * kb) * N + 64 * nb; t.N = N; t.WT = WT + (size_t)(64 * nb) * K + 64 * kb; t.ldt = K; t.gain = gain ? gain + 64 * kb : nullptr;
    return true;
}
__device__ __forceinline__ bool tr_gate_job(int& r, const float* W, int row_off, bf16_t* WT, TrSel& t) {
    const int items = 12 * 2 * 2;
    if (r >= items) { r -= items; return false; }
    const int blk = r / 4, kb = (r % 4) / 2, nb = r % 2;
    t.W = W + (size_t)blk * 16384 + (size_t)(64 * kb) * 128 + 64 * nb; t.N = 128; t.WT = WT + (size_t)blk * 32768 + (size_t)(row_off + 64 * nb) * 128 + 64 * kb; t.ldt = 128; t.gain = nullptr;
    return true;
}
__device__ __forceinline__ void cvt_rows(const float* X, bf16_t* out, float* ss, int rows, int gw, int NGW, int lane) {
    f32x4 v[8], nv[8]; int m = gw;
    if (m < rows) {
#pragma unroll
        for (int j = 0; j < 8; ++j) v[j] = ((const f32x4*)(X + (size_t)m * DM) + lane)[64 * j]; }
    for (; m < rows; m += NGW) {
        if (m + NGW < rows) {
#pragma unroll
            for (int j = 0; j < 8; ++j) nv[j] = ((const f32x4*)(X + (size_t)(m + NGW) * DM) + lane)[64 * j]; }
        asm volatile("" ::: "memory");
        float s = 0.f;
#pragma unroll
        for (int j = 0; j < 8; ++j) s += (v[j].x * v[j].x + v[j].y * v[j].y) + (v[j].z * v[j].z + v[j].w * v[j].w);
        s = wave_sum(s); if (lane == 0) ss[m] = s;
        u32x2* o8 = (u32x2*)(out + (size_t)m * DM) + lane;
#pragma unroll
        for (int j = 0; j < 8; ++j) { u32x2 w; w.x = cvt_pk_bf16(v[j].x, v[j].y); w.y = cvt_pk_bf16(v[j].z, v[j].w); o8[64 * j] = w; }
        asm volatile("" ::: "memory");
#pragma unroll
        for (int j = 0; j < 8; ++j) v[j] = nv[j];
    }
}

__device__ __forceinline__ void norm_rows(const float* X, const float* g, bf16_t* out, int rows, int gw, int NGW, int lane) {
    f32x4 gv[8];
#pragma unroll
    for (int j = 0; j < 8; ++j) gv[j] = ((const f32x4*)g)[lane + 64 * j];
    for (int m = gw; m < rows; m += NGW) {
        const f32x4* xr = (const f32x4*)(X + (size_t)m * DM) + lane; f32x4 v[8]; float s = 0.f;
#pragma unroll
        for (int j = 0; j < 8; ++j) { v[j] = xr[64 * j]; s += (v[j].x * v[j].x + v[j].y * v[j].y) + (v[j].z * v[j].z + v[j].w * v[j].w); }
        const float rstd = rsqrtf(wave_sum(s) * (1.f / DM) + EPS);
        u32x2* o8 = (u32x2*)(out + (size_t)m * DM) + lane;
#pragma unroll
        for (int j = 0; j < 8; ++j) { u32x2 w; w.x = cvt_pk_bf16(v[j].x * rstd * gv[j].x, v[j].y * rstd * gv[j].y); w.y = cvt_pk_bf16(v[j].z * rstd * gv[j].z, v[j].w * rstd * gv[j].w); o8[64 * j] = w; }
    }
}
template <int NJ, bool HEADS>
__device__ __forceinline__ void seg_norm(bf16_t* seg, const float* g, int n, int lane) {
    u32x2 w[NJ]; float s[NJ]; float tot = 0.f;
#pragma unroll
    for (int j = 0; j < NJ; ++j) { w[j] = ((const u32x2*)seg)[lane + 64 * j]; const float a = bflo(w[j].x), b = bfhi(w[j].x), c = bflo(w[j].y), d = bfhi(w[j].y); s[j] = (a * a + b * b) + (c * c + d * d); tot += s[j]; }
    float rs[NJ];
    if (HEADS) {
#pragma unroll
        for (int j = 0; j < NJ; ++j) rs[j] = rsqrtf(half_sum(s[j]) * (1.f / 128.f) + EPS);
    } else { const float r = rsqrtf(wave_sum(tot) / (float)n + EPS);
#pragma unroll
        for (int j = 0; j < NJ; ++j) rs[j] = r; }
#pragma unroll
    for (int j = 0; j < NJ; ++j) { const int gi = HEADS ? ((lane & 31) * 4) : (lane + 64 * j) * 4; const f32x4 gv = *(const f32x4*)(g + gi);
        u32x2 o; o.x = cvt_pk_bf16(bflo(w[j].x) * rs[j] * gv.x, bfhi(w[j].x) * rs[j] * gv.y); o.y = cvt_pk_bf16(bflo(w[j].y) * rs[j] * gv.z, bfhi(w[j].y) * rs[j] * gv.w);
        ((u32x2*)seg)[lane + 64 * j] = o; }
}

__device__ __forceinline__ u32x4 qk_head(u32x4 w, const float (&g)[8], bool r1, bool r2, int partner, const float (&cs)[8], const float (&sn)[8]) {
    float x[8] = {bflo(w.x), bfhi(w.x), bflo(w.y), bfhi(w.y), bflo(w.z), bfhi(w.z), bflo(w.w), bfhi(w.w)};
    float ss = 0.f;
#pragma unroll
    for (int j = 0; j < 8; ++j) ss += x[j] * x[j];
    const float rstd = rsqrtf(half_sum(ss) * (1.f / 192.f) + EPS);
#pragma unroll
    for (int j = 0; j < 8; ++j) x[j] = x[j] * rstd * g[j];
#pragma unroll
    for (int j = 0; j < 8; ++j) { const float pj = __shfl(x[j], partner); if (r1) x[j] = x[j] * cs[j] - pj * sn[j]; else if (r2) x[j] = x[j] * cs[j] + pj * sn[j]; }
    u32x4 o; o.x = cvt_pk_bf16(x[0], x[1]); o.y = cvt_pk_bf16(x[2], x[3]); o.z = cvt_pk_bf16(x[4], x[5]); o.w = cvt_pk_bf16(x[6], x[7]);
    return o;
}

#define XB_TMO      128
#define XB_XCNT(j)  (256  + 64 * (j))
#define XB_XSUB(j)  (1280 + 64 * (j))
#define XB_XGEN(j)  (2304 + 64 * (j))
#define XB_TOP      3328
#define XB_TOPGEN   3392
#define XCD_BAR_WORDS 3456
#define XB_SPIN_CAP (1u << 18)
__device__ __forceinline__ unsigned xb_ld(unsigned* p)              { return __hip_atomic_load(p, __ATOMIC_RELAXED, __HIP_MEMORY_SCOPE_AGENT); }
__device__ __forceinline__ unsigned xb_add(unsigned* p, unsigned v) { return __hip_atomic_fetch_add(p, v, __ATOMIC_RELAXED, __HIP_MEMORY_SCOPE_AGENT); }
__device__ __forceinline__ unsigned xb_xcc_id() { return (unsigned)__builtin_amdgcn_s_getreg((3 << 11) | 20) & 0xFu; }
#define XB_SPIN(cond, bar) do { unsigned _sp = 0; while (cond) { __builtin_amdgcn_s_sleep(1); \
    if ((++_sp & 255u) == 0u) { if (xb_ld(&(bar)[XB_TMO])) break; if (_sp > XB_SPIN_CAP) { atomicAdd(&(bar)[XB_TMO], 1u); break; } } } } while (0)
struct XcdBarrier { unsigned* bar; unsigned x; volatile LAS unsigned* st; };
__device__ __forceinline__ void xcd_barrier_complete(unsigned* bar, unsigned x, unsigned& nloc, unsigned& nx) {
    const unsigned G = gridDim.x * gridDim.y * gridDim.z;
    unsigned sum, cnt, mine, sp = 0u;
    for (;;) {
        sum = 0u; cnt = 0u; mine = 0u;
#pragma unroll
        for (unsigned j = 0; j < 16; ++j) { const unsigned c = xb_ld(&bar[XB_XCNT(j)]); sum += c; cnt += (c > 0u) ? 1u : 0u; mine = (j == x) ? c : mine; }
        if (sum == G) break;
        __builtin_amdgcn_s_sleep(1);
        if ((++sp & 255u) == 0u) { if (xb_ld(&bar[XB_TMO])) break; if (sp > XB_SPIN_CAP) { atomicAdd(&bar[XB_TMO], 1u); break; } }
    }
    nloc = mine > 0u ? mine : 1u; nx = cnt > 0u ? cnt : 1u;
}
__device__ __forceinline__ void xcd_barrier(const XcdBarrier& b) {
    asm volatile("s_waitcnt vmcnt(0)" ::: "memory");
    __syncthreads();
    if (threadIdx.x == 0) {
        unsigned* bar = b.bar;
        __builtin_amdgcn_s_waitcnt(0);
        unsigned nloc = b.st[0], nx = b.st[1];
        if (nloc == 0u) { xcd_barrier_complete(bar, b.x, nloc, nx); b.st[0] = nloc; b.st[1] = nx; }
        const unsigned old = xb_add(&bar[XB_XSUB(b.x)], 1u);
        const unsigned gen = old / nloc;
        if (old + 1u == (gen + 1u) * nloc) {
            __builtin_amdgcn_fence(__ATOMIC_RELEASE, "agent");
            asm volatile("s_waitcnt vmcnt(0)" ::: "memory");
            const unsigned og = xb_add(&bar[XB_TOP], 1u);
            const unsigned tg = og / nx;
            if (og + 1u == (tg + 1u) * nx) xb_add(&bar[XB_TOPGEN], 1u);
            else XB_SPIN(xb_ld(&bar[XB_TOPGEN]) == tg, bar);
            __builtin_amdgcn_fence(__ATOMIC_ACQUIRE, "agent");
            xb_add(&bar[XB_XGEN(b.x)], 1u);
            asm volatile("s_waitcnt vmcnt(0)" ::: "memory");
        } else {
            XB_SPIN(xb_ld(&bar[XB_XGEN(b.x)]) == gen, bar);
            __builtin_amdgcn_fence(__ATOMIC_ACQUIRE, "agent");
            asm volatile("s_waitcnt vmcnt(0)" ::: "memory");
        }
    }
    __syncthreads();
}
typedef __attribute__((address_space(4))) const Params CParams;
#define PHASE_BEGIN \
    CParams* P = (CParams*)__builtin_amdgcn_kernarg_segment_ptr(); asm volatile("" : "+s"(P)); \
    const int tid = my_tid(), lane = tid & 63, wave = __builtin_amdgcn_readfirstlane(tid >> 6); \
    const int G = gridDim.x, bx = blockIdx.x; const int gw = bx * 8 + wave, NGW = G * 8; \
    (void)lane; (void)gw; (void)NGW; \
    unsigned char* ws = P->ws; \
    unsigned* ctl = (unsigned*)(ws + WS_CTL); \
    bf16_t* Win0_t = (bf16_t*)(ws + WS_WIN0); bf16_t* Wqup_t = (bf16_t*)(ws + WS_WQUP); bf16_t* Wkvup_t = (bf16_t*)(ws + WS_WKVUP); bf16_t* Wout_t = (bf16_t*)(ws + WS_WOUT); \
    bf16_t* Wmi0_t = (bf16_t*)(ws + WS_A0); bf16_t* Wmo0_t = (bf16_t*)(ws + WS_A0 + 32 * MiB); bf16_t* Wmi1_t = (bf16_t*)(ws + WS_A1); bf16_t* Wmo1_t = (bf16_t*)(ws + WS_A1 + 32 * MiB); bf16_t* Wlru_t = (bf16_t*)(ws + WS_WLRU); bf16_t* Wmkv_t = (bf16_t*)(ws + WS_WMKV); bf16_t* Wg_t = (bf16_t*)(ws + WS_WG); \
    bf16_t* memn = (bf16_t*)(ws + WS_MEMN); float* mkv = (float*)(ws + WS_MKV); bf16_t* memK = (bf16_t*)(ws + WS_MEMK); bf16_t* memV = (bf16_t*)(ws + WS_MEMV); \
    float* rope = (float*)(ws + WS_ROPE); float* carryP = (float*)(ws + WS_CARRY); float* carryH = carryP + NB * NCHUNK * LRU_W; \
    bf16_t* xb = (bf16_t*)(ws + WS_S1); bf16_t* mixed0 = (bf16_t*)(ws + WS_A1); bf16_t* mixed1 = (bf16_t*)(ws + WS_A0); \
    float* ss0 = (float*)(ws + WS_SS); float* ss1 = ss0 + T; float* ss2 = ss1 + T; float* ss3 = ss2 + T; \
    bf16_t* proj0 = (bf16_t*)(ws + U_PROJ0); bf16_t* kvb = (bf16_t*)(ws + U_KV); bf16_t* Kb = (bf16_t*)(ws + U_K); bf16_t* Qb = (bf16_t*)P->out; \
    bf16_t* gateb = (bf16_t*)(ws + U_GATE); bf16_t* xinb = (bf16_t*)(ws + U_XIN); bf16_t* bscan = xinb; bf16_t* mqb = (bf16_t*)(ws + U_MQ); bf16_t* xcb = (bf16_t*)(ws + U_XC); bf16_t* ascan = (bf16_t*)(ws + U_A); \
    bf16_t* ub = (bf16_t*)(ws + WS_U); \
    float* clam = (float*)(ws + WS_CTL + 8192); \
    (void)0
__global__ void __launch_bounds__(512, 2) fwd_kernel(Params p) {
    extern __shared__ __attribute__((aligned(16))) unsigned char lds_raw[];
    LAS unsigned char* lds = (LAS unsigned char*)lds_raw;
    LAS int* s_item = (LAS int*)(lds + LDS_MISC);
    if (threadIdx.x < 64) ((LAS unsigned*)(lds + LDS_MISC))[threadIdx.x] = 0u;
    __syncthreads();
    cg::grid_group grid = cg::this_grid();
    const int lo = p.ph_lo, hi = p.ph_hi;
    if (hi > NPHASE + 7) grid.sync();
    if (hi - lo > 1 && threadIdx.x == 0) (void)xb_add((unsigned*)(p.ws + WS_CTL) + 4096 + XB_XCNT(xb_xcc_id()), 1u);
#ifndef PHMASK
#define PHMASK 0xFFFFF
#endif
#ifndef REPMASK
#define REPMASK 0
#endif
#define PH(k) if (((PHMASK >> (k)) & 1) && lo <= (k) && (k) < hi) for (int rep_ = 0; rep_ < 1 + ((REPMASK >> (k)) & 1); ++rep_)
#define SEAM(k) do { if (lo <= (k) && (k) + 1 < hi) { CParams* P_ = (CParams*)__builtin_amdgcn_kernarg_segment_ptr(); asm volatile("" : "+s"(P_)); \
        XcdBarrier b_; b_.bar = (unsigned*)(P_->ws + WS_CTL) + 4096; b_.x = xb_xcc_id(); b_.st = (volatile LAS unsigned*)(lds + LDS_MISC + 32); xcd_barrier(b_); } } while (0)

    PH(0) { PHASE_BEGIN; if (rep_) grid.sync();
        if (bx == 0 && tid < 64) ctl[tid] = 0u;
        if (bx == 1) for (int c = tid; c < LRU_W; c += 512) clam[c] = -8.0f * log1pf(expf(-P->lru_lambda[c]));
        LAS float* scr = (LAS float*)(lds + wave * TR_SCR_BYTES);
        constexpr int NITEMS = 2 * (2048 / 64) * (8192 / 64) + (2048 / 64) * (1856 / 64) + (768 / 64) * (2304 / 64) + (512 / 64) * (3072 / 64) + 2 * (2048 / 64) * (2048 / 64)
                             + (2048 / 64) * (3584 / 64) + (2048 / 64) * (1024 / 64) + 2 * 48;
#define P0_SELECT(it_, t) do { int r = (it_); \
            if (tr_job(r, P->w_mlp_in, 2048, 8192, Wmi0_t, P->mlp_norm, t)) {} \
            else if (tr_job(r, P->w_mlp_out, 8192, 2048, Wmo0_t, nullptr, t)) {} \
            else if (tr_job(r, P->w_in_mla, 2048, 1856, Win0_t, P->mix_norm, t)) {} \
            else if (tr_job(r, P->w_q_up, 768, 2304, Wqup_t, nullptr, t)) {} \
            else if (tr_job(r, P->w_kv_up, 512, 3072, Wkvup_t, nullptr, t)) {} \
            else if (tr_job(r, P->w_out, 2048, 2048, Wout_t, nullptr, t)) {} \
            else if (tr_job(r, P->w_out + (size_t)2048 * 2048, 2048, 2048, Wout_t + (size_t)2048 * 2048, nullptr, t)) {} \
            else if (tr_job(r, P->w_in_lru, 2048, 3584, Wlru_t, P->mix_norm + DM, t)) {} \
            else if (tr_job(r, P->w_mem_kv, 2048, 1024, Wmkv_t, nullptr, t)) {} \
            else if (tr_gate_job(r, P->w_gate_a, 0, Wg_t, t)) {} \
            else tr_gate_job(r, P->w_gate_i, 128, Wg_t, t); } while (0)
        { int it = gw; TrSel cur, nx; f32x4 v[16], nv[16]; float gg[16], ng[16];
          if (it < NITEMS) { P0_SELECT(it, cur); tr_load(cur, lane, v, gg); }
          while (it < NITEMS) { const int nit = it + NGW;
              if (nit < NITEMS) { P0_SELECT(nit, nx); tr_load(nx, lane, nv, ng); }
              asm volatile("" ::: "memory");
              tr_store(cur, v, gg, scr, lane);
              asm volatile("" ::: "memory");
              cur = nx; it = nit;
#pragma unroll
              for (int i = 0; i < 16; ++i) { v[i] = nv[i]; gg[i] = ng[i]; } } }
#undef P0_SELECT
        { u32x4* z = (u32x4*)(Win0_t + (size_t)MLA_IN * 2048); const int n16 = (MLA_INP - MLA_IN) * 2048 * 2 / 16;
          for (int i = bx * 512 + tid; i < n16; i += G * 512) z[i] = (u32x4){0u, 0u, 0u, 0u}; }
        for (int i = bx * 512 + tid; i < 3 * T; i += G * 512) ss1[i] = 0.f;
        cvt_rows(P->x, xb, ss0, T, gw, NGW, lane);
        norm_rows(P->mem, P->mem_norm, memn, NB * MEML, gw, NGW, lane);
        for (int i = bx * 512 + tid; i < T * 32; i += G * 512) { const int m = i >> 5, f = i & 31; const float inv = powf(10000.f, -(float)f / 32.f); const float ang = (float)P->pos[m] * inv;
            rope[(size_t)m * 64 + f] = cosf(ang); rope[(size_t)m * 64 + 32 + f] = sinf(ang); }
    }
    SEAM(0);
    PH(1) { PHASE_BEGIN;
        pg8::Gemm g{xb, Win0_t, T, MLA_INP, 2048, 2048, 2048, 0}; pg8::StaticOrder S; S.init(T, MLA_INP, G, bx);
        pg8::EpiBf16<0> E{proj0, proj0, proj0, 2048, 2048, 2048, 1 << 20, 1 << 20, ss0};
        pg8::gemm_phase<pg8::EpiBf16<0>, true>(lds, g, S, E);
    }
    SEAM(1);
    PH(2) { PHASE_BEGIN;
        f32x4 gq_[3], gkv_[2]; const f32x4 gm_ = *(const f32x4*)(P->mem_q_norm + (lane & 31) * 4);
#pragma unroll
        for (int j = 0; j < 3; ++j) gq_[j] = *(const f32x4*)(P->q_lat_norm + (lane + 64 * j) * 4);
#pragma unroll
        for (int j = 0; j < 2; ++j) gkv_[j] = *(const f32x4*)(P->kv_lat_norm + (lane + 64 * j) * 4);
        u32x2 w[7], nw[7]; int m = gw;
#define P2_LOAD(dst, mm) do { const u32x2* r_ = (const u32x2*)(proj0 + (size_t)(mm) * 2048); \
            dst[0] = r_[lane]; dst[1] = r_[lane + 64]; dst[2] = r_[lane + 128]; dst[3] = r_[192 + lane]; dst[4] = r_[192 + lane + 64]; dst[5] = r_[336 + lane]; dst[6] = r_[336 + lane + 64]; } while (0)
        if (m < T) P2_LOAD(w, m);
        for (; m < T; m += NGW) {
            if (m + NGW < T) P2_LOAD(nw, m + NGW);
            asm volatile("" ::: "memory");
            float sq[7];
#pragma unroll
            for (int j = 0; j < 7; ++j) { const float a = bflo(w[j].x), b = bfhi(w[j].x), c = bflo(w[j].y), d = bfhi(w[j].y); sq[j] = (a * a + b * b) + (c * c + d * d); }
            const float rq = rsqrtf(wave_sum(sq[0] + sq[1] + sq[2]) * (1.f / 768.f) + EPS), rkv = rsqrtf(wave_sum(sq[3] + sq[4]) * (1.f / 512.f) + EPS);
            const float rm0 = rsqrtf(half_sum(sq[5]) * (1.f / 128.f) + EPS), rm1 = rsqrtf(half_sum(sq[6]) * (1.f / 128.f) + EPS);
            u32x2* r_ = (u32x2*)(proj0 + (size_t)m * 2048);
#define P2_ST(idx, j, rs, gv) do { u32x2 o_; o_.x = cvt_pk_bf16(bflo(w[j].x) * (rs) * (gv).x, bfhi(w[j].x) * (rs) * (gv).y); o_.y = cvt_pk_bf16(bflo(w[j].y) * (rs) * (gv).z, bfhi(w[j].y) * (rs) * (gv).w); r_[idx] = o_; } while (0)
            P2_ST(lane, 0, rq, gq_[0]); P2_ST(lane + 64, 1, rq, gq_[1]); P2_ST(lane + 128, 2, rq, gq_[2]);
            P2_ST(192 + lane, 3, rkv, gkv_[0]); P2_ST(192 + lane + 64, 4, rkv, gkv_[1]);
            P2_ST(336 + lane, 5, rm0, gm_); P2_ST(336 + lane + 64, 6, rm1, gm_);
            asm volatile("" ::: "memory");
#pragma unroll
            for (int j = 0; j < 7; ++j) w[j] = nw[j];
        }
#undef P2_LOAD
#undef P2_ST
    }
    SEAM(2);
    PH(3) { PHASE_BEGIN;
        { pg8::Gemm g{proj0 + QLORA, Wkvup_t, T, KVW, KVLORA, 2048, KVLORA, 0}; pg8::StaticOrder S; S.init(T, KVW, G, bx);
          pg8::EpiBf16<0> E{kvb, kvb, kvb, KVW, KVW, KVW, 1 << 20, 1 << 20, nullptr}; pg8::gemm_phase<pg8::EpiBf16<0>, true>(lds, g, S, E); }
        { pg8::Gemm g{proj0, Wqup_t, T, QW, QLORA, 2048, QLORA, 0}; pg8::StaticOrder S; S.init(T, QW, G, bx);
          pg8::EpiBf16<0> E{Qb, Qb, Qb, QW, QW, QW, 1 << 20, 1 << 20, nullptr}; pg8::gemm_phase<pg8::EpiBf16<0>, true>(lds, g, S, E); }
        { pg8::Gemm g{memn, Wmkv_t, NB * MEML, 1024, 2048, 2048, 2048, 0}; pg8::StaticOrder S; S.init(NB * MEML, 1024, G, (bx + G - 64) % G);
          pg8::EpiRes E{nullptr, nullptr, mkv, nullptr, nullptr, 1024}; pg8::gemm_phase<pg8::EpiRes, true>(lds, g, S, E); }
    }
    SEAM(3);
    PH(4) { PHASE_BEGIN;
        const int half = lane >> 5, L = lane & 31; const bool act = L < 24, r1 = (L >= 16 && L < 20), r2 = (L >= 20 && L < 24);
        const int partner = r1 ? lane + 4 : (r2 ? lane - 4 : lane);
        float gq[8], gk[8];
#pragma unroll
        for (int j = 0; j < 8; ++j) { gq[j] = act ? P->q_norm[L * 8 + j] : 0.f; gk[j] = act ? P->k_norm[L * 8 + j] : 0.f; }
        for (int m = gw; m < T; m += NGW) {
            float cs[8], sn[8];
            { const int i0 = ((L - 16) & 3) * 8;
#pragma unroll
              for (int j = 0; j < 8; ++j) { cs[j] = rope[(size_t)m * 64 + i0 + j]; sn[j] = rope[(size_t)m * 64 + 32 + i0 + j]; } }
            bf16_t* qrow = Qb + (size_t)m * QW + L * 8; bf16_t* krow = Kb + (size_t)m * QW + L * 8;
            const bf16_t* ksrc = (L < 16) ? kvb + (size_t)m * KVW + L * 8 : proj0 + (size_t)m * 2048 + 1280 + (L - 16) * 8; const int kstep = (L < 16) ? 256 : 0;
            const u32x4 zero4 = {0u, 0u, 0u, 0u};
            u32x4 wq = act ? *(const u32x4*)(qrow + half * QKD) : zero4, wk = act ? *(const u32x4*)(ksrc + half * kstep) : zero4;
#pragma unroll 1
            for (int i = 0; i < 6; ++i) { const int h = 2 * i + half; u32x4 nq = zero4, nk = zero4;
                if (i < 5 && act) { nq = *(const u32x4*)(qrow + (h + 2) * QKD); nk = *(const u32x4*)(ksrc + (h + 2) * kstep); }
                asm volatile("" ::: "memory");
                const u32x4 oq = qk_head(wq, gq, r1, r2, partner, cs, sn), ok = qk_head(wk, gk, r1, r2, partner, cs, sn);
                if (act) { *(u32x4*)(qrow + h * QKD) = oq; *(u32x4*)(krow + h * QKD) = ok; }
                asm volatile("" ::: "memory");
                wq = nq; wk = nk; }
        }
        for (int m = gw; m < NB * MEML; m += NGW) { const float* r = mkv + (size_t)m * 1024;
            const f32x4 k0 = *(const f32x4*)(r + lane * 8), k1 = *(const f32x4*)(r + lane * 8 + 4), v0 = *(const f32x4*)(r + 512 + lane * 8), v1 = *(const f32x4*)(r + 512 + lane * 8 + 4);
            float ss = (k0.x * k0.x + k0.y * k0.y) + (k0.z * k0.z + k0.w * k0.w) + (k1.x * k1.x + k1.y * k1.y) + (k1.z * k1.z + k1.w * k1.w);
#pragma unroll
            for (int o = 1; o < 16; o <<= 1) ss += __shfl_xor(ss, o);
            const float rstd = rsqrtf(ss * (1.f / 128.f) + EPS); const float* gk2 = P->mem_k_norm + (lane & 15) * 8;
            u32x4 ok, ov; ok.x = cvt_pk_bf16(k0.x * rstd * gk2[0], k0.y * rstd * gk2[1]); ok.y = cvt_pk_bf16(k0.z * rstd * gk2[2], k0.w * rstd * gk2[3]);
            ok.z = cvt_pk_bf16(k1.x * rstd * gk2[4], k1.y * rstd * gk2[5]); ok.w = cvt_pk_bf16(k1.z * rstd * gk2[6], k1.w * rstd * gk2[7]);
            ov.x = cvt_pk_bf16(v0.x, v0.y); ov.y = cvt_pk_bf16(v0.z, v0.w); ov.z = cvt_pk_bf16(v1.x, v1.y); ov.w = cvt_pk_bf16(v1.z, v1.w);
            *(u32x4*)(memK + (size_t)m * 512 + lane * 8) = ok; *(u32x4*)(memV + (size_t)m * 512 + lane * 8) = ov; }
    }
    SEAM(4);
    PH(5) { PHASE_BEGIN; if (rep_) grid.sync();
        const int x0 = (int)(xb_xcc_id() & 7u);
        for (int qi = 0; qi < 8; ++qi) { const int q = (x0 + qi) & 7;
            for (;;) {
                if (tid == 0) *s_item = (int)atomicAdd(ctl + 8 * q, 1u);
                __syncthreads(); const int li = *s_item; __syncthreads();
                if (li >= 128) break;
                if (li < 96) { const int qb = 31 - li / 3, bh = q + 8 * (li % 3), b = bh / NHEAD, h = bh % NHEAD; const size_t r0 = (size_t)b * SEQ;
                    att::attn_block<192, true>(Qb + (r0 + qb * 256) * QW + h * QKD, QW, Kb + r0 * QW + h * QKD, QW, kvb + r0 * KVW + h * 256 + 128, KVW,
                                               mixed0 + (r0 + qb * 256) * DM + h * 128, DM, qb * 256, 4 * (qb + 1), 0.07216878364870322f, (LAS char*)lds);
                } else { const int i2 = q * 32 + (li - 96), qb = i2 & 31, mh = (i2 >> 5) & 3, b = i2 >> 7; const size_t r0 = (size_t)b * SEQ;
                    att::attn_block<128, false>(proj0 + (r0 + qb * 256) * 2048 + 1344 + mh * 128, 2048, memK + (size_t)b * MEML * 512 + mh * 128, 512, memV + (size_t)b * MEML * 512 + mh * 128, 512,
                                                mixed0 + (r0 + qb * 256) * DM + LRU_W + mh * 128, DM, 0, 4, 0.08838834764831845f, (LAS char*)lds); }
            } }
    }
    SEAM(5);
    PH(6) { PHASE_BEGIN;
        pg8::Gemm g{mixed0, Wout_t, T, DM, DM, DM, DM, 0}; pg8::StaticOrder S; S.init(T, DM, G, bx);
        pg8::EpiRes E{P->x, nullptr, nullptr, xb, ss1, DM}; pg8::gemm_phase<pg8::EpiRes, true>(lds, g, S, E);
    }
    SEAM(6);
    PH(8) { PHASE_BEGIN; if (rep_) grid.sync();
        pg8::Gemm g{xb, Wmi0_t, T, DFF, DM, DM, DM, 0}; pg8::StaticOrder S; S.init(T, DFF, G, bx);
        pg8::EpiBf16<1> E{ub, ub, ub, DFF, DFF, DFF, 1 << 20, 1 << 20, ss1}; pg8::gemm_phase<pg8::EpiBf16<1>, true>(lds, g, S, E);
    }
    SEAM(8);
    PH(9) { PHASE_BEGIN;
        pg8::Gemm g{ub, Wmo0_t, T, DM, DFF, DFF, DFF, 0}; pg8::StaticOrder S; S.init(T, DM, G, bx);
        pg8::EpiRes E{nullptr, xb, nullptr, xb, ss2, DM}; pg8::gemm_phase<pg8::EpiRes, true>(lds, g, S, E);
    }
    SEAM(9);
    PH(11) { PHASE_BEGIN;
        pg8::Gemm g{xb, Wlru_t, T, LRU_IN, DM, DM, DM, 0}; pg8::StaticOrder S; S.init(T, LRU_IN, G, bx);
        pg8::EpiBf16<2> E{gateb, xinb, mqb, LRU_W, LRU_W, 512, 6, 12, ss2}; pg8::gemm_phase<pg8::EpiBf16<2>, true>(lds, g, S, E);
    }
    SEAM(11);
    PH(12) { PHASE_BEGIN;
        { LAS float* scr = (LAS float*)(lds + wave * TR_SCR_BYTES); constexpr int NIT1 = 2 * (2048 / 64) * (8192 / 64);
#define P12_SELECT(it_, t) do { int r = (it_); if (tr_job(r, P->w_mlp_in + (size_t)2048 * 8192, 2048, 8192, Wmi1_t, P->mlp_norm + DM, t)) {} \
              else tr_job(r, P->w_mlp_out + (size_t)2048 * 8192, 8192, 2048, Wmo1_t, nullptr, t); } while (0)
          int it = gw; TrSel cur, nx; f32x4 v[16], nv[16]; float gg[16], ng[16];
          if (it < NIT1) { P12_SELECT(it, cur); tr_load(cur, lane, v, gg); }
          while (it < NIT1) { const int nit = it + NGW;
              if (nit < NIT1) { P12_SELECT(nit, nx); tr_load(nx, lane, nv, ng); }
              asm volatile("" ::: "memory");
              tr_store(cur, v, gg, scr, lane);
              asm volatile("" ::: "memory");
              cur = nx; it = nit;
#pragma unroll
              for (int i = 0; i < 16; ++i) { v[i] = nv[i]; gg[i] = ng[i]; } } }
#undef P12_SELECT
        for (int item = gw; item < (T / 32) * 3; item += NGW) { const int third = item % 3, m0 = (item / 3) * 32; const int c0 = third * 512 + lane * 8;
            float wt[4][8], bs[8];
#pragma unroll
            for (int k = 0; k < 4; ++k) { const f32x4 w0 = *(const f32x4*)(P->conv_w + k * LRU_W + c0), w1 = *(const f32x4*)(P->conv_w + k * LRU_W + c0 + 4);
                wt[k][0] = w0.x; wt[k][1] = w0.y; wt[k][2] = w0.z; wt[k][3] = w0.w; wt[k][4] = w1.x; wt[k][5] = w1.y; wt[k][6] = w1.z; wt[k][7] = w1.w; }
            { const f32x4 b0 = *(const f32x4*)(P->conv_b + c0), b1 = *(const f32x4*)(P->conv_b + c0 + 4); bs[0] = b0.x; bs[1] = b0.y; bs[2] = b0.z; bs[3] = b0.w; bs[4] = b1.x; bs[5] = b1.y; bs[6] = b1.z; bs[7] = b1.w; }
            const bf16_t* xp = xinb + c0; u32x4 win[3], cur[4], nxt[4];
#pragma unroll
            for (int k = 0; k < 3; ++k) { const int mm = m0 - 3 + k; win[k] = *(const u32x4*)(xp + (size_t)(mm < 0 ? 0 : mm) * LRU_W); }
#pragma unroll
            for (int k = 0; k < 4; ++k) cur[k] = *(const u32x4*)(xp + (size_t)(m0 + k) * LRU_W);
#pragma unroll 1
            for (int g = 0; g < 8; ++g) { const int mg = m0 + 4 * g;
                if (g < 7) {
#pragma unroll
                    for (int k = 0; k < 4; ++k) nxt[k] = *(const u32x4*)(xp + (size_t)(mg + 4 + k) * LRU_W); }
                asm volatile("" ::: "memory");
                u32x4 outv[4];
#pragma unroll
                for (int r = 0; r < 4; ++r) { const int sidx = (mg + r) & (SEQ - 1); float acc[8];
#pragma unroll
                    for (int e = 0; e < 8; ++e) acc[e] = bs[e];
#pragma unroll
                    for (int k = 0; k < 4; ++k) { const int wi = r + k; const u32x4 xv = wi < 3 ? win[wi] : cur[wi - 3];
                        if (sidx - 3 + k >= 0) { acc[0] += wt[k][0] * bflo(xv.x); acc[1] += wt[k][1] * bfhi(xv.x); acc[2] += wt[k][2] * bflo(xv.y); acc[3] += wt[k][3] * bfhi(xv.y);
                                                 acc[4] += wt[k][4] * bflo(xv.z); acc[5] += wt[k][5] * bfhi(xv.z); acc[6] += wt[k][6] * bflo(xv.w); acc[7] += wt[k][7] * bfhi(xv.w); } }
                    outv[r].x = cvt_pk_bf16(acc[0], acc[1]); outv[r].y = cvt_pk_bf16(acc[2], acc[3]); outv[r].z = cvt_pk_bf16(acc[4], acc[5]); outv[r].w = cvt_pk_bf16(acc[6], acc[7]); }
#pragma unroll
                for (int r = 0; r < 4; ++r) *(u32x4*)(xcb + (size_t)(mg + r) * LRU_W + c0) = outv[r];
                asm volatile("" ::: "memory");
                win[0] = cur[1]; win[1] = cur[2]; win[2] = cur[3];
#pragma unroll
                for (int k = 0; k < 4; ++k) cur[k] = nxt[k]; } }
        { const f32x4 gm_ = *(const f32x4*)(P->mem_q_norm + 128 + (lane & 31) * 4); u32x2 w0, w1, n0, n1; int m = gw;
          if (m < T) { const u32x2* r_ = (const u32x2*)(mqb + (size_t)m * 512); w0 = r_[lane]; w1 = r_[lane + 64]; }
          for (; m < T; m += NGW) {
              if (m + NGW < T) { const u32x2* r_ = (const u32x2*)(mqb + (size_t)(m + NGW) * 512); n0 = r_[lane]; n1 = r_[lane + 64]; }
              asm volatile("" ::: "memory");
              float s0, s1; { const float a = bflo(w0.x), b = bfhi(w0.x), c = bflo(w0.y), d = bfhi(w0.y); s0 = (a * a + b * b) + (c * c + d * d); }
              { const float a = bflo(w1.x), b = bfhi(w1.x), c = bflo(w1.y), d = bfhi(w1.y); s1 = (a * a + b * b) + (c * c + d * d); }
              const float r0 = rsqrtf(half_sum(s0) * (1.f / 128.f) + EPS), r1 = rsqrtf(half_sum(s1) * (1.f / 128.f) + EPS);
              u32x2* r_ = (u32x2*)(mqb + (size_t)m * 512); u32x2 o;
              o.x = cvt_pk_bf16(bflo(w0.x) * r0 * gm_.x, bfhi(w0.x) * r0 * gm_.y); o.y = cvt_pk_bf16(bflo(w0.y) * r0 * gm_.z, bfhi(w0.y) * r0 * gm_.w); r_[lane] = o;
              o.x = cvt_pk_bf16(bflo(w1.x) * r1 * gm_.x, bfhi(w1.x) * r1 * gm_.y); o.y = cvt_pk_bf16(bflo(w1.y) * r1 * gm_.z, bfhi(w1.y) * r1 * gm_.w); r_[lane + 64] = o;
              asm volatile("" ::: "memory");
              w0 = n0; w1 = n1; } }
    }
    SEAM(12);
    PH(13) { PHASE_BEGIN;
        pg8::Gemm g{xcb, Wg_t, T, 12 * 256, 128, LRU_W, 128, 256}; pg8::StaticOrder S; S.init(T, 12 * 256, G, bx);
        pg8::EpiGates E{P->b_gate_a, P->b_gate_i, clam, ascan, bscan, (LAS float*)(lds + LDS_MISC + 256)}; pg8::gemm_phase<pg8::EpiGates, true>(lds, g, S, E);
    }
    SEAM(13);
    PH(14) { PHASE_BEGIN;
        for (int it = bx; it < NB * NCHUNK; it += G) { const int ch = it % NCHUNK, b = it / NCHUNK;
            if (tid < LRU_W / 4) { const int c = tid * 4; const size_t base = ((size_t)b * SEQ + (size_t)ch * CHL) * LRU_W + c; float h[4] = {0.f, 0.f, 0.f, 0.f}, Pp[4] = {1.f, 1.f, 1.f, 1.f};
#pragma unroll 8
                for (int s = 0; s < CHL; ++s) { const u32x2 aw = *(const u32x2*)(ascan + base + (size_t)s * LRU_W), bw = *(const u32x2*)(bscan + base + (size_t)s * LRU_W), xw = *(const u32x2*)(xcb + base + (size_t)s * LRU_W);
                    const float av[4] = {1.f - bflo(aw.x), 1.f - bfhi(aw.x), 1.f - bflo(aw.y), 1.f - bfhi(aw.y)}, bv[4] = {bflo(bw.x) * bflo(xw.x), bfhi(bw.x) * bfhi(xw.x), bflo(bw.y) * bflo(xw.y), bfhi(bw.y) * bfhi(xw.y)};
#pragma unroll
                    for (int j = 0; j < 4; ++j) { h[j] = av[j] * h[j] + bv[j]; Pp[j] *= av[j]; } }
                *(f32x4*)(carryP + ((size_t)b * NCHUNK + ch) * LRU_W + c) = (f32x4){Pp[0], Pp[1], Pp[2], Pp[3]}; *(f32x4*)(carryH + ((size_t)b * NCHUNK + ch) * LRU_W + c) = (f32x4){h[0], h[1], h[2], h[3]}; } }
        for (int i2 = bx; i2 < NB * 4 * 32; i2 += G) { const int qb = i2 & 31, mh = (i2 >> 5) & 3, b = i2 >> 7; const size_t r0 = (size_t)b * SEQ;
            att::attn_block<128, false>(mqb + (r0 + qb * 256) * 512 + mh * 128, 512, memK + (size_t)b * MEML * 512 + mh * 128, 512, memV + (size_t)b * MEML * 512 + mh * 128, 512,
                                        mixed1 + (r0 + qb * 256) * DM + LRU_W + mh * 128, DM, 0, 4, 0.08838834764831845f, (LAS char*)lds); }
    }
    SEAM(14);
    PH(15) { PHASE_BEGIN;
        for (int it = bx; it < NB * NCHUNK; it += G) { const int ch = it % NCHUNK, b = it / NCHUNK;
            if (tid < LRU_W / 4) { const int c = tid * 4; float h[4] = {0.f, 0.f, 0.f, 0.f};
#pragma unroll 4
                for (int j = 0; j < ch; ++j) { const size_t ci = ((size_t)b * NCHUNK + j) * LRU_W + c; const f32x4 cp = *(const f32x4*)(carryP + ci), chh = *(const f32x4*)(carryH + ci);
                    h[0] = cp.x * h[0] + chh.x; h[1] = cp.y * h[1] + chh.y; h[2] = cp.z * h[2] + chh.z; h[3] = cp.w * h[3] + chh.w; }
                const size_t row0 = (size_t)b * SEQ + (size_t)ch * CHL;
                u32x2 ca[8], cb[8], cg_[8], cx[8], na[8], nb[8], ng[8], nx_[8];
#pragma unroll
                for (int j = 0; j < 8; ++j) { const size_t off = (row0 + j) * LRU_W + c; ca[j] = *(const u32x2*)(ascan + off); cb[j] = *(const u32x2*)(bscan + off); cg_[j] = *(const u32x2*)(gateb + off); cx[j] = *(const u32x2*)(xcb + off); }
#pragma unroll 1
                for (int s0 = 0; s0 < CHL; s0 += 8) {
                    if (s0 + 8 < CHL) {
#pragma unroll
                        for (int j = 0; j < 8; ++j) { const size_t off = (row0 + s0 + 8 + j) * LRU_W + c; na[j] = *(const u32x2*)(ascan + off); nb[j] = *(const u32x2*)(bscan + off); ng[j] = *(const u32x2*)(gateb + off); nx_[j] = *(const u32x2*)(xcb + off); } }
                    asm volatile("" ::: "memory");
                    u32x2 y[8];
#pragma unroll
                    for (int j = 0; j < 8; ++j) { h[0] = (1.f - bflo(ca[j].x)) * h[0] + bflo(cb[j].x) * bflo(cx[j].x); h[1] = (1.f - bfhi(ca[j].x)) * h[1] + bfhi(cb[j].x) * bfhi(cx[j].x);
                        h[2] = (1.f - bflo(ca[j].y)) * h[2] + bflo(cb[j].y) * bflo(cx[j].y); h[3] = (1.f - bfhi(ca[j].y)) * h[3] + bfhi(cb[j].y) * bfhi(cx[j].y);
                        y[j].x = cvt_pk_bf16(h[0] * bflo(cg_[j].x), h[1] * bfhi(cg_[j].x)); y[j].y = cvt_pk_bf16(h[2] * bflo(cg_[j].y), h[3] * bfhi(cg_[j].y)); }
#pragma unroll
                    for (int j = 0; j < 8; ++j) *(u32x2*)(mixed1 + (row0 + s0 + j) * DM + c) = y[j];
                    asm volatile("" ::: "memory");
#pragma unroll
                    for (int j = 0; j < 8; ++j) { ca[j] = na[j]; cb[j] = nb[j]; cg_[j] = ng[j]; cx[j] = nx_[j]; }
                } } }
    }
    SEAM(15);
    PH(16) { PHASE_BEGIN;
        pg8::Gemm g{mixed1, Wout_t + (size_t)DM * DM, T, DM, DM, DM, DM, 0}; pg8::StaticOrder S; S.init(T, DM, G, bx);
        pg8::EpiRes E{nullptr, xb, nullptr, xb, ss3, DM}; pg8::gemm_phase<pg8::EpiRes, true>(lds, g, S, E);
    }
    SEAM(16);
    PH(18) { PHASE_BEGIN;
        pg8::Gemm g{xb, Wmi1_t, T, DFF, DM, DM, DM, 0}; pg8::StaticOrder S; S.init(T, DFF, G, bx);
        pg8::EpiBf16<1> E{ub, ub, ub, DFF, DFF, DFF, 1 << 20, 1 << 20, ss3}; pg8::gemm_phase<pg8::EpiBf16<1>, true>(lds, g, S, E);
    }
    SEAM(18);
    PH(19) { PHASE_BEGIN;
        pg8::Gemm g{ub, Wmo1_t, T, DM, DFF, DFF, DFF, 0}; pg8::StaticOrder S; S.init(T, DM, G, bx);
        pg8::EpiRes E{nullptr, xb, P->out, nullptr, nullptr, DM}; pg8::gemm_phase<pg8::EpiRes, true>(lds, g, S, E);
    }
#undef PH
#undef SEAM
}

#ifndef ONE_LAUNCH
#define ONE_LAUNCH 1
#endif
extern "C" void kernel_launch(void* const* d_in, const int* in_sizes, int n_in, void* d_out, int out_size, void* d_ws, size_t ws_size, hipStream_t stream) {
    static int grid = 0;
    if (grid == 0) {
        if (n_in != 27 || ws_size < WS_END) { fprintf(stderr, "kernel_launch: unexpected n_in %d / ws_size %zu\n", n_in, ws_size); grid = -1; return; }
        int dev = 0, cus = 0, per_cu = 0;
        hipGetDevice(&dev); hipDeviceGetAttribute(&cus, hipDeviceAttributeMultiprocessorCount, dev);
        hipFuncSetAttribute((const void*)fwd_kernel, hipFuncAttributeMaxDynamicSharedMemorySize, LDS_TOTAL);
        hipOccupancyMaxActiveBlocksPerMultiprocessor(&per_cu, (const void*)fwd_kernel, 512, LDS_TOTAL);
        if (per_cu < 1) { fprintf(stderr, "kernel_launch: occupancy query says %d blocks per CU\n", per_cu); per_cu = 1; }
        (void)hipGetLastError();
        grid = cus;
    }
    if (grid < 0) return;
    Params p{};
    p.x = (const float*)d_in[0]; p.mem = (const float*)d_in[1]; p.pos = (const int*)d_in[2];
    p.mix_norm = (const float*)d_in[3]; p.mlp_norm = (const float*)d_in[4]; p.w_out = (const float*)d_in[5]; p.w_mlp_in = (const float*)d_in[6]; p.w_mlp_out = (const float*)d_in[7];
    p.mem_norm = (const float*)d_in[8]; p.w_mem_kv = (const float*)d_in[9]; p.mem_k_norm = (const float*)d_in[10]; p.mem_q_norm = (const float*)d_in[11]; p.w_in_mla = (const float*)d_in[12];
    p.q_lat_norm = (const float*)d_in[13]; p.w_q_up = (const float*)d_in[14]; p.kv_lat_norm = (const float*)d_in[15]; p.w_kv_up = (const float*)d_in[16]; p.q_norm = (const float*)d_in[17];
    p.k_norm = (const float*)d_in[18]; p.w_in_lru = (const float*)d_in[19]; p.conv_w = (const float*)d_in[20]; p.conv_b = (const float*)d_in[21]; p.w_gate_a = (const float*)d_in[22];
    p.b_gate_a = (const float*)d_in[23]; p.w_gate_i = (const float*)d_in[24]; p.b_gate_i = (const float*)d_in[25]; p.lru_lambda = (const float*)d_in[26];
    p.out = (float*)d_out; p.ws = (unsigned char*)d_ws;
#if ONE_LAUNCH
    (void)hipMemsetAsync((char*)d_ws + WS_CTL + 16384, 0, 16384, stream);
    p.ph_lo = 0; p.ph_hi = NPHASE;
    void* args[] = {&p};
    hipError_t e = hipLaunchCooperativeKernel((const void*)fwd_kernel, dim3(grid), dim3(512), args, LDS_TOTAL, stream);
    if (e != hipSuccess) fprintf(stderr, "cooperative launch failed: %s (grid %d)\n", hipGetErrorString(e), grid);
#else
    for (int k = 0; k < NPHASE; ++k) { p.ph_lo = k; p.ph_hi = k + 1; hipLaunchKernelGGL(fwd_kernel, dim3(grid), dim3(512), LDS_TOTAL, stream, p); }
#endif
}
```

```cpp
#include <hip/hip_runtime.h>
#include <hip/hip_cooperative_groups.h>
#include <cstdio>
#include <cstdint>
namespace cg = cooperative_groups;

#define LAS __attribute__((address_space(3)))
typedef unsigned short bf16_t;
typedef short bf16x8 __attribute__((ext_vector_type(8)));
typedef short s16x4 __attribute__((ext_vector_type(4)));
typedef float f32x4 __attribute__((ext_vector_type(4)));
typedef float f32x16 __attribute__((ext_vector_type(16)));
typedef unsigned u32x4 __attribute__((ext_vector_type(4)));
typedef unsigned u32x2 __attribute__((ext_vector_type(2)));

constexpr int DM = 2048, SEQ = 8192, NB = 2, T = NB * SEQ, MEML = 256;
constexpr int MLA_IN = 1856, MLA_INP = 2048, QLORA = 768, KVLORA = 512, NHEAD = 12, QKD = 192, LRU_W = 1536, LRU_IN = 3584, DFF = 8192;
constexpr int QW = NHEAD * QKD  , KVW = NHEAD * 256  ;
constexpr float EPS = 1e-6f;
constexpr int NCHUNK = 128, CHL = 64;

constexpr size_t MiB = 1u << 20;
constexpr size_t WS_CTL = 0;
constexpr size_t WS_SS = 256 * 1024;
constexpr size_t WS_WIN0 = 1 * MiB;
constexpr size_t WS_WQUP = WS_WIN0 + 8 * MiB;
constexpr size_t WS_WKVUP = WS_WQUP + 3456 * 1024;
constexpr size_t WS_WOUT = WS_WKVUP + 3 * MiB;
constexpr size_t WS_WLRU = WS_WOUT + 16 * MiB;
constexpr size_t WS_WMKV = WS_WLRU + 14 * MiB;
constexpr size_t WS_WG = WS_WMKV + 4 * MiB;
constexpr size_t WS_MEMN = WS_WG + 1 * MiB;
constexpr size_t WS_MKV = WS_MEMN + 2 * MiB;
constexpr size_t WS_MEMK = WS_MKV + 2 * MiB;
constexpr size_t WS_MEMV = WS_MEMK + 512 * 1024;
constexpr size_t WS_ROPE = WS_MEMV + 512 * 1024;
constexpr size_t WS_CARRY = WS_ROPE + 4 * MiB;
constexpr size_t WS_A0 = 64 * MiB;
constexpr size_t WS_A1 = 128 * MiB;
constexpr size_t WS_S1 = 192 * MiB;
static_assert(WS_CARRY + 3 * MiB <= WS_A0, "ws map");
constexpr size_t WS_U = 256 * MiB;
constexpr size_t WS_END = 512 * MiB;
constexpr size_t U_PROJ0 = WS_U;
constexpr size_t U_KV = WS_U + 64 * MiB;
constexpr size_t U_K = WS_U + 160 * MiB;
constexpr size_t U_GATE = WS_U;
constexpr size_t U_XIN = WS_U + 48 * MiB;
constexpr size_t U_MQ = WS_U + 96 * MiB;
constexpr size_t U_XC = WS_U + 112 * MiB;
constexpr size_t U_A = WS_U + 160 * MiB;

__device__ __forceinline__ unsigned cvt_pk_bf16(float lo, float hi) { unsigned r; asm volatile("v_cvt_pk_bf16_f32 %0, %1, %2" : "=v"(r) : "v"(lo), "v"(hi)); return r; }
__device__ __forceinline__ float bflo(unsigned u) { return __uint_as_float(u << 16); }
__device__ __forceinline__ float bfhi(unsigned u) { return __uint_as_float(u & 0xffff0000u); }
__device__ __forceinline__ float bf1(bf16_t u) { return __uint_as_float(((unsigned)u) << 16); }
__device__ __forceinline__ bf16_t f2bf(float f) { return (bf16_t)(cvt_pk_bf16(f, 0.f) & 0xffffu); }
__device__ __forceinline__ float wave_sum(float v) {
#pragma unroll
    for (int o = 1; o < 64; o <<= 1) v += __shfl_xor(v, o);
    return v;
}
__device__ __forceinline__ float half_sum(float v) {
#pragma unroll
    for (int o = 1; o < 32; o <<= 1) v += __shfl_xor(v, o);
    return v;
}
__device__ __forceinline__ int my_tid() { int t = threadIdx.x; asm volatile("" : "+v"(t)); return t; }
__device__ __forceinline__ float sigmoidf_(float x) { return __builtin_amdgcn_rcpf(1.f + __expf(-x)); }

namespace pg8 {
constexpr int BM = 256, BK = 64, HALF = 128, HTB = HALF * BK * 2, STAGE_BYTES = 8 * HTB, NXCD = 8, WGM = 8;
__host__ __device__ __forceinline__ int lds_byte(int r, int c) { const int st = (r >> 4) * 2 + (c >> 5), rr = r & 15, cc = c & 31, ob = rr * 64 + cc * 2; return st * 1024 + (ob ^ (((ob >> 9) & 1) << 5)); }
__host__ __device__ __forceinline__ void stage_rc(int b, int& R, int& C) { const int st = b / 1024, sb = b % 1024, swz = sb ^ (((sb >> 9) & 1) << 5); R = (st >> 1) * 16 + swz / 64; C = (st & 1) * 32 + (swz % 64) / 2; }
__host__ __device__ __forceinline__ int perm32(int rho) { const int n = rho >> 4, i = rho & 15; return 8 * (i >> 2) + 4 * n + (i & 3); }
struct Unit { int pm, pn; };
struct Gemm { const bf16_t* A; const bf16_t* Bt; int M, N, K, lda, ldb, acol; };
struct StaticOrder {
    int nM, nN, nwg, G, c;
    __host__ __device__ void init(int M, int N, int G_, int c_) { nM = M / BM; nN = N / BM; nwg = nM * nN; G = G_; c = c_; }
    __host__ __device__ bool next(int i, Unit& u) const {
        const long L = (long)i * G + c; if (L >= nwg) return false;
        int wgid = (int)L; { const int q = nwg / NXCD, r = nwg % NXCD, xcd = wgid % NXCD, off = wgid / NXCD; wgid = (xcd < r ? xcd * (q + 1) : r * (q + 1) + (xcd - r) * q) + off; }
        const int nig = WGM * nN, gid = wgid / nig, fm = gid * WGM, gsz = (nM - fm) < WGM ? (nM - fm) : WGM;
        u.pm = fm + ((wgid % nig) % gsz); u.pn = (wgid % nig) / gsz; return true;
    }
};
template <class Epi, bool ALIGN_EPI>
__device__ __forceinline__ void gemm_phase(LAS unsigned char* lds, const Gemm g, const StaticOrder& S, const Epi& E) {
    const int tid = my_tid(), wid = __builtin_amdgcn_readfirstlane(tid >> 6), lane = tid & 63, wr = wid >> 2, wc = wid & 3, fr = lane & 15, fq = lane >> 4;
    const int nt = g.K / BK;
    unsigned voffA[2], voffB[2];
#pragma unroll
    for (int i = 0; i < 2; ++i) { int R, C; stage_rc(tid * 16 + i * 8192, R, C); const int Rb = Epi::PERM ? ((R & ~31) + perm32(R & 31)) : R;
        voffA[i] = (unsigned)(R * g.lda + C) * 2u; voffB[i] = (unsigned)(Rb * g.ldb + C) * 2u; }
    const size_t kstep = (size_t)(BK * 2);
    const size_t hA = (size_t)HALF * g.lda * 2, hB = (size_t)HALF * g.ldb * 2;
    const size_t tA = 2 * hA, tB = 2 * hB;
    const unsigned ldsw = (unsigned)wid * 1024u;
    const int aoff = lds_byte(wr * 64 + fr, fq * 8), boff = lds_byte(wc * 32 + fr, fq * 8);
#define PG8_SA(b, h) (((b) * 2 + (h)) * HTB)
#define PG8_SB(b, h) ((4 + (b) * 2 + (h)) * HTB)
#define PG8_STAGE(bufoff, gbase, voff) do { _Pragma("unroll") for (int _i = 0; _i < 2; ++_i) \
        __builtin_amdgcn_global_load_lds((const unsigned*)((const char*)(gbase) + (voff)[_i]), (LAS unsigned*)(lds + (bufoff) + ldsw + _i * 8192), 16, 0, 0); } while (0)
#define PG8_LDA(dst, b, h) do { _Pragma("unroll") for (int m = 0; m < 4; ++m) _Pragma("unroll") for (int k = 0; k < 2; ++k) dst[m][k] = *(const LAS bf16x8*)(lds + PG8_SA(b, h) + aoff + m * 2048 + k * 1024); } while (0)
#define PG8_LDB(dst, b, h) do { _Pragma("unroll") for (int n = 0; n < 2; ++n) _Pragma("unroll") for (int k = 0; k < 2; ++k) dst[n][k] = *(const LAS bf16x8*)(lds + PG8_SB(b, h) + boff + n * 2048 + k * 1024); } while (0)
#define PG8_MMA(ai, bj, At, Bt) do { __builtin_amdgcn_s_setprio(1); _Pragma("unroll") for (int m = 0; m < 4; ++m) _Pragma("unroll") for (int n = 0; n < 2; ++n) _Pragma("unroll") for (int k = 0; k < 2; ++k) \
        acc[ai][bj][m][n] = __builtin_amdgcn_mfma_f32_16x16x32_bf16(Bt[n][k], At[m][k], acc[ai][bj][m][n], 0, 0, 0); __builtin_amdgcn_s_setprio(0); } while (0)
#define PG8_WAIT_V(n) asm volatile("s_waitcnt vmcnt(" #n ")" ::: "memory")
#define PG8_WAIT_L(n) asm volatile("s_waitcnt lgkmcnt(" #n ")" ::: "memory")
#define PG8_BAR __builtin_amdgcn_s_barrier()
#define PG8_SCHED __builtin_amdgcn_sched_barrier(0)
    Unit cur, nxt; int ui = 0;
    if (!S.next(0, cur)) return;
    float rsv[8], rsn[8];
    E.pre(cur, wr, fr, rsv); E.post(0, rsv);
    f32x4 acc[2][2][4][2];
#pragma unroll
    for (int a = 0; a < 2; ++a)
#pragma unroll
        for (int b = 0; b < 2; ++b)
#pragma unroll
            for (int m = 0; m < 4; ++m)
#pragma unroll
                for (int n = 0; n < 2; ++n) acc[a][b][m][n] = (f32x4){0.f, 0.f, 0.f, 0.f};
    bf16x8 At[4][2], B0[2][2], B1[2][2];
    const char* cA = (const char*)g.A + (size_t)cur.pm * tA + (size_t)cur.pn * g.acol; const char* cB = (const char*)g.Bt + (size_t)cur.pn * tB;
    PG8_STAGE(PG8_SB(0, 0), cB, voffB); PG8_STAGE(PG8_SB(0, 1), cB + hB, voffB); PG8_STAGE(PG8_SA(0, 0), cA, voffA); PG8_STAGE(PG8_SA(0, 1), cA + hA, voffA);
    if (wr == 1) PG8_BAR;
    PG8_WAIT_V(2); PG8_BAR;
    PG8_STAGE(PG8_SB(1, 0), cB + kstep, voffB); PG8_STAGE(PG8_SA(1, 0), cA + kstep, voffA); PG8_STAGE(PG8_SB(1, 1), cB + hB + kstep, voffB);
    PG8_WAIT_V(6); PG8_BAR;
    for (;;) {
        const bool has_next = S.next(ui + 1, nxt);
        const char* nA = has_next ? (const char*)g.A + (size_t)nxt.pm * tA + (size_t)nxt.pn * g.acol : cA; const char* nB = has_next ? (const char*)g.Bt + (size_t)nxt.pn * tB : cB;
        for (int t = 0; t < nt; t += 2) {
            const bool last = (t == nt - 2);
            const char* a1 = cA + (size_t)(t + 1) * kstep;
            const char* a2 = last ? nA : cA + (size_t)(t + 2) * kstep; const char* b2 = last ? nB : cB + (size_t)(t + 2) * kstep;
            const char* a3 = a2 + kstep; const char* b3 = b2 + kstep;
            PG8_LDB(B0, 0, 0); PG8_LDB(B1, 0, 1); PG8_SCHED; PG8_LDA(At, 0, 0); PG8_STAGE(PG8_SA(1, 1), a1 + hA, voffA);
            PG8_WAIT_V(8); PG8_WAIT_L(0); PG8_BAR; PG8_MMA(0, 0, At, B0); PG8_MMA(0, 1, At, B1); PG8_BAR; PG8_SCHED;
            PG8_LDA(At, 0, 1); PG8_STAGE(PG8_SB(0, 0), b2, voffB); PG8_STAGE(PG8_SB(0, 1), b2 + hB, voffB); PG8_STAGE(PG8_SA(0, 0), a2, voffA);
            PG8_WAIT_V(8); PG8_WAIT_L(0); PG8_BAR; PG8_MMA(1, 0, At, B0); PG8_MMA(1, 1, At, B1); PG8_BAR; PG8_SCHED;
            PG8_LDB(B0, 1, 0); PG8_LDB(B1, 1, 1); PG8_SCHED; PG8_LDA(At, 1, 0); PG8_STAGE(PG8_SA(0, 1), a2 + hA, voffA);
            PG8_WAIT_V(8); PG8_WAIT_L(0); PG8_BAR; PG8_MMA(0, 0, At, B0); PG8_MMA(0, 1, At, B1); PG8_BAR; PG8_SCHED;
            PG8_LDA(At, 1, 1); PG8_STAGE(PG8_SB(1, 0), b3, voffB); PG8_STAGE(PG8_SB(1, 1), b3 + hB, voffB); PG8_STAGE(PG8_SA(1, 0), a3, voffA);
            PG8_WAIT_V(8); PG8_WAIT_L(0); PG8_BAR; PG8_MMA(1, 0, At, B0); PG8_MMA(1, 1, At, B1); PG8_BAR; PG8_SCHED;
        }
        if constexpr (ALIGN_EPI) { if (wr == 0) PG8_BAR; }
        if (has_next) E.pre(nxt, wr, fr, rsn);
        E(acc, cur, wr, wc, fr, fq, ui, rsv);
        if (!has_next) break;
        E.post(ui + 1, rsn);
#pragma unroll
        for (int a = 0; a < 2; ++a)
#pragma unroll
            for (int b = 0; b < 2; ++b)
#pragma unroll
                for (int m = 0; m < 4; ++m)
#pragma unroll
                    for (int n = 0; n < 2; ++n) acc[a][b][m][n] = (f32x4){0.f, 0.f, 0.f, 0.f};
        cur = nxt; cA = nA; cB = nB; ++ui;
#pragma unroll
        for (int i_ = 0; i_ < 8; ++i_) rsv[i_] = rsn[i_];
        if constexpr (ALIGN_EPI) { if (wr == 1) PG8_BAR; }
    }
    PG8_WAIT_V(0);
    if constexpr (!ALIGN_EPI) { if (wr == 0) PG8_BAR; }
    PG8_BAR;
#undef PG8_SA
#undef PG8_SB
#undef PG8_STAGE
#undef PG8_LDA
#undef PG8_LDB
#undef PG8_MMA
#undef PG8_WAIT_V
#undef PG8_WAIT_L
#undef PG8_BAR
#undef PG8_SCHED
}

template <int ACT> struct EpiBf16 {
    static constexpr bool PERM = true;
    bf16_t* O0; bf16_t* O1; bf16_t* O2; int ld0, ld1, ld2, pn1, pn2; const float* ss;
    __device__ __forceinline__ void pre(const Unit& u, int wr, int fr, float (&rsv)[8]) const {
        const int row0 = u.pm * BM + wr * 64 + fr;
#pragma unroll
        for (int i = 0; i < 8; ++i) rsv[i] = ss ? ss[row0 + (i >> 2) * HALF + (i & 3) * 16] : 0.f;
    }
    __device__ __forceinline__ void post(int, const float (&)[8]) const {}
    __device__ __forceinline__ void operator()(const f32x4 (&acc)[2][2][4][2], const Unit& u, int wr, int wc, int fr, int fq, int, const float (&rsv_)[8]) const {
        bf16_t* base; int ldc, pnl; bool act2 = false;
        if (u.pn < pn1) { base = O0; ldc = ld0; pnl = u.pn; act2 = true; } else if (u.pn < pn2) { base = O1; ldc = ld1; pnl = u.pn - pn1; } else { base = O2; ldc = ld2; pnl = u.pn - pn2; }
        const int row0 = u.pm * BM + wr * 64 + fr; const int col0 = pnl * BM + wc * 32 + 8 * fq;
        float rsv[2][4];
#pragma unroll
        for (int ai = 0; ai < 2; ++ai)
#pragma unroll
            for (int m = 0; m < 4; ++m) rsv[ai][m] = ss ? rsqrtf(rsv_[ai * 4 + m] * (1.f / 2048.f) + EPS) : 1.f;
#pragma unroll
        for (int ai = 0; ai < 2; ++ai)
#pragma unroll
            for (int m = 0; m < 4; ++m) { bf16_t* rowp = base + (size_t)(row0 + ai * HALF + m * 16) * ldc + col0;
                const float rs = rsv[ai][m];
#pragma unroll
                for (int bj = 0; bj < 2; ++bj) { f32x4 v0 = acc[ai][bj][m][0] * rs, v1 = acc[ai][bj][m][1] * rs;
                    if (ACT == 1) {
#pragma unroll
                        for (int j = 0; j < 4; ++j) { const float a = fmaxf(v0[j], 0.f), b = fmaxf(v1[j], 0.f); v0[j] = a * a; v1[j] = b * b; } }
                    if (ACT == 2) { if (act2) {
#pragma unroll
                        for (int j = 0; j < 4; ++j) { float x = v0[j]; float z = 0.7978845608028654f * (x + 0.044715f * x * x * x); v0[j] = x / (1.f + __expf(-2.f * z));
                                                      x = v1[j]; z = 0.7978845608028654f * (x + 0.044715f * x * x * x); v1[j] = x / (1.f + __expf(-2.f * z)); } } }
                    u32x4 w; w.x = cvt_pk_bf16(v0[0], v0[1]); w.y = cvt_pk_bf16(v0[2], v0[3]); w.z = cvt_pk_bf16(v1[0], v1[1]); w.w = cvt_pk_bf16(v1[2], v1[3]);
                    *(u32x4*)(rowp + bj * HALF) = w; } }
    }
};
struct EpiRes {
    static constexpr bool PERM = true;
    const float* basef; const bf16_t* baseb; float* outf; bf16_t* outb; float* ss; int ldc;
    __device__ __forceinline__ void pre(const Unit&, int, int, float (&)[8]) const {}
    __device__ __forceinline__ void post(int, const float (&)[8]) const {}
    __device__ __forceinline__ void operator()(const f32x4 (&acc)[2][2][4][2], const Unit& u, int wr, int wc, int fr, int fq, int, const float (&)[8]) const {
        const int col0 = u.pn * BM + wc * 32 + 8 * fq; const int row0 = u.pm * BM + wr * 64 + fr;
        float part[2][4];
        f32x4 c0[2], c1[2], n0[2], n1[2];
#define ER_LOAD(d0_, d1_, aim_) do { _Pragma("unroll") for (int bj = 0; bj < 2; ++bj) { const size_t off_ = (size_t)(row0 + ((aim_) >> 2) * HALF + ((aim_) & 3) * 16) * ldc + col0 + bj * HALF; \
            if (basef) { d0_[bj] = *(const f32x4*)(basef + off_); d1_[bj] = *(const f32x4*)(basef + off_ + 4); } \
            else if (baseb) { const u32x4 bw = *(const u32x4*)(baseb + off_); d0_[bj] = (f32x4){bflo(bw.x), bfhi(bw.x), bflo(bw.y), bfhi(bw.y)}; d1_[bj] = (f32x4){bflo(bw.z), bfhi(bw.z), bflo(bw.w), bfhi(bw.w)}; } \
            else { d0_[bj] = (f32x4){0.f, 0.f, 0.f, 0.f}; d1_[bj] = (f32x4){0.f, 0.f, 0.f, 0.f}; } } } while (0)
        ER_LOAD(c0, c1, 0);
#pragma unroll
        for (int aim = 0; aim < 8; ++aim) { const int ai = aim >> 2, m = aim & 3;
            if (aim < 7) ER_LOAD(n0, n1, aim + 1);
            asm volatile("" ::: "memory");
            float pp = 0.f;
#pragma unroll
            for (int bj = 0; bj < 2; ++bj) { const size_t off = (size_t)(row0 + ai * HALF + m * 16) * ldc + col0 + bj * HALF;
                const f32x4 v0 = acc[ai][bj][m][0] + c0[bj], v1 = acc[ai][bj][m][1] + c1[bj];
                if (outf) { *(f32x4*)(outf + off) = v0; *(f32x4*)(outf + off + 4) = v1; }
                if (outb) { u32x4 w; w.x = cvt_pk_bf16(v0[0], v0[1]); w.y = cvt_pk_bf16(v0[2], v0[3]); w.z = cvt_pk_bf16(v1[0], v1[1]); w.w = cvt_pk_bf16(v1[2], v1[3]); *(u32x4*)(outb + off) = w; }
                pp += (v0[0] * v0[0] + v0[1] * v0[1]) + (v0[2] * v0[2] + v0[3] * v0[3]) + (v1[0] * v1[0] + v1[1] * v1[1]) + (v1[2] * v1[2] + v1[3] * v1[3]); }
            part[ai][m] = pp;
            asm volatile("" ::: "memory");
#pragma unroll
            for (int bj = 0; bj < 2; ++bj) { c0[bj] = n0[bj]; c1[bj] = n1[bj]; } }
#undef ER_LOAD
        if (ss) {
#pragma unroll
            for (int ai = 0; ai < 2; ++ai)
#pragma unroll
                for (int m = 0; m < 4; ++m) { float pp = part[ai][m]; pp += __shfl_xor(pp, 16); pp += __shfl_xor(pp, 32); if (fq == 0) unsafeAtomicAdd(ss + row0 + ai * HALF + m * 16, pp); } }
    }
};
struct EpiGates {
    static constexpr bool PERM = false;
    const float* ba; const float* bi; const float* cl; bf16_t* Aout; bf16_t* Bout; LAS float* cbuf;
    __device__ __forceinline__ void pre(const Unit& u, int, int, float (&r)[8]) const { const int t = my_tid();
        unsigned long long p0 = (unsigned long long)cl, p1 = (unsigned long long)ba, p2 = (unsigned long long)bi;
        asm volatile("" : "+s"(p0), "+s"(p1), "+s"(p2));
        const unsigned long long ps = t < 128 ? p0 : (t < 256 ? p1 : p2); const float v = ((const float*)ps)[u.pn * 128 + (t & 127)];
#pragma unroll
        for (int i = 0; i < 8; ++i) r[i] = v; }
    __device__ __forceinline__ void post(int ui, const float (&r)[8]) const { const int t = my_tid(); if (t < 384) cbuf[(ui & 1) * 384 + t] = r[0]; }
    __device__ __forceinline__ void operator()(const f32x4 (&acc)[2][2][4][2], const Unit& u, int wr, int wc, int fr, int fq, int ui, const float (&)[8]) const {
        const int cc = wc * 32 + 4 * fq; const int ch0 = u.pn * 128 + cc; const int row0 = u.pm * BM + wr * 64 + fr; const LAS float* cb = cbuf + (ui & 1) * 384 + cc;
#pragma unroll
        for (int ai = 0; ai < 2; ++ai)
#pragma unroll
            for (int m = 0; m < 4; ++m) { const size_t off = (size_t)(row0 + ai * HALF + m * 16) * LRU_W + ch0;
#pragma unroll
                for (int n = 0; n < 2; ++n) { const f32x4 vcl = *(const LAS f32x4*)(cb + n * 16), vba = *(const LAS f32x4*)(cb + 128 + n * 16), vbi = *(const LAS f32x4*)(cb + 256 + n * 16);
                    const f32x4 va = acc[ai][0][m][n] + vba, vi = acc[ai][1][m][n] + vbi;
                    float a4[4]; float b4[4];
#pragma unroll
                    for (int j = 0; j < 4; ++j) { const float r = sigmoidf_(va[j]), ig = sigmoidf_(vi[j]); const float la = vcl[j] * r; a4[j] = 1.f - __expf(la); b4[j] = __builtin_amdgcn_sqrtf(a4[j] * (2.f - a4[j])) * ig; }
                    { u32x2 aw; aw.x = cvt_pk_bf16(a4[0], a4[1]); aw.y = cvt_pk_bf16(a4[2], a4[3]); *(u32x2*)(Aout + off + n * 16) = aw; }
                    u32x2 bw; bw.x = cvt_pk_bf16(b4[0], b4[1]); bw.y = cvt_pk_bf16(b4[2], b4[3]); *(u32x2*)(Bout + off + n * 16) = bw;
                    __builtin_amdgcn_sched_barrier(0); } }
    }
};
}

namespace att {
constexpr int NW = 8, QBLK = 32, KVBLK = 64, QB = 256;
constexpr int SHM_V = 16384, SHM_KN = 16384, SHM_KR = 8192, SHM_K = SHM_KN + SHM_KR;
constexpr int OFF_K = 3 * SHM_V, OFF_WS = OFF_K + 2 * SHM_K, OFF_QR = OFF_WS + NW * 64 * 4, LDS_BYTES = OFF_QR + NW * 4096;
constexpr float THR = 8.f;
#define KSWZF(row) ((((row) & 3) << 2) | (((row) >> 2) & 3))
#define KSWZ(row, colB) ((row) * 256 + ((colB) ^ (KSWZF(row) << 4)))
#define KRSWZ(row, colB) (SHM_KN + (row) * 128 + ((colB) ^ ((((row) >> 1) & 7) << 4)))
#define SBAR() __builtin_amdgcn_sched_barrier(0)
__device__ __forceinline__ int v_st(int k, int c) { const int kk = (k & ~0xC) | ((k & 4) << 1) | ((k & 8) >> 1); return ((kk >> 3) * 4 + (c >> 5)) * 512 + ((kk & 7) * 32 + (c & 31)) * 2; }
__device__ __forceinline__ int v_rd_base(int lane) { return ((lane & 3) << 3) | (((lane >> 2) & 3) << 6) | (((lane >> 4) & 1) << 5) | (((lane >> 5) & 1) << 8); }
constexpr int v_rd_off(int d0, int ks, int half) { return d0 * 512 + ks * 4096 + half * 2048; }
__device__ __forceinline__ int crow(int r, int hi) { return (r & 3) + 8 * (r >> 2) + 4 * hi; }
__device__ __forceinline__ void mask_tile(f32x16& p0, f32x16& p1, int dq) {
    const float NEG = -__builtin_inff();
#pragma unroll
    for (int r = 0; r < 16; ++r) { const int c = (r & 3) + 8 * (r >> 2); if (dq - c < 0) p0[r] = NEG; if (dq - c - 32 < 0) p1[r] = NEG; }
}
__device__ __forceinline__ void partialSM(f32x16& p0, f32x16& p1, float& m_reg, float& mn, float& alpha, float SCALE, float C2) {
    float pmax = p0[0];
#pragma unroll
    for (int r = 1; r < 16; ++r) pmax = fmaxf(pmax, p0[r]);
#pragma unroll
    for (int r = 0; r < 16; ++r) pmax = fmaxf(pmax, p1[r]);
    { auto rr = __builtin_amdgcn_permlane32_swap(__float_as_uint(pmax), __float_as_uint(pmax), false, false); pmax = fmaxf(__uint_as_float(rr[0]), __uint_as_float(rr[1])); }
    if (__builtin_expect(__all((pmax - m_reg) * SCALE <= THR), 1)) { mn = m_reg; alpha = 1.f; }
    else { mn = fmaxf(m_reg, pmax); alpha = __builtin_amdgcn_exp2f((m_reg - mn) * C2); m_reg = mn; }
    const float mnL = -mn * C2;
#pragma unroll
    for (int r = 0; r < 16; ++r) p0[r] = fmaf(p0[r], C2, mnL);
#pragma unroll
    for (int r = 0; r < 16; ++r) p1[r] = fmaf(p1[r], C2, mnL);
#pragma unroll
    for (int r = 0; r < 16; ++r) p0[r] = __builtin_amdgcn_exp2f(p0[r]);
}
__device__ __forceinline__ void finishSM(f32x16& p0, f32x16& p1, float alpha, float& l_reg, bf16x8& pa0, bf16x8& pa1, bf16x8& pa2, bf16x8& pa3) {
#pragma unroll
    for (int r = 0; r < 16; ++r) p1[r] = __builtin_amdgcn_exp2f(p1[r]);
    float ps = 0;
#pragma unroll
    for (int r = 0; r < 16; ++r) ps += p0[r];
#pragma unroll
    for (int r = 0; r < 16; ++r) ps += p1[r];
    { auto rr = __builtin_amdgcn_permlane32_swap(__float_as_uint(ps), __float_as_uint(ps), false, false); ps = __uint_as_float(rr[0]) + __uint_as_float(rr[1]); }
    l_reg = l_reg * alpha + ps;
#define PK4(P, B_, OUT) do { unsigned a0 = cvt_pk_bf16(P[B_+0], P[B_+1]), a1 = cvt_pk_bf16(P[B_+2], P[B_+3]);                          \
        unsigned b0 = cvt_pk_bf16(P[B_+4], P[B_+5]), b1 = cvt_pk_bf16(P[B_+6], P[B_+7]);                                             \
        auto r0 = __builtin_amdgcn_permlane32_swap(a0, b0, false, false); auto r1 = __builtin_amdgcn_permlane32_swap(a1, b1, false, false); \
        u32x4 w = {r0[0], r1[0], r0[1], r1[1]}; OUT = __builtin_bit_cast(bf16x8, w); } while (0)
    PK4(p0, 0, pa0); PK4(p0, 8, pa1); PK4(p1, 0, pa2); PK4(p1, 8, pa3);
#undef PK4
}
template <int DQ>
__device__ __forceinline__ void qkt(f32x16& p0, f32x16& p1, const LAS char* Kt, int r32, int hi, const bf16x8* qr, const LAS char* qrl) {
    constexpr int ND = DQ / 16, PF = 6;
    p0 = f32x16{}; p1 = f32x16{};
    const LAS char* kb[4]; const LAS char* kr[4];
#pragma unroll
    for (int dd = 0; dd < 4; ++dd) { kb[dd] = Kt + KSWZ(r32, (dd * 16 + hi * 8) * 2); kr[dd] = Kt + KRSWZ(r32, (dd * 16 + hi * 8) * 2); }
    const int koff = (r32 & 2) ? -128 : 128;
#define RDK(d, half) (*reinterpret_cast<const LAS bf16x8*>((d) < 8 ? kb[(d) & 3] + ((d) >> 2) * koff + (half) * 32 * 256 : kr[((d) - 8) & 3] + (half) * 32 * 128))
    bf16x8 k0[PF], k1[PF], qf[4];
    if constexpr (DQ == 192) {
#pragma unroll
        for (int dd = 0; dd < 4; ++dd) qf[dd] = *reinterpret_cast<const LAS bf16x8*>(qrl + dd * 1024);
    }
#pragma unroll
    for (int d = 0; d < PF; ++d) { k0[d] = RDK(d, 0); k1[d] = RDK(d, 1); }
    SBAR();
#pragma unroll
    for (int d = 0; d < ND; ++d) { const bf16x8 q = d < 8 ? qr[d & 7] : qf[(d - 8) & 3];
        p0 = __builtin_amdgcn_mfma_f32_32x32x16_bf16(k0[d % PF], q, p0, 0, 0, 0);
        p1 = __builtin_amdgcn_mfma_f32_32x32x16_bf16(k1[d % PF], q, p1, 0, 0, 0);
        if (d + PF < ND) { k0[d % PF] = RDK(d + PF, 0); k1[d % PF] = RDK(d + PF, 1); }
        SBAR(); }
#undef RDK
}
__device__ __forceinline__ void pv_tile(f32x16* o, int vb, bf16x8 pa0, bf16x8 pa1, bf16x8 pa2, bf16x8 pa3) {
#define TRRD(dst, off) asm volatile("ds_read_b64_tr_b16 %0, %1 offset:%2" : "=&v"(dst) : "v"(vb), "i"(off) : "memory")
#define RD8(L, H, d0) do { constexpr int b_ = v_rd_off(d0, 0, 0); TRRD(L[0], b_); TRRD(H[0], b_ + 2048); TRRD(L[1], b_ + 4096); TRRD(H[1], b_ + 6144); TRRD(L[2], b_ + 8192); TRRD(H[2], b_ + 10240); TRRD(L[3], b_ + 12288); TRRD(H[3], b_ + 14336); } while (0)
#define MM4(L, H, d0) do { \
        o[d0] = __builtin_amdgcn_mfma_f32_32x32x16_bf16(pa0, (bf16x8){L[0][0], L[0][1], L[0][2], L[0][3], H[0][0], H[0][1], H[0][2], H[0][3]}, o[d0], 0, 0, 0);   \
        o[d0] = __builtin_amdgcn_mfma_f32_32x32x16_bf16(pa1, (bf16x8){L[1][0], L[1][1], L[1][2], L[1][3], H[1][0], H[1][1], H[1][2], H[1][3]}, o[d0], 0, 0, 0);   \
        o[d0] = __builtin_amdgcn_mfma_f32_32x32x16_bf16(pa2, (bf16x8){L[2][0], L[2][1], L[2][2], L[2][3], H[2][0], H[2][1], H[2][2], H[2][3]}, o[d0], 0, 0, 0);   \
        o[d0] = __builtin_amdgcn_mfma_f32_32x32x16_bf16(pa3, (bf16x8){L[3][0], L[3][1], L[3][2], L[3][3], H[3][0], H[3][1], H[3][2], H[3][3]}, o[d0], 0, 0, 0); } while (0)
    s16x4 la[4], ha[4], lb[4], hb[4];
    RD8(la, ha, 0); RD8(lb, hb, 1);
    asm volatile("s_waitcnt lgkmcnt(8)" ::: "memory"); SBAR(); MM4(la, ha, 0); SBAR();
    RD8(la, ha, 2);
    asm volatile("s_waitcnt lgkmcnt(8)" ::: "memory"); SBAR(); MM4(lb, hb, 1); SBAR();
    RD8(lb, hb, 3);
    asm volatile("s_waitcnt lgkmcnt(8)" ::: "memory"); SBAR(); MM4(la, ha, 2); SBAR();
    asm volatile("s_waitcnt lgkmcnt(0)" ::: "memory"); SBAR(); MM4(lb, hb, 3);
#undef MM4
#undef RD8
#undef TRRD
}

template <int DQ, bool CAUSAL>
__device__ __forceinline__ void attn_block(const bf16_t* Q, int ldq, const bf16_t* Kh, int ldk, const bf16_t* Vh, int ldv, bf16_t* O, int ldo, int P0, int NT, float SCALE, LAS char* lds) {
    const float C2 = 1.4426950408889634f * SCALE;
    const int tid = my_tid(), wid = __builtin_amdgcn_readfirstlane(tid >> 6), lane = tid & 63, r32 = lane & 31, hi = lane >> 5;
    const int qlo = P0 + wid * QBLK, qm = qlo + r32 - 4 * hi;
    LAS char* V_lds = lds; LAS char* K_lds = lds + OFF_K;
    LAS float* ws = (LAS float*)(lds + OFF_WS) + wid * 64; LAS float* li_l = ws; LAS float* al_l = ws + 32;
    float m_reg = -1e30f, l_reg = 0; f32x16 o[4] = {};
    const int krow = 4 * wid + (lane >> 4);
    const unsigned goffK = (unsigned)krow * (unsigned)ldk + (unsigned)(((lane & 15) ^ KSWZF(krow)) * 8);
    const int rrow = 8 * wid + (lane >> 3);
    const unsigned goffR = (unsigned)rrow * (unsigned)ldk + 128u + (unsigned)(((lane & 7) ^ ((rrow >> 1) & 7)) * 8);
    const int vsub = 2 * wid + (lane >> 5), vkk = (vsub >> 2) * 8 + ((lane & 31) >> 2), vk = (vkk & ~0xC) | ((vkk & 4) << 1) | ((vkk & 8) >> 1);
    const unsigned goffV = (unsigned)vk * (unsigned)ldv + (unsigned)((vsub & 3) * 32 + (lane & 3) * 8);
    const int vb0 = (int)(uintptr_t)V_lds + v_rd_base(lane);
#define GLDS(gp, lp) __builtin_amdgcn_global_load_lds((const unsigned*)(gp), (LAS unsigned*)(lp), 16, 0, 0)
#define DMA_TILE(t, kslot, vslot) do { const bf16_t* kt_ = Kh + (size_t)(t) * KVBLK * ldk; const bf16_t* vt_ = Vh + (size_t)(t) * KVBLK * ldv; \
        LAS char* kd_ = K_lds + (kslot) * SHM_K + wid * 1024; LAS char* vd_ = V_lds + (vslot) * SHM_V + wid * 1024; \
        GLDS(kt_ + goffK, kd_); GLDS(kt_ + goffK + (size_t)32 * ldk, kd_ + 8192); \
        if constexpr (DQ == 192) GLDS(kt_ + goffR, kd_ + SHM_KN); \
        GLDS(vt_ + goffV, vd_); GLDS(vt_ + goffV + (size_t)32 * ldv, vd_ + 8192); } while (0)
#define RESC(a) do { if (__any((a) < 1.f)) { if (hi == 0) al_l[r32] = (a); asm volatile("s_waitcnt lgkmcnt(0)" ::: "memory");              \
                     _Pragma("unroll") for (int d_ = 0; d_ < 4; ++d_) _Pragma("unroll") for (int r = 0; r < 16; ++r) o[d_][r] *= al_l[crow(r, hi)]; } } while (0)
#define KBASE(t) ((t) * KVBLK)
#define MASKT(P0_, P1_, t) do { if constexpr (CAUSAL) { const int kb_ = KBASE(t); if (kb_ + KVBLK - 1 > qlo) mask_tile(P0_, P1_, qm - kb_); } } while (0)
    DMA_TILE(0, 0, 0);
    bf16x8 qr[8];
#pragma unroll
    for (int d0 = 0; d0 < 8; ++d0) qr[d0] = *(const bf16x8*)(Q + (size_t)(wid * QBLK + r32) * ldq + d0 * 16 + hi * 8);
    LAS char* qrl = lds + OFF_QR + wid * 4096 + lane * 16;
    if constexpr (DQ == 192) {
#pragma unroll
        for (int dd = 0; dd < 4; ++dd) *(LAS bf16x8*)(qrl + dd * 1024) = *(const bf16x8*)(Q + (size_t)(wid * QBLK + r32) * ldq + (8 + dd) * 16 + hi * 8);
    }
    __syncthreads();
    int vs_cur = 0, vs_next = 1;
#pragma unroll 1
    for (int t = 0; t < NT; ++t) {
        if (t + 1 < NT) DMA_TILE(t + 1, (t + 1) & 1, vs_next);
        f32x16 p0, p1; float mn, al; bf16x8 pa0, pa1, pa2, pa3;
        SBAR(); qkt<DQ>(p0, p1, K_lds + (t & 1) * SHM_K, r32, hi, qr, qrl);
        MASKT(p0, p1, t); partialSM(p0, p1, m_reg, mn, al, SCALE, C2);
        RESC(al);
        finishSM(p0, p1, al, l_reg, pa0, pa1, pa2, pa3); SBAR();
        pv_tile(o, vb0 + vs_cur * SHM_V, pa0, pa1, pa2, pa3);
        __syncthreads();
        { const int t_ = vs_cur; vs_cur = vs_next; vs_next = t_; }
    }
    SBAR();
    if (hi == 0) li_l[r32] = l_reg; asm volatile("s_waitcnt lgkmcnt(0)" ::: "memory");
    float rli[16];
#pragma unroll
    for (int r = 0; r < 16; ++r) rli[r] = __builtin_amdgcn_rcpf(li_l[crow(r, hi)]);
    { LAS bf16_t* stg = (LAS bf16_t*)(lds + wid * 8192);
#pragma unroll
      for (int r = 0; r < 16; ++r) { const int orow = crow(r, hi);
#pragma unroll
          for (int d0 = 0; d0 < 4; ++d0) stg[orow * 128 + d0 * 32 + r32] = f2bf(o[d0][r] * rli[r]); }
      asm volatile("s_waitcnt lgkmcnt(0)" ::: "memory");
      bf16_t* Ow = O + (size_t)(wid * QBLK) * ldo;
#pragma unroll
      for (int i = 0; i < 8; ++i) { const int c = i * 64 + lane, row = c >> 4, ch = c & 15;
          const u32x4 v = *(const LAS u32x4*)(stg + row * 128 + ch * 8);
          *(u32x4*)(Ow + (size_t)row * ldo + ch * 8) = v; } }
    __syncthreads();
#undef GLDS
#undef DMA_TILE
#undef RESC
#undef KBASE
#undef MASKT
#undef HALF_STEP
}
}

struct Params {
    const float* x; const float* mem; const int* pos;
    const float *mix_norm, *mlp_norm, *w_out, *w_mlp_in, *w_mlp_out, *mem_norm, *w_mem_kv, *mem_k_norm, *mem_q_norm, *w_in_mla, *q_lat_norm, *w_q_up, *kv_lat_norm, *w_kv_up,
        *q_norm, *k_norm, *w_in_lru, *conv_w, *conv_b, *w_gate_a, *b_gate_a, *w_gate_i, *b_gate_i, *lru_lambda;
    float* out; unsigned char* ws; int ph_lo, ph_hi;
};
constexpr int LDS_MISC = 135168, LDS_TOTAL = LDS_MISC + 256 + 3072;
constexpr int NPHASE = 20;

constexpr int TR_STRIDE = 65, TR_SCR_BYTES = 64 * TR_STRIDE * 4;
struct TrSel { const float* W; bf16_t* WT; const float* gain; int N, ldt; };
__device__ __forceinline__ void tr_load(const TrSel& t, int lane, f32x4 (&v)[16], float (&g)[16]) {
#pragma unroll
    for (int i = 0; i < 16; ++i) { v[i] = *(const f32x4*)(t.W + (size_t)(4 * i + (lane >> 4)) * t.N + (lane & 15) * 4); g[i] = t.gain ? t.gain[4 * i + (lane >> 4)] : 1.f; }
}
__device__ __forceinline__ void tr_store(const TrSel& t, const f32x4 (&v)[16], const float (&g)[16], LAS float* scr, int lane) {
#pragma unroll
    for (int i = 0; i < 16; ++i) { const int kk = 4 * i + (lane >> 4); LAS float* d = scr + kk * TR_STRIDE + (lane & 15) * 4;
        d[0] = v[i].x * g[i]; d[1] = v[i].y * g[i]; d[2] = v[i].z * g[i]; d[3] = v[i].w * g[i]; }
    asm volatile("s_waitcnt lgkmcnt(0)" ::: "memory");
    const int c = lane & 7;
#pragma unroll
    for (int j = 0; j < 8; ++j) { const int n = (lane >> 3) + 8 * j; const LAS float* sp = scr + (8 * c) * TR_STRIDE + n;
        u32x4 o; o.x = cvt_pk_bf16(sp[0 * TR_STRIDE], sp[1 * TR_STRIDE]); o.y = cvt_pk_bf16(sp[2 * TR_STRIDE], sp[3 * TR_STRIDE]); o.z = cvt_pk_bf16(sp[4 * TR_STRIDE], sp[5 * TR_STRIDE]); o.w = cvt_pk_bf16(sp[6 * TR_STRIDE], sp[7 * TR_STRIDE]);
        *(u32x4*)(t.WT + (size_t)n * t.ldt + 8 * c) = o; }
    asm volatile("s_waitcnt lgkmcnt(0)" ::: "memory");
}
__device__ __forceinline__ bool tr_job(int& r, const float* W, int K, int N, bf16_t* WT, const float* gain, TrSel& t) {
    const int nblk = N / 64, items = (K / 64) * nblk;
    if (r >= items) { r -= items; return false; }
    const int kb = r / nblk, nb = r % nblk;
    t.W = W + (size_t)(64 * kb) * N + 64 * nb; t.N = N; t.WT = WT + (size_t)(64 * nb) * K + 64 * kb; t.ldt = K; t.gain = gain ? gain + 64 * kb : nullptr;
    return true;
}
__device__ __forceinline__ bool tr_gate_job(int& r, const float* W, int row_off, bf16_t* WT, TrSel& t) {
    const int items = 12 * 2 * 2;
    if (r >= items) { r -= items; return false; }
    const int blk = r / 4, kb = (r % 4) / 2, nb = r % 2;
    t.W = W + (size_t)blk * 16384 + (size_t)(64 * kb) * 128 + 64 * nb; t.N = 128; t.WT = WT + (size_t)blk * 32768 + (size_t)(row_off + 64 * nb) * 128 + 64 * kb; t.ldt = 128; t.gain = nullptr;
    return true;
}
__device__ __forceinline__ void cvt_rows(const float* X, bf16_t* out, float* ss, int rows, int gw, int NGW, int lane) {
    f32x4 v[8], nv[8]; int m = gw;
    if (m < rows) {
#pragma unroll
        for (int j = 0; j < 8; ++j) v[j] = ((const f32x4*)(X + (size_t)m * DM) + lane)[64 * j]; }
    for (; m < rows; m += NGW) {
        if (m + NGW < rows) {
#pragma unroll
            for (int j = 0; j < 8; ++j) nv[j] = ((const f32x4*)(X + (size_t)(m + NGW) * DM) + lane)[64 * j]; }
        asm volatile("" ::: "memory");
        float s = 0.f;
#pragma unroll
        for (int j = 0; j < 8; ++j) s += (v[j].x * v[j].x + v[j].y * v[j].y) + (v[j].z * v[j].z + v[j].w * v[j].w);
        s = wave_sum(s); if (lane == 0) ss[m] = s;
        u32x2* o8 = (u32x2*)(out + (size_t)m * DM) + lane;
#pragma unroll
        for (int j = 0; j < 8; ++j) { u32x2 w; w.x = cvt_pk_bf16(v[j].x, v[j].y); w.y = cvt_pk_bf16(v[j].z, v[j].w); o8[64 * j] = w; }
        asm volatile("" ::: "memory");
#pragma unroll
        for (int j = 0; j < 8; ++j) v[j] = nv[j];
    }
}

__device__ __forceinline__ void norm_rows(const float* X, const float* g, bf16_t* out, int rows, int gw, int NGW, int lane) {
    f32x4 gv[8];
#pragma unroll
    for (int j = 0; j < 8; ++j) gv[j] = ((const f32x4*)g)[lane + 64 * j];
    for (int m = gw; m < rows; m += NGW) {
        const f32x4* xr = (const f32x4*)(X + (size_t)m * DM) + lane; f32x4 v[8]; float s = 0.f;
#pragma unroll
        for (int j = 0; j < 8; ++j) { v[j] = xr[64 * j]; s += (v[j].x * v[j].x + v[j].y * v[j].y) + (v[j].z * v[j].z + v[j].w * v[j].w); }
        const float rstd = rsqrtf(wave_sum(s) * (1.f / DM) + EPS);
        u32x2* o8 = (u32x2*)(out + (size_t)m * DM) + lane;
#pragma unroll
        for (int j = 0; j < 8; ++j) { u32x2 w; w.x = cvt_pk_bf16(v[j].x * rstd * gv[j].x, v[j].y * rstd * gv[j].y); w.y = cvt_pk_bf16(v[j].z * rstd * gv[j].z, v[j].w * rstd * gv[j].w); o8[64 * j] = w; }
    }
}
template <int NJ, bool HEADS>
__device__ __forceinline__ void seg_norm(bf16_t* seg, const float* g, int n, int lane) {
    u32x2 w[NJ]; float s[NJ]; float tot = 0.f;
#pragma unroll
    for (int j = 0; j < NJ; ++j) { w[j] = ((const u32x2*)seg)[lane + 64 * j]; const float a = bflo(w[j].x), b = bfhi(w[j].x), c = bflo(w[j].y), d = bfhi(w[j].y); s[j] = (a * a + b * b) + (c * c + d * d); tot += s[j]; }
    float rs[NJ];
    if (HEADS) {
#pragma unroll
        for (int j = 0; j < NJ; ++j) rs[j] = rsqrtf(half_sum(s[j]) * (1.f / 128.f) + EPS);
    } else { const float r = rsqrtf(wave_sum(tot) / (float)n + EPS);
#pragma unroll
        for (int j = 0; j < NJ; ++j) rs[j] = r; }
#pragma unroll
    for (int j = 0; j < NJ; ++j) { const int gi = HEADS ? ((lane & 31) * 4) : (lane + 64 * j) * 4; const f32x4 gv = *(const f32x4*)(g + gi);
        u32x2 o; o.x = cvt_pk_bf16(bflo(w[j].x) * rs[j] * gv.x, bfhi(w[j].x) * rs[j] * gv.y); o.y = cvt_pk_bf16(bflo(w[j].y) * rs[j] * gv.z, bfhi(w[j].y) * rs[j] * gv.w);
        ((u32x2*)seg)[lane + 64 * j] = o; }
}

__device__ __forceinline__ u32x4 qk_head(u32x4 w, const float (&g)[8], bool r1, bool r2, int partner, const float (&cs)[8], const float (&sn)[8]) {
    float x[8] = {bflo(w.x), bfhi(w.x), bflo(w.y), bfhi(w.y), bflo(w.z), bfhi(w.z), bflo(w.w), bfhi(w.w)};
    float ss = 0.f;
#pragma unroll
    for (int j = 0; j < 8; ++j) ss += x[j] * x[j];
    const float rstd = rsqrtf(half_sum(ss) * (1.f / 192.f) + EPS);
#pragma unroll
    for (int j = 0; j < 8; ++j) x[j] = x[j] * rstd * g[j];
#pragma unroll
    for (int j = 0; j < 8; ++j) { const float pj = __shfl(x[j], partner); if (r1) x[j] = x[j] * cs[j] - pj * sn[j]; else if (r2) x[j] = x[j] * cs[j] + pj * sn[j]; }
    u32x4 o; o.x = cvt_pk_bf16(x[0], x[1]); o.y = cvt_pk_bf16(x[2], x[3]); o.z = cvt_pk_bf16(x[4], x[5]); o.w = cvt_pk_bf16(x[6], x[7]);
    return o;
}

#define XB_TMO      128
#define XB_XCNT(j)  (256  + 64 * (j))
#define XB_XSUB(j)  (1280 + 64 * (j))
#define XB_XGEN(j)  (2304 + 64 * (j))
#define XB_TOP      3328
#define XB_TOPGEN   3392
#define XCD_BAR_WORDS 3456
#define XB_SPIN_CAP (1u << 18)
__device__ __forceinline__ unsigned xb_ld(unsigned* p)              { return __hip_atomic_load(p, __ATOMIC_RELAXED, __HIP_MEMORY_SCOPE_AGENT); }
__device__ __forceinline__ unsigned xb_add(unsigned* p, unsigned v) { return __hip_atomic_fetch_add(p, v, __ATOMIC_RELAXED, __HIP_MEMORY_SCOPE_AGENT); }
__device__ __forceinline__ unsigned xb_xcc_id() { return (unsigned)__builtin_amdgcn_s_getreg((3 << 11) | 20) & 0xFu; }
#define XB_SPIN(cond, bar) do { unsigned _sp = 0; while (cond) { __builtin_amdgcn_s_sleep(1); \
    if ((++_sp & 255u) == 0u) { if (xb_ld(&(bar)[XB_TMO])) break; if (_sp > XB_SPIN_CAP) { atomicAdd(&(bar)[XB_TMO], 1u); break; } } } } while (0)
struct XcdBarrier { unsigned* bar; unsigned x; volatile LAS unsigned* st; };
__device__ __forceinline__ void xcd_barrier_complete(unsigned* bar, unsigned x, unsigned& nloc, unsigned& nx) {
    const unsigned G = gridDim.x * gridDim.y * gridDim.z;
    unsigned sum, cnt, mine, sp = 0u;
    for (;;) {
        sum = 0u; cnt = 0u; mine = 0u;
#pragma unroll
        for (unsigned j = 0; j < 16; ++j) { const unsigned c = xb_ld(&bar[XB_XCNT(j)]); sum += c; cnt += (c > 0u) ? 1u : 0u; mine = (j == x) ? c : mine; }
        if (sum == G) break;
        __builtin_amdgcn_s_sleep(1);
        if ((++sp & 255u) == 0u) { if (xb_ld(&bar[XB_TMO])) break; if (sp > XB_SPIN_CAP) { atomicAdd(&bar[XB_TMO], 1u); break; } }
    }
    nloc = mine > 0u ? mine : 1u; nx = cnt > 0u ? cnt : 1u;
}
__device__ __forceinline__ void xcd_barrier(const XcdBarrier& b) {
    asm volatile("s_waitcnt vmcnt(0)" ::: "memory");
    __syncthreads();
    if (threadIdx.x == 0) {
        unsigned* bar = b.bar;
        __builtin_amdgcn_s_waitcnt(0);
        unsigned nloc = b.st[0], nx = b.st[1];
        if (nloc == 0u) { xcd_barrier_complete(bar, b.x, nloc, nx); b.st[0] = nloc; b.st[1] = nx; }
        const unsigned old = xb_add(&bar[XB_XSUB(b.x)], 1u);
        const unsigned gen = old / nloc;
        if (old + 1u == (gen + 1u) * nloc) {
            __builtin_amdgcn_fence(__ATOMIC_RELEASE, "agent");
            asm volatile("s_waitcnt vmcnt(0)" ::: "memory");
            const unsigned og = xb_add(&bar[XB_TOP], 1u);
            const unsigned tg = og / nx;
            if (og + 1u == (tg + 1u) * nx) xb_add(&bar[XB_TOPGEN], 1u);
            else XB_SPIN(xb_ld(&bar[XB_TOPGEN]) == tg, bar);
            __builtin_amdgcn_fence(__ATOMIC_ACQUIRE, "agent");
            xb_add(&bar[XB_XGEN(b.x)], 1u);
            asm volatile("s_waitcnt vmcnt(0)" ::: "memory");
        } else {
            XB_SPIN(xb_ld(&bar[XB_XGEN(b.x)]) == gen, bar);
            __builtin_amdgcn_fence(__ATOMIC_ACQUIRE, "agent");
            asm volatile("s_waitcnt vmcnt(0)" ::: "memory");
        }
    }
    __syncthreads();
}
typedef __attribute__((address_space(4))) const Params CParams;
#define PHASE_BEGIN \
    CParams* P = (CParams*)__builtin_amdgcn_kernarg_segment_ptr(); asm volatile("" : "+s"(P)); \
    const int tid = my_tid(), lane = tid & 63, wave = __builtin_amdgcn_readfirstlane(tid >> 6); \
    const int G = gridDim.x, bx = blockIdx.x; const int gw = bx * 8 + wave, NGW = G * 8; \
    (void)lane; (void)gw; (void)NGW; \
    unsigned char* ws = P->ws; \
    unsigned* ctl = (unsigned*)(ws + WS_CTL); \
    bf16_t* Win0_t = (bf16_t*)(ws + WS_WIN0); bf16_t* Wqup_t = (bf16_t*)(ws + WS_WQUP); bf16_t* Wkvup_t = (bf16_t*)(ws + WS_WKVUP); bf16_t* Wout_t = (bf16_t*)(ws + WS_WOUT); \
    bf16_t* Wmi0_t = (bf16_t*)(ws + WS_A0); bf16_t* Wmo0_t = (bf16_t*)(ws + WS_A0 + 32 * MiB); bf16_t* Wmi1_t = (bf16_t*)(ws + WS_A1); bf16_t* Wmo1_t = (bf16_t*)(ws + WS_A1 + 32 * MiB); bf16_t* Wlru_t = (bf16_t*)(ws + WS_WLRU); bf16_t* Wmkv_t = (bf16_t*)(ws + WS_WMKV); bf16_t* Wg_t = (bf16_t*)(ws + WS_WG); \
    bf16_t* memn = (bf16_t*)(ws + WS_MEMN); float* mkv = (float*)(ws + WS_MKV); bf16_t* memK = (bf16_t*)(ws + WS_MEMK); bf16_t* memV = (bf16_t*)(ws + WS_MEMV); \
    float* rope = (float*)(ws + WS_ROPE); float* carryP = (float*)(ws + WS_CARRY); float* carryH = carryP + NB * NCHUNK * LRU_W; \
    bf16_t* xb = (bf16_t*)(ws + WS_S1); bf16_t* mixed0 = (bf16_t*)(ws + WS_A1); bf16_t* mixed1 = (bf16_t*)(ws + WS_A0); \
    float* ss0 = (float*)(ws + WS_SS); float* ss1 = ss0 + T; float* ss2 = ss1 + T; float* ss3 = ss2 + T; \
    bf16_t* proj0 = (bf16_t*)(ws + U_PROJ0); bf16_t* kvb = (bf16_t*)(ws + U_KV); bf16_t* Kb = (bf16_t*)(ws + U_K); bf16_t* Qb = (bf16_t*)P->out; \
    bf16_t* gateb = (bf16_t*)(ws + U_GATE); bf16_t* xinb = (bf16_t*)(ws + U_XIN); bf16_t* bscan = xinb; bf16_t* mqb = (bf16_t*)(ws + U_MQ); bf16_t* xcb = (bf16_t*)(ws + U_XC); bf16_t* ascan = (bf16_t*)(ws + U_A); \
    bf16_t* ub = (bf16_t*)(ws + WS_U); \
    float* clam = (float*)(ws + WS_CTL + 8192); \
    (void)0
__global__ void __launch_bounds__(512, 2) fwd_kernel(Params p) {
    extern __shared__ __attribute__((aligned(16))) unsigned char lds_raw[];
    LAS unsigned char* lds = (LAS unsigned char*)lds_raw;
    LAS int* s_item = (LAS int*)(lds + LDS_MISC);
    if (threadIdx.x < 64) ((LAS unsigned*)(lds + LDS_MISC))[threadIdx.x] = 0u;
    __syncthreads();
    cg::grid_group grid = cg::this_grid();
    const int lo = p.ph_lo, hi = p.ph_hi;
    if (hi > NPHASE + 7) grid.sync();
    if (hi - lo > 1 && threadIdx.x == 0) (void)xb_add((unsigned*)(p.ws + WS_CTL) + 4096 + XB_XCNT(xb_xcc_id()), 1u);
#ifndef PHMASK
#define PHMASK 0xFFFFF
#endif
#ifndef REPMASK
#define REPMASK 0
#endif
#define PH(k) if (((PHMASK >> (k)) & 1) && lo <= (k) && (k) < hi) for (int rep_ = 0; rep_ < 1 + ((REPMASK >> (k)) & 1); ++rep_)
#define SEAM(k) do { if (lo <= (k) && (k) + 1 < hi) { CParams* P_ = (CParams*)__builtin_amdgcn_kernarg_segment_ptr(); asm volatile("" : "+s"(P_)); \
        XcdBarrier b_; b_.bar = (unsigned*)(P_->ws + WS_CTL) + 4096; b_.x = xb_xcc_id(); b_.st = (volatile LAS unsigned*)(lds + LDS_MISC + 32); xcd_barrier(b_); } } while (0)

    PH(0) { PHASE_BEGIN; if (rep_) grid.sync();
        if (bx == 0 && tid < 64) ctl[tid] = 0u;
        if (bx == 1) for (int c = tid; c < LRU_W; c += 512) clam[c] = -8.0f * log1pf(expf(-P->lru_lambda[c]));
        LAS float* scr = (LAS float*)(lds + wave * TR_SCR_BYTES);
        constexpr int NITEMS = 2 * (2048 / 64) * (8192 / 64) + (2048 / 64) * (1856 / 64) + (768 / 64) * (2304 / 64) + (512 / 64) * (3072 / 64) + 2 * (2048 / 64) * (2048 / 64)
                             + (2048 / 64) * (3584 / 64) + (2048 / 64) * (1024 / 64) + 2 * 48;
#define P0_SELECT(it_, t) do { int r = (it_); \
            if (tr_job(r, P->w_mlp_in, 2048, 8192, Wmi0_t, P->mlp_norm, t)) {} \
            else if (tr_job(r, P->w_mlp_out, 8192, 2048, Wmo0_t, nullptr, t)) {} \
            else if (tr_job(r, P->w_in_mla, 2048, 1856, Win0_t, P->mix_norm, t)) {} \
            else if (tr_job(r, P->w_q_up, 768, 2304, Wqup_t, nullptr, t)) {} \
            else if (tr_job(r, P->w_kv_up, 512, 3072, Wkvup_t, nullptr, t)) {} \
            else if (tr_job(r, P->w_out, 2048, 2048, Wout_t, nullptr, t)) {} \
            else if (tr_job(r, P->w_out + (size_t)2048 * 2048, 2048, 2048, Wout_t + (size_t)2048 * 2048, nullptr, t)) {} \
            else if (tr_job(r, P->w_in_lru, 2048, 3584, Wlru_t, P->mix_norm + DM, t)) {} \
            else if (tr_job(r, P->w_mem_kv, 2048, 1024, Wmkv_t, nullptr, t)) {} \
            else if (tr_gate_job(r, P->w_gate_a, 0, Wg_t, t)) {} \
            else tr_gate_job(r, P->w_gate_i, 128, Wg_t, t); } while (0)
        { int it = gw; TrSel cur, nx; f32x4 v[16], nv[16]; float gg[16], ng[16];
          if (it < NITEMS) { P0_SELECT(it, cur); tr_load(cur, lane, v, gg); }
          while (it < NITEMS) { const int nit = it + NGW;
              if (nit < NITEMS) { P0_SELECT(nit, nx); tr_load(nx, lane, nv, ng); }
              asm volatile("" ::: "memory");
              tr_store(cur, v, gg, scr, lane);
              asm volatile("" ::: "memory");
              cur = nx; it = nit;
#pragma unroll
              for (int i = 0; i < 16; ++i) { v[i] = nv[i]; gg[i] = ng[i]; } } }
#undef P0_SELECT
        { u32x4* z = (u32x4*)(Win0_t + (size_t)MLA_IN * 2048); const int n16 = (MLA_INP - MLA_IN) * 2048 * 2 / 16;
          for (int i = bx * 512 + tid; i < n16; i += G * 512) z[i] = (u32x4){0u, 0u, 0u, 0u}; }
        for (int i = bx * 512 + tid; i < 3 * T; i += G * 512) ss1[i] = 0.f;
        cvt_rows(P->x, xb, ss0, T, gw, NGW, lane);
        norm_rows(P->mem, P->mem_norm, memn, NB * MEML, gw, NGW, lane);
        for (int i = bx * 512 + tid; i < T * 32; i += G * 512) { const int m = i >> 5, f = i & 31; const float inv = powf(10000.f, -(float)f / 32.f); const float ang = (float)P->pos[m] * inv;
            rope[(size_t)m * 64 + f] = cosf(ang); rope[(size_t)m * 64 + 32 + f] = sinf(ang); }
    }
    SEAM(0);
    PH(1) { PHASE_BEGIN;
        pg8::Gemm g{xb, Win0_t, T, MLA_INP, 2048, 2048, 2048, 0}; pg8::StaticOrder S; S.init(T, MLA_INP, G, bx);
        pg8::EpiBf16<0> E{proj0, proj0, proj0, 2048, 2048, 2048, 1 << 20, 1 << 20, ss0};
        pg8::gemm_phase<pg8::EpiBf16<0>, true>(lds, g, S, E);
    }
    SEAM(1);
    PH(2) { PHASE_BEGIN;
        f32x4 gq_[3], gkv_[2]; const f32x4 gm_ = *(const f32x4*)(P->mem_q_norm + (lane & 31) * 4);
#pragma unroll
        for (int j = 0; j < 3; ++j) gq_[j] = *(const f32x4*)(P->q_lat_norm + (lane + 64 * j) * 4);
#pragma unroll
        for (int j = 0; j < 2; ++j) gkv_[j] = *(const f32x4*)(P->kv_lat_norm + (lane + 64 * j) * 4);
        u32x2 w[7], nw[7]; int m = gw;
#define P2_LOAD(dst, mm) do { const u32x2* r_ = (const u32x2*)(proj0 + (size_t)(mm) * 2048); \
            dst[0] = r_[lane]; dst[1] = r_[lane + 64]; dst[2] = r_[lane + 128]; dst[3] = r_[192 + lane]; dst[4] = r_[192 + lane + 64]; dst[5] = r_[336 + lane]; dst[6] = r_[336 + lane + 64]; } while (0)
        if (m < T) P2_LOAD(w, m);
        for (; m < T; m += NGW) {
            if (m + NGW < T) P2_LOAD(nw, m + NGW);
            asm volatile("" ::: "memory");
            float sq[7];
#pragma unroll
            for (int j = 0; j < 7; ++j) { const float a = bflo(w[j].x), b = bfhi(w[j].x), c = bflo(w[j].y), d = bfhi(w[j].y); sq[j] = (a * a + b * b) + (c * c + d * d); }
            const float rq = rsqrtf(wave_sum(sq[0] + sq[1] + sq[2]) * (1.f / 768.f) + EPS), rkv = rsqrtf(wave_sum(sq[3] + sq[4]) * (1.f / 512.f) + EPS);
            const float rm0 = rsqrtf(half_sum(sq[5]) * (1.f / 128.f) + EPS), rm1 = rsqrtf(half_sum(sq[6]) * (1.f / 128.f) + EPS);
            u32x2* r_ = (u32x2*)(proj0 + (size_t)m * 2048);
#define P2_ST(idx, j, rs, gv) do { u32x2 o_; o_.x = cvt_pk_bf16(bflo(w[j].x) * (rs) * (gv).x, bfhi(w[j].x) * (rs) * (gv).y); o_.y = cvt_pk_bf16(bflo(w[j].y) * (rs) * (gv).z, bfhi(w[j].y) * (rs) * (gv).w); r_[idx] = o_; } while (0)
            P2_ST(lane, 0, rq, gq_[0]); P2_ST(lane + 64, 1, rq, gq_[1]); P2_ST(lane + 128, 2, rq, gq_[2]);
            P2_ST(192 + lane, 3, rkv, gkv_[0]); P2_ST(192 + lane + 64, 4, rkv, gkv_[1]);
            P2_ST(336 + lane, 5, rm0, gm_); P2_ST(336 + lane + 64, 6, rm1, gm_);
            asm volatile("" ::: "memory");
#pragma unroll
            for (int j = 0; j < 7; ++j) w[j] = nw[j];
        }
#undef P2_LOAD
#undef P2_ST
    }
    SEAM(2);
    PH(3) { PHASE_BEGIN;
        { pg8::Gemm g{proj0 + QLORA, Wkvup_t, T, KVW, KVLORA, 2048, KVLORA, 0}; pg8::StaticOrder S; S.init(T, KVW, G, bx);
          pg8::EpiBf16<0> E{kvb, kvb, kvb, KVW, KVW, KVW, 1 << 20, 1 << 20, nullptr}; pg8::gemm_phase<pg8::EpiBf16<0>, true>(lds, g, S, E); }
        { pg8::Gemm g{proj0, Wqup_t, T, QW, QLORA, 2048, QLORA, 0}; pg8::StaticOrder S; S.init(T, QW, G, bx);
          pg8::EpiBf16<0> E{Qb, Qb, Qb, QW, QW, QW, 1 << 20, 1 << 20, nullptr}; pg8::gemm_phase<pg8::EpiBf16<0>, true>(lds, g, S, E); }
        { pg8::Gemm g{memn, Wmkv_t, NB * MEML, 1024, 2048, 2048, 2048, 0}; pg8::StaticOrder S; S.init(NB * MEML, 1024, G, (bx + G - 64) % G);
          pg8::EpiRes E{nullptr, nullptr, mkv, nullptr, nullptr, 1024}; pg8::gemm_phase<pg8::EpiRes, true>(lds, g, S, E); }
    }
    SEAM(3);
    PH(4) { PHASE_BEGIN;
        const int half = lane >> 5, L = lane & 31; const bool act = L < 24, r1 = (L >= 16 && L < 20), r2 = (L >= 20 && L < 24);
        const int partner = r1 ? lane + 4 : (r2 ? lane - 4 : lane);
        float gq[8], gk[8];
#pragma unroll
        for (int j = 0; j < 8; ++j) { gq[j] = act ? P->q_norm[L * 8 + j] : 0.f; gk[j] = act ? P->k_norm[L * 8 + j] : 0.f; }
        for (int m = gw; m < T; m += NGW) {
            float cs[8], sn[8];
            { const int i0 = ((L - 16) & 3) * 8;
#pragma unroll
              for (int j = 0; j < 8; ++j) { cs[j] = rope[(size_t)m * 64 + i0 + j]; sn[j] = rope[(size_t)m * 64 + 32 + i0 + j]; } }
            bf16_t* qrow = Qb + (size_t)m * QW + L * 8; bf16_t* krow = Kb + (size_t)m * QW + L * 8;
            const bf16_t* ksrc = (L < 16) ? kvb + (size_t)m * KVW + L * 8 : proj0 + (size_t)m * 2048 + 1280 + (L - 16) * 8; const int kstep = (L < 16) ? 256 : 0;
            const u32x4 zero4 = {0u, 0u, 0u, 0u};
            u32x4 wq = act ? *(const u32x4*)(qrow + half * QKD) : zero4, wk = act ? *(const u32x4*)(ksrc + half * kstep) : zero4;
#pragma unroll 1
            for (int i = 0; i < 6; ++i) { const int h = 2 * i + half; u32x4 nq = zero4, nk = zero4;
                if (i < 5 && act) { nq = *(const u32x4*)(qrow + (h + 2) * QKD); nk = *(const u32x4*)(ksrc + (h + 2) * kstep); }
                asm volatile("" ::: "memory");
                const u32x4 oq = qk_head(wq, gq, r1, r2, partner, cs, sn), ok = qk_head(wk, gk, r1, r2, partner, cs, sn);
                if (act) { *(u32x4*)(qrow + h * QKD) = oq; *(u32x4*)(krow + h * QKD) = ok; }
                asm volatile("" ::: "memory");
                wq = nq; wk = nk; }
        }
        for (int m = gw; m < NB * MEML; m += NGW) { const float* r = mkv + (size_t)m * 1024;
            const f32x4 k0 = *(const f32x4*)(r + lane * 8), k1 = *(const f32x4*)(r + lane * 8 + 4), v0 = *(const f32x4*)(r + 512 + lane * 8), v1 = *(const f32x4*)(r + 512 + lane * 8 + 4);
            float ss = (k0.x * k0.x + k0.y * k0.y) + (k0.z * k0.z + k0.w * k0.w) + (k1.x * k1.x + k1.y * k1.y) + (k1.z * k1.z + k1.w * k1.w);
#pragma unroll
            for (int o = 1; o < 16; o <<= 1) ss += __shfl_xor(ss, o);
            const float rstd = rsqrtf(ss * (1.f / 128.f) + EPS); const float* gk2 = P->mem_k_norm + (lane & 15) * 8;
            u32x4 ok, ov; ok.x = cvt_pk_bf16(k0.x * rstd * gk2[0], k0.y * rstd * gk2[1]); ok.y = cvt_pk_bf16(k0.z * rstd * gk2[2], k0.w * rstd * gk2[3]);
            ok.z = cvt_pk_bf16(k1.x * rstd * gk2[4], k1.y * rstd * gk2[5]); ok.w = cvt_pk_bf16(k1.z * rstd * gk2[6], k1.w * rstd * gk2[7]);
            ov.x = cvt_pk_bf16(v0.x, v0.y); ov.y = cvt_pk_bf16(v0.z, v0.w); ov.z = cvt_pk_bf16(v1.x, v1.y); ov.w = cvt_pk_bf16(v1.z, v1.w);
            *(u32x4*)(memK + (size_t)m * 512 + lane * 8) = ok; *(u32x4*)(memV + (size_t)m * 512 + lane * 8) = ov; }
    }
    SEAM(4);
    PH(5) { PHASE_BEGIN; if (rep_) grid.sync();
        const int x0 = (int)(xb_xcc_id() & 7u);
        for (int qi = 0; qi < 8; ++qi) { const int q = (x0 + qi) & 7;
            for (;;) {
                if (tid == 0) *s_item = (int)atomicAdd(ctl + 8 * q, 1u);
                __syncthreads(); const int li = *s_item; __syncthreads();
                if (li >= 128) break;
                if (li < 96) { const int qb = 31 - li / 3, bh = q + 8 * (li % 3), b = bh / NHEAD, h = bh % NHEAD; const size_t r0 = (size_t)b * SEQ;
                    att::attn_block<192, true>(Qb + (r0 + qb * 256) * QW + h * QKD, QW, Kb + r0 * QW + h * QKD, QW, kvb + r0 * KVW + h * 256 + 128, KVW,
                                               mixed0 + (r0 + qb * 256) * DM + h * 128, DM, qb * 256, 4 * (qb + 1), 0.07216878364870322f, (LAS char*)lds);
                } else { const int i2 = q * 32 + (li - 96), qb = i2 & 31, mh = (i2 >> 5) & 3, b = i2 >> 7; const size_t r0 = (size_t)b * SEQ;
                    att::attn_block<128, false>(proj0 + (r0 + qb * 256) * 2048 + 1344 + mh * 128, 2048, memK + (size_t)b * MEML * 512 + mh * 128, 512, memV + (size_t)b * MEML * 512 + mh * 128, 512,
                                                mixed0 + (r0 + qb * 256) * DM + LRU_W + mh * 128, DM, 0, 4, 0.08838834764831845f, (LAS char*)lds); }
            } }
    }
    SEAM(5);
    PH(6) { PHASE_BEGIN;
        pg8::Gemm g{mixed0, Wout_t, T, DM, DM, DM, DM, 0}; pg8::StaticOrder S; S.init(T, DM, G, bx);
        pg8::EpiRes E{P->x, nullptr, nullptr, xb, ss1, DM}; pg8::gemm_phase<pg8::EpiRes, true>(lds, g, S, E);
    }
    SEAM(6);
    PH(8) { PHASE_BEGIN; if (rep_) grid.sync();
        pg8::Gemm g{xb, Wmi0_t, T, DFF, DM, DM, DM, 0}; pg8::StaticOrder S; S.init(T, DFF, G, bx);
        pg8::EpiBf16<1> E{ub, ub, ub, DFF, DFF, DFF, 1 << 20, 1 << 20, ss1}; pg8::gemm_phase<pg8::EpiBf16<1>, true>(lds, g, S, E);
    }
    SEAM(8);
    PH(9) { PHASE_BEGIN;
        pg8::Gemm g{ub, Wmo0_t, T, DM, DFF, DFF, DFF, 0}; pg8::StaticOrder S; S.init(T, DM, G, bx);
        pg8::EpiRes E{nullptr, xb, nullptr, xb, ss2, DM}; pg8::gemm_phase<pg8::EpiRes, true>(lds, g, S, E);
    }
    SEAM(9);
    PH(11) { PHASE_BEGIN;
        pg8::Gemm g{xb, Wlru_t, T, LRU_IN, DM, DM, DM, 0}; pg8::StaticOrder S; S.init(T, LRU_IN, G, bx);
        pg8::EpiBf16<2> E{gateb, xinb, mqb, LRU_W, LRU_W, 512, 6, 12, ss2}; pg8::gemm_phase<pg8::EpiBf16<2>, true>(lds, g, S, E);
    }
    SEAM(11);
    PH(12) { PHASE_BEGIN;
        { LAS float* scr = (LAS float*)(lds + wave * TR_SCR_BYTES); constexpr int NIT1 = 2 * (2048 / 64) * (8192 / 64);
#define P12_SELECT(it_, t) do { int r = (it_); if (tr_job(r, P->w_mlp_in + (size_t)2048 * 8192, 2048, 8192, Wmi1_t, P->mlp_norm + DM, t)) {} \
              else tr_job(r, P->w_mlp_out + (size_t)2048 * 8192, 8192, 2048, Wmo1_t, nullptr, t); } while (0)
          int it = gw; TrSel cur, nx; f32x4 v[16], nv[16]; float gg[16], ng[16];
          if (it < NIT1) { P12_SELECT(it, cur); tr_load(cur, lane, v, gg); }
          while (it < NIT1) { const int nit = it + NGW;
              if (nit < NIT1) { P12_SELECT(nit, nx); tr_load(nx, lane, nv, ng); }
              asm volatile("" ::: "memory");
              tr_store(cur, v, gg, scr, lane);
              asm volatile("" ::: "memory");
              cur = nx; it = nit;
#pragma unroll
              for (int i = 0; i < 16; ++i) { v[i] = nv[i]; gg[i] = ng[i]; } } }
#undef P12_SELECT
        for (int item = gw; item < (T / 32) * 3; item += NGW) { const int third = item % 3, m0 = (item / 3) * 32; const int c0 = third * 512 + lane * 8;
            float wt[4][8], bs[8];
#pragma unroll
            for (int k = 0; k < 4; ++k) { const f32x4 w0 = *(const f32x4*)(P->conv_w + k * LRU_W + c0), w1 = *(const f32x4*)(P->conv_w + k * LRU_W + c0 + 4);
                wt[k][0] = w0.x; wt[k][1] = w0.y; wt[k][2] = w0.z; wt[k][3] = w0.w; wt[k][4] = w1.x; wt[k][5] = w1.y; wt[k][6] = w1.z; wt[k][7] = w1.w; }
            { const f32x4 b0 = *(const f32x4*)(P->conv_b + c0), b1 = *(const f32x4*)(P->conv_b + c0 + 4); bs[0] = b0.x; bs[1] = b0.y; bs[2] = b0.z; bs[3] = b0.w; bs[4] = b1.x; bs[5] = b1.y; bs[6] = b1.z; bs[7] = b1.w; }
            const bf16_t* xp = xinb + c0; u32x4 win[3], cur[4], nxt[4];
#pragma unroll
            for (int k = 0; k < 3; ++k) { const int mm = m0 - 3 + k; win[k] = *(const u32x4*)(xp + (size_t)(mm < 0 ? 0 : mm) * LRU_W); }
#pragma unroll
            for (int k = 0; k < 4; ++k) cur[k] = *(const u32x4*)(xp + (size_t)(m0 + k) * LRU_W);
#pragma unroll 1
            for (int g = 0; g < 8; ++g) { const int mg = m0 + 4 * g;
                if (g < 7) {
#pragma unroll
                    for (int k = 0; k < 4; ++k) nxt[k] = *(const u32x4*)(xp + (size_t)(mg + 4 + k) * LRU_W); }
                asm volatile("" ::: "memory");
                u32x4 outv[4];
#pragma unroll
                for (int r = 0; r < 4; ++r) { const int sidx = (mg + r) & (SEQ - 1); float acc[8];
#pragma unroll
                    for (int e = 0; e < 8; ++e) acc[e] = bs[e];
#pragma unroll
                    for (int k = 0; k < 4; ++k) { const int wi = r + k; const u32x4 xv = wi < 3 ? win[wi] : cur[wi - 3];
                        if (sidx - 3 + k >= 0) { acc[0] += wt[k][0] * bflo(xv.x); acc[1] += wt[k][1] * bfhi(xv.x); acc[2] += wt[k][2] * bflo(xv.y); acc[3] += wt[k][3] * bfhi(xv.y);
                                                 acc[4] += wt[k][4] * bflo(xv.z); acc[5] += wt[k][5] * bfhi(xv.z); acc[6] += wt[k][6] * bflo(xv.w); acc[7] += wt[k][7] * bfhi(xv.w); } }
                    outv[r].x = cvt_pk_bf16(acc[0], acc[1]); outv[r].y = cvt_pk_bf16(acc[2], acc[3]); outv[r].z = cvt_pk_bf16(acc[4], acc[5]); outv[r].w = cvt_pk_bf16(acc[6], acc[7]); }
#pragma unroll
                for (int r = 0; r < 4; ++r) *(u32x4*)(xcb + (size_t)(mg + r) * LRU_W + c0) = outv[r];
                asm volatile("" ::: "memory");
                win[0] = cur[1]; win[1] = cur[2]; win[2] = cur[3];
#pragma unroll
                for (int k = 0; k < 4; ++k) cur[k] = nxt[k]; } }
        { const f32x4 gm_ = *(const f32x4*)(P->mem_q_norm + 128 + (lane & 31) * 4); u32x2 w0, w1, n0, n1; int m = gw;
          if (m < T) { const u32x2* r_ = (const u32x2*)(mqb + (size_t)m * 512); w0 = r_[lane]; w1 = r_[lane + 64]; }
          for (; m < T; m += NGW) {
              if (m + NGW < T) { const u32x2* r_ = (const u32x2*)(mqb + (size_t)(m + NGW) * 512); n0 = r_[lane]; n1 = r_[lane + 64]; }
              asm volatile("" ::: "memory");
              float s0, s1; { const float a = bflo(w0.x), b = bfhi(w0.x), c = bflo(w0.y), d = bfhi(w0.y); s0 = (a * a + b * b) + (c * c + d * d); }
              { const float a = bflo(w1.x), b = bfhi(w1.x), c = bflo(w1.y), d = bfhi(w1.y); s1 = (a * a + b * b) + (c * c + d * d); }
              const float r0 = rsqrtf(half_sum(s0) * (1.f / 128.f) + EPS), r1 = rsqrtf(half_sum(s1) * (1.f / 128.f) + EPS);
              u32x2* r_ = (u32x2*)(mqb + (size_t)m * 512); u32x2 o;
              o.x = cvt_pk_bf16(bflo(w0.x) * r0 * gm_.x, bfhi(w0.x) * r0 * gm_.y); o.y = cvt_pk_bf16(bflo(w0.y) * r0 * gm_.z, bfhi(w0.y) * r0 * gm_.w); r_[lane] = o;
              o.x = cvt_pk_bf16(bflo(w1.x) * r1 * gm_.x, bfhi(w1.x) * r1 * gm_.y); o.y = cvt_pk_bf16(bflo(w1.y) * r1 * gm_.z, bfhi(w1.y) * r1 * gm_.w); r_[lane + 64] = o;
              asm volatile("" ::: "memory");
              w0 = n0; w1 = n1; } }
    }
    SEAM(12);
    PH(13) { PHASE_BEGIN;
        pg8::Gemm g{xcb, Wg_t, T, 12 * 256, 128, LRU_W, 128, 256}; pg8::StaticOrder S; S.init(T, 12 * 256, G, bx);
        pg8::EpiGates E{P->b_gate_a, P->b_gate_i, clam, ascan, bscan, (LAS float*)(lds + LDS_MISC + 256)}; pg8::gemm_phase<pg8::EpiGates, true>(lds, g, S, E);
    }
    SEAM(13);
    PH(14) { PHASE_BEGIN;
        for (int it = bx; it < NB * NCHUNK; it += G) { const int ch = it % NCHUNK, b = it / NCHUNK;
            if (tid < LRU_W / 4) { const int c = tid * 4; const size_t base = ((size_t)b * SEQ + (size_t)ch * CHL) * LRU_W + c; float h[4] = {0.f, 0.f, 0.f, 0.f}, Pp[4] = {1.f, 1.f, 1.f, 1.f};
#pragma unroll 8
                for (int s = 0; s < CHL; ++s) { const u32x2 aw = *(const u32x2*)(ascan + base + (size_t)s * LRU_W), bw = *(const u32x2*)(bscan + base + (size_t)s * LRU_W), xw = *(const u32x2*)(xcb + base + (size_t)s * LRU_W);
                    const float av[4] = {1.f - bflo(aw.x), 1.f - bfhi(aw.x), 1.f - bflo(aw.y), 1.f - bfhi(aw.y)}, bv[4] = {bflo(bw.x) * bflo(xw.x), bfhi(bw.x) * bfhi(xw.x), bflo(bw.y) * bflo(xw.y), bfhi(bw.y) * bfhi(xw.y)};
#pragma unroll
                    for (int j = 0; j < 4; ++j) { h[j] = av[j] * h[j] + bv[j]; Pp[j] *= av[j]; } }
                *(f32x4*)(carryP + ((size_t)b * NCHUNK + ch) * LRU_W + c) = (f32x4){Pp[0], Pp[1], Pp[2], Pp[3]}; *(f32x4*)(carryH + ((size_t)b * NCHUNK + ch) * LRU_W + c) = (f32x4){h[0], h[1], h[2], h[3]}; } }
        for (int i2 = bx; i2 < NB * 4 * 32; i2 += G) { const int qb = i2 & 31, mh = (i2 >> 5) & 3, b = i2 >> 7; const size_t r0 = (size_t)b * SEQ;
            att::attn_block<128, false>(mqb + (r0 + qb * 256) * 512 + mh * 128, 512, memK + (size_t)b * MEML * 512 + mh * 128, 512, memV + (size_t)b * MEML * 512 + mh * 128, 512,
                                        mixed1 + (r0 + qb * 256) * DM + LRU_W + mh * 128, DM, 0, 4, 0.08838834764831845f, (LAS char*)lds); }
    }
    SEAM(14);
    PH(15) { PHASE_BEGIN;
        for (int it = bx; it < NB * NCHUNK; it += G) { const int ch = it % NCHUNK, b = it / NCHUNK;
            if (tid < LRU_W / 4) { const int c = tid * 4; float h[4] = {0.f, 0.f, 0.f, 0.f};
#pragma unroll 4
                for (int j = 0; j < ch; ++j) { const size_t ci = ((size_t)b * NCHUNK + j) * LRU_W + c; const f32x4 cp = *(const f32x4*)(carryP + ci), chh = *(const f32x4*)(carryH + ci);
                    h[0] = cp.x * h[0] + chh.x; h[1] = cp.y * h[1] + chh.y; h[2] = cp.z * h[2] + chh.z; h[3] = cp.w * h[3] + chh.w; }
                const size_t row0 = (size_t)b * SEQ + (size_t)ch * CHL;
                u32x2 ca[8], cb[8], cg_[8], cx[8], na[8], nb[8], ng[8], nx_[8];
#pragma unroll
                for (int j = 0; j < 8; ++j) { const size_t off = (row0 + j) * LRU_W + c; ca[j] = *(const u32x2*)(ascan + off); cb[j] = *(const u32x2*)(bscan + off); cg_[j] = *(const u32x2*)(gateb + off); cx[j] = *(const u32x2*)(xcb + off); }
#pragma unroll 1
                for (int s0 = 0; s0 < CHL; s0 += 8) {
                    if (s0 + 8 < CHL) {
#pragma unroll
                        for (int j = 0; j < 8; ++j) { const size_t off = (row0 + s0 + 8 + j) * LRU_W + c; na[j] = *(const u32x2*)(ascan + off); nb[j] = *(const u32x2*)(bscan + off); ng[j] = *(const u32x2*)(gateb + off); nx_[j] = *(const u32x2*)(xcb + off); } }
                    asm volatile("" ::: "memory");
                    u32x2 y[8];
#pragma unroll
                    for (int j = 0; j < 8; ++j) { h[0] = (1.f - bflo(ca[j].x)) * h[0] + bflo(cb[j].x) * bflo(cx[j].x); h[1] = (1.f - bfhi(ca[j].x)) * h[1] + bfhi(cb[j].x) * bfhi(cx[j].x);
                        h[2] = (1.f - bflo(ca[j].y)) * h[2] + bflo(cb[j].y) * bflo(cx[j].y); h[3] = (1.f - bfhi(ca[j].y)) * h[3] + bfhi(cb[j].y) * bfhi(cx[j].y);
                        y[j].x = cvt_pk_bf16(h[0] * bflo(cg_[j].x), h[1] * bfhi(cg_[j].x)); y[j].y = cvt_pk_bf16(h[2] * bflo(cg_[j].y), h[3] * bfhi(cg_[j].y)); }
#pragma unroll
                    for (int j = 0; j < 8; ++j) *(u32x2*)(mixed1 + (row0 + s0 + j) * DM + c) = y[j];
                    asm volatile("" ::: "memory");
#pragma unroll
                    for (int j = 0; j < 8; ++j) { ca[j] = na[j]; cb[j] = nb[j]; cg_[j] = ng[j]; cx[j] = nx_[j]; }
                } } }
    }
    SEAM(15);
    PH(16) { PHASE_BEGIN;
        pg8::Gemm g{mixed1, Wout_t + (size_t)DM * DM, T, DM, DM, DM, DM, 0}; pg8::StaticOrder S; S.init(T, DM, G, bx);
        pg8::EpiRes E{nullptr, xb, nullptr, xb, ss3, DM}; pg8::gemm_phase<pg8::EpiRes, true>(lds, g, S, E);
    }
    SEAM(16);
    PH(18) { PHASE_BEGIN;
        pg8::Gemm g{xb, Wmi1_t, T, DFF, DM, DM, DM, 0}; pg8::StaticOrder S; S.init(T, DFF, G, bx);
        pg8::EpiBf16<1> E{ub, ub, ub, DFF, DFF, DFF, 1 << 20, 1 << 20, ss3}; pg8::gemm_phase<pg8::EpiBf16<1>, true>(lds, g, S, E);
    }
    SEAM(18);
    PH(19) { PHASE_BEGIN;
        pg8::Gemm g{ub, Wmo1_t, T, DM, DFF, DFF, DFF, 0}; pg8::StaticOrder S; S.init(T, DM, G, bx);
        pg8::EpiRes E{nullptr, xb, P->out, nullptr, nullptr, DM}; pg8::gemm_phase<pg8::EpiRes, true>(lds, g, S, E);
    }
#undef PH
#undef SEAM
}

#ifndef ONE_LAUNCH
#define ONE_LAUNCH 1
#endif
extern "C" void kernel_launch(void* const* d_in, const int* in_sizes, int n_in, void* d_out, int out_size, void* d_ws, size_t ws_size, hipStream_t stream) {
    static int grid = 0;
    if (grid == 0) {
        if (n_in != 27 || ws_size < WS_END) { fprintf(stderr, "kernel_launch: unexpected n_in %d / ws_size %zu\n", n_in, ws_size); grid = -1; return; }
        int dev = 0, cus = 0, per_cu = 0;
        hipGetDevice(&dev); hipDeviceGetAttribute(&cus, hipDeviceAttributeMultiprocessorCount, dev);
        hipFuncSetAttribute((const void*)fwd_kernel, hipFuncAttributeMaxDynamicSharedMemorySize, LDS_TOTAL);
        hipOccupancyMaxActiveBlocksPerMultiprocessor(&per_cu, (const void*)fwd_kernel, 512, LDS_TOTAL);
        if (per_cu < 1) { fprintf(stderr, "kernel_launch: occupancy query says %d blocks per CU\n", per_cu); per_cu = 1; }
        (void)hipGetLastError();
        grid = cus;
    }
    if (grid < 0) return;
    Params p{};
    p.x = (const float*)d_in[0]; p.mem = (const float*)d_in[1]; p.pos = (const int*)d_in[2];
    p.mix_norm = (const float*)d_in[3]; p.mlp_norm = (const float*)d_in[4]; p.w_out = (const float*)d_in[5]; p.w_mlp_in = (const float*)d_in[6]; p.w_mlp_out = (const float*)d_in[7];
    p.mem_norm = (const float*)d_in[8]; p.w_mem_kv = (const float*)d_in[9]; p.mem_k_norm = (const float*)d_in[10]; p.mem_q_norm = (const float*)d_in[11]; p.w_in_mla = (const float*)d_in[12];
    p.q_lat_norm = (const float*)d_in[13]; p.w_q_up = (const float*)d_in[14]; p.kv_lat_norm = (const float*)d_in[15]; p.w_kv_up = (const float*)d_in[16]; p.q_norm = (const float*)d_in[17];
    p.k_norm = (const float*)d_in[18]; p.w_in_lru = (const float*)d_in[19]; p.conv_w = (const float*)d_in[20]; p.conv_b = (const float*)d_in[21]; p.w_gate_a = (const float*)d_in[22];
    p.b_gate_a = (const float*)d_in[23]; p.w_gate_i = (const float*)d_in[24]; p.b_gate_i = (const float*)d_in[25]; p.lru_lambda = (const float*)d_in[26];
    p.out = (float*)d_out; p.ws = (unsigned char*)d_ws;
#if ONE_LAUNCH
    (void)hipMemsetAsync((char*)d_ws + WS_CTL + 16384, 0, 16384, stream);
    p.ph_lo = 0; p.ph_hi = NPHASE;
    void* args[] = {&p};
    hipError_t e = hipLaunchCooperativeKernel((const void*)fwd_kernel, dim3(grid), dim3(512), args, LDS_TOTAL, stream);
    if (e != hipSuccess) fprintf(stderr, "cooperative launch failed: %s (grid %d)\n", hipGetErrorString(e), grid);
#else
    for (int k = 0; k < NPHASE; ++k) { p.ph_lo = k; p.ph_hi = k + 1; hipLaunchKernelGGL(fwd_kernel, dim3(grid), dim3(512), LDS_TOTAL, stream, p); }
#endif
}
```

```cpp
#include <hip/hip_runtime.h>
#include <hip/hip_cooperative_groups.h>
#include <cstdio>
#include <cstdint>
namespace cg = cooperative_groups;

#define LAS __attribute__((address_space(3)))
typedef unsigned short bf16_t;
typedef short bf16x8 __attribute__((ext_vector_type(8)));
typedef short s16x4 __attribute__((ext_vector_type(4)));
typedef float f32x4 __attribute__((ext_vector_type(4)));
typedef float f32x16 __attribute__((ext_vector_type(16)));
typedef unsigned u32x4 __attribute__((ext_vector_type(4)));
typedef unsigned u32x2 __attribute__((ext_vector_type(2)));

constexpr int DM = 2048, SEQ = 8192, NB = 2, T = NB * SEQ, MEML = 256;
constexpr int MLA_IN = 1856, MLA_INP = 2048, QLORA = 768, KVLORA = 512, NHEAD = 12, QKD = 192, LRU_W = 1536, LRU_IN = 3584, DFF = 8192;
constexpr int QW = NHEAD * QKD  , KVW = NHEAD * 256  ;
constexpr float EPS = 1e-6f;
constexpr int NCHUNK = 128, CHL = 64;

constexpr size_t MiB = 1u << 20;
constexpr size_t WS_CTL = 0;
constexpr size_t WS_SS = 256 * 1024;
constexpr size_t WS_WIN0 = 1 * MiB;
constexpr size_t WS_WQUP = WS_WIN0 + 8 * MiB;
constexpr size_t WS_WKVUP = WS_WQUP + 3456 * 1024;
constexpr size_t WS_WOUT = WS_WKVUP + 3 * MiB;
constexpr size_t WS_WLRU = WS_WOUT + 16 * MiB;
constexpr size_t WS_WMKV = WS_WLRU + 14 * MiB;
constexpr size_t WS_WG = WS_WMKV + 4 * MiB;
constexpr size_t WS_MEMN = WS_WG + 1 * MiB;
constexpr size_t WS_MKV = WS_MEMN + 2 * MiB;
constexpr size_t WS_MEMK = WS_MKV + 2 * MiB;
constexpr size_t WS_MEMV = WS_MEMK + 512 * 1024;
constexpr size_t WS_ROPE = WS_MEMV + 512 * 1024;
constexpr size_t WS_CARRY = WS_ROPE + 4 * MiB;
constexpr size_t WS_A0 = 64 * MiB;
constexpr size_t WS_A1 = 128 * MiB;
constexpr size_t WS_S1 = 192 * MiB;
static_assert(WS_CARRY + 3 * MiB <= WS_A0, "ws map");
constexpr size_t WS_U = 256 * MiB;
constexpr size_t WS_END = 512 * MiB;
constexpr size_t U_PROJ0 = WS_U;
constexpr size_t U_KV = WS_U + 64 * MiB;
constexpr size_t U_K = WS_U + 160 * MiB;
constexpr size_t U_GATE = WS_U;
constexpr size_t U_XIN = WS_U + 48 * MiB;
constexpr size_t U_MQ = WS_U + 96 * MiB;
constexpr size_t U_XC = WS_U + 112 * MiB;
constexpr size_t U_A = WS_U + 160 * MiB;

__device__ __forceinline__ unsigned cvt_pk_bf16(float lo, float hi) { unsigned r; asm volatile("v_cvt_pk_bf16_f32 %0, %1, %2" : "=v"(r) : "v"(lo), "v"(hi)); return r; }
__device__ __forceinline__ float bflo(unsigned u) { return __uint_as_float(u << 16); }
__device__ __forceinline__ float bfhi(unsigned u) { return __uint_as_float(u & 0xffff0000u); }
__device__ __forceinline__ float bf1(bf16_t u) { return __uint_as_float(((unsigned)u) << 16); }
__device__ __forceinline__ bf16_t f2bf(float f) { return (bf16_t)(cvt_pk_bf16(f, 0.f) & 0xffffu); }
__device__ __forceinline__ float wave_sum(float v) {
#pragma unroll
    for (int o = 1; o < 64; o <<= 1) v += __shfl_xor(v, o);
    return v;
}
__device__ __forceinline__ float half_sum(float v) {
#pragma unroll
    for (int o = 1; o < 32; o <<= 1) v += __shfl_xor(v, o);
    return v;
}
__device__ __forceinline__ int my_tid() { int t = threadIdx.x; asm volatile("" : "+v"(t)); return t; }
__device__ __forceinline__ float sigmoidf_(float x) { return __builtin_amdgcn_rcpf(1.f + __expf(-x)); }

namespace pg8 {
constexpr int BM = 256, BK = 64, HALF = 128, HTB = HALF * BK * 2, STAGE_BYTES = 8 * HTB, NXCD = 8, WGM = 8;
__host__ __device__ __forceinline__ int lds_byte(int r, int c) { const int st = (r >> 4) * 2 + (c >> 5), rr = r & 15, cc = c & 31, ob = rr * 64 + cc * 2; return st * 1024 + (ob ^ (((ob >> 9) & 1) << 5)); }
__host__ __device__ __forceinline__ void stage_rc(int b, int& R, int& C) { const int st = b / 1024, sb = b % 1024, swz = sb ^ (((sb >> 9) & 1) << 5); R = (st >> 1) * 16 + swz / 64; C = (st & 1) * 32 + (swz % 64) / 2; }
__host__ __device__ __forceinline__ int perm32(int rho) { const int n = rho >> 4, i = rho & 15; return 8 * (i >> 2) + 4 * n + (i & 3); }
struct Unit { int pm, pn; };
struct Gemm { const bf16_t* A; const bf16_t* Bt; int M, N, K, lda, ldb, acol; };
struct StaticOrder {
    int nM, nN, nwg, G, c;
    __host__ __device__ void init(int M, int N, int G_, int c_) { nM = M / BM; nN = N / BM; nwg = nM * nN; G = G_; c = c_; }
    __host__ __device__ bool next(int i, Unit& u) const {
        const long L = (long)i * G + c; if (L >= nwg) return false;
        int wgid = (int)L; { const int q = nwg / NXCD, r = nwg % NXCD, xcd = wgid % NXCD, off = wgid / NXCD; wgid = (xcd < r ? xcd * (q + 1) : r * (q + 1) + (xcd - r) * q) + off; }
        const int nig = WGM * nN, gid = wgid / nig, fm = gid * WGM, gsz = (nM - fm) < WGM ? (nM - fm) : WGM;
        u.pm = fm + ((wgid % nig) % gsz); u.pn = (wgid % nig) / gsz; return true;
    }
};
template <class Epi, bool ALIGN_EPI>
__device__ __forceinline__ void gemm_phase(LAS unsigned char* lds, const Gemm g, const StaticOrder& S, const Epi& E) {
    const int tid = my_tid(), wid = __builtin_amdgcn_readfirstlane(tid >> 6), lane = tid & 63, wr = wid >> 2, wc = wid & 3, fr = lane & 15, fq = lane >> 4;
    const int nt = g.K / BK;
    unsigned voffA[2], voffB[2];
#pragma unroll
    for (int i = 0; i < 2; ++i) { int R, C; stage_rc(tid * 16 + i * 8192, R, C); const int Rb = Epi::PERM ? ((R & ~31) + perm32(R & 31)) : R;
        voffA[i] = (unsigned)(R * g.lda + C) * 2u; voffB[i] = (unsigned)(Rb * g.ldb + C) * 2u; }
    const size_t kstep = (size_t)(BK * 2);
    const size_t hA = (size_t)HALF * g.lda * 2, hB = (size_t)HALF * g.ldb * 2;
    const size_t tA = 2 * hA, tB = 2 * hB;
    const unsigned ldsw = (unsigned)wid * 1024u;
    const int aoff = lds_byte(wr * 64 + fr, fq * 8), boff = lds_byte(wc * 32 + fr, fq * 8);
#define PG8_SA(b, h) (((b) * 2 + (h)) * HTB)
#define PG8_SB(b, h) ((4 + (b) * 2 + (h)) * HTB)
#define PG8_STAGE(bufoff, gbase, voff) do { _Pragma("unroll") for (int _i = 0; _i < 2; ++_i) \
        __builtin_amdgcn_global_load_lds((const unsigned*)((const char*)(gbase) + (voff)[_i]), (LAS unsigned*)(lds + (bufoff) + ldsw + _i * 8192), 16, 0, 0); } while (0)
#define PG8_LDA(dst, b, h) do { _Pragma("unroll") for (int m = 0; m < 4; ++m) _Pragma("unroll") for (int k = 0; k < 2; ++k) dst[m][k] = *(const LAS bf16x8*)(lds + PG8_SA(b, h) + aoff + m * 2048 + k * 1024); } while (0)
#define PG8_LDB(dst, b, h) do { _Pragma("unroll") for (int n = 0; n < 2; ++n) _Pragma("unroll") for (int k = 0; k < 2; ++k) dst[n][k] = *(const LAS bf16x8*)(lds + PG8_SB(b, h) + boff + n * 2048 + k * 1024); } while (0)
#define PG8_MMA(ai, bj, At, Bt) do { __builtin_amdgcn_s_setprio(1); _Pragma("unroll") for (int m = 0; m < 4; ++m) _Pragma("unroll") for (int n = 0; n < 2; ++n) _Pragma("unroll") for (int k = 0; k < 2; ++k) \
        acc[ai][bj][m][n] = __builtin_amdgcn_mfma_f32_16x16x32_bf16(Bt[n][k], At[m][k], acc[ai][bj][m][n], 0, 0, 0); __builtin_amdgcn_s_setprio(0); } while (0)
#define PG8_WAIT_V(n) asm volatile("s_waitcnt vmcnt(" #n ")" ::: "memory")
#define PG8_WAIT_L(n) asm volatile("s_waitcnt lgkmcnt(" #n ")" ::: "memory")
#define PG8_BAR __builtin_amdgcn_s_barrier()
#define PG8_SCHED __builtin_amdgcn_sched_barrier(0)
    Unit cur, nxt; int ui = 0;
    if (!S.next(0, cur)) return;
    float rsv[8], rsn[8];
    E.pre(cur, wr, fr, rsv); E.post(0, rsv);
    f32x4 acc[2][2][4][2];
#pragma unroll
    for (int a = 0; a < 2; ++a)
#pragma unroll
        for (int b = 0; b < 2; ++b)
#pragma unroll
            for (int m = 0; m < 4; ++m)
#pragma unroll
                for (int n = 0; n < 2; ++n) acc[a][b][m][n] = (f32x4){0.f, 0.f, 0.f, 0.f};
    bf16x8 At[4][2], B0[2][2], B1[2][2];
    const char* cA = (const char*)g.A + (size_t)cur.pm * tA + (size_t)cur.pn * g.acol; const char* cB = (const char*)g.Bt + (size_t)cur.pn * tB;
    PG8_STAGE(PG8_SB(0, 0), cB, voffB); PG8_STAGE(PG8_SB(0, 1), cB + hB, voffB); PG8_STAGE(PG8_SA(0, 0), cA, voffA); PG8_STAGE(PG8_SA(0, 1), cA + hA, voffA);
    if (wr == 1) PG8_BAR;
    PG8_WAIT_V(2); PG8_BAR;
    PG8_STAGE(PG8_SB(1, 0), cB + kstep, voffB); PG8_STAGE(PG8_SA(1, 0), cA + kstep, voffA); PG8_STAGE(PG8_SB(1, 1), cB + hB + kstep, voffB);
    PG8_WAIT_V(6); PG8_BAR;
    for (;;) {
        const bool has_next = S.next(ui + 1, nxt);
        const char* nA = has_next ? (const char*)g.A + (size_t)nxt.pm * tA + (size_t)nxt.pn * g.acol : cA; const char* nB = has_next ? (const char*)g.Bt + (size_t)nxt.pn * tB : cB;
        for (int t = 0; t < nt; t += 2) {
            const bool last = (t == nt - 2);
            const char* a1 = cA + (size_t)(t + 1) * kstep;
            const char* a2 = last ? nA : cA + (size_t)(t + 2) * kstep; const char* b2 = last ? nB : cB + (size_t)(t + 2) * kstep;
            const char* a3 = a2 + kstep; const char* b3 = b2 + kstep;
            PG8_LDB(B0, 0, 0); PG8_LDB(B1, 0, 1); PG8_SCHED; PG8_LDA(At, 0, 0); PG8_STAGE(PG8_SA(1, 1), a1 + hA, voffA);
            PG8_WAIT_V(8); PG8_WAIT_L(0); PG8_BAR; PG8_MMA(0, 0, At, B0); PG8_MMA(0, 1, At, B1); PG8_BAR; PG8_SCHED;
            PG8_LDA(At, 0, 1); PG8_STAGE(PG8_SB(0, 0), b2, voffB); PG8_STAGE(PG8_SB(0, 1), b2 + hB, voffB); PG8_STAGE(PG8_SA(0, 0), a2, voffA);
            PG8_WAIT_V(8); PG8_WAIT_L(0); PG8_BAR; PG8_MMA(1, 0, At, B0); PG8_MMA(1, 1, At, B1); PG8_BAR; PG8_SCHED;
            PG8_LDB(B0, 1, 0); PG8_LDB(B1, 1, 1); PG8_SCHED; PG8_LDA(At, 1, 0); PG8_STAGE(PG8_SA(0, 1), a2 + hA, voffA);
            PG8_WAIT_V(8); PG8_WAIT_L(0); PG8_BAR; PG8_MMA(0, 0, At, B0); PG8_MMA(0, 1, At, B1); PG8_BAR; PG8_SCHED;
            PG8_LDA(At, 1, 1); PG8_STAGE(PG8_SB(1, 0), b3, voffB); PG8_STAGE(PG8_SB(1, 1), b3 + hB, voffB); PG8_STAGE(PG8_SA(1, 0), a3, voffA);
            PG8_WAIT_V(8); PG8_WAIT_L(0); PG8_BAR; PG8_MMA(1, 0, At, B0); PG8_MMA(1, 1, At, B1); PG8_BAR; PG8_SCHED;
        }
        if constexpr (ALIGN_EPI) { if (wr == 0) PG8_BAR; }
        if (has_next) E.pre(nxt, wr, fr, rsn);
        E(acc, cur, wr, wc, fr, fq, ui, rsv);
        if (!has_next) break;
        E.post(ui + 1, rsn);
#pragma unroll
        for (int a = 0; a < 2; ++a)
#pragma unroll
            for (int b = 0; b < 2; ++b)
#pragma unroll
                for (int m = 0; m < 4; ++m)
#pragma unroll
                    for (int n = 0; n < 2; ++n) acc[a][b][m][n] = (f32x4){0.f, 0.f, 0.f, 0.f};
        cur = nxt; cA = nA; cB = nB; ++ui;
#pragma unroll
        for (int i_ = 0; i_ < 8; ++i_) rsv[i_] = rsn[i_];
        if constexpr (ALIGN_EPI) { if (wr == 1) PG8_BAR; }
    }
    PG8_WAIT_V(0);
    if constexpr (!ALIGN_EPI) { if (wr == 0) PG8_BAR; }
    PG8_BAR;
#undef PG8_SA
#undef PG8_SB
#undef PG8_STAGE
#undef PG8_LDA
#undef PG8_LDB
#undef PG8_MMA
#undef PG8_WAIT_V
#undef PG8_WAIT_L
#undef PG8_BAR
#undef PG8_SCHED
}

template <int ACT> struct EpiBf16 {
    static constexpr bool PERM = true;
    bf16_t* O0; bf16_t* O1; bf16_t* O2; int ld0, ld1, ld2, pn1, pn2; const float* ss;
    __device__ __forceinline__ void pre(const Unit& u, int wr, int fr, float (&rsv)[8]) const {
        const int row0 = u.pm * BM + wr * 64 + fr;
#pragma unroll
        for (int i = 0; i < 8; ++i) rsv[i] = ss ? ss[row0 + (i >> 2) * HALF + (i & 3) * 16] : 0.f;
    }
    __device__ __forceinline__ void post(int, const float (&)[8]) const {}
    __device__ __forceinline__ void operator()(const f32x4 (&acc)[2][2][4][2], const Unit& u, int wr, int wc, int fr, int fq, int, const float (&rsv_)[8]) const {
        bf16_t* base; int ldc, pnl; bool act2 = false;
        if (u.pn < pn1) { base = O0; ldc = ld0; pnl = u.pn; act2 = true; } else if (u.pn < pn2) { base = O1; ldc = ld1; pnl = u.pn - pn1; } else { base = O2; ldc = ld2; pnl = u.pn - pn2; }
        const int row0 = u.pm * BM + wr * 64 + fr; const int col0 = pnl * BM + wc * 32 + 8 * fq;
        float rsv[2][4];
#pragma unroll
        for (int ai = 0; ai < 2; ++ai)
#pragma unroll
            for (int m = 0; m < 4; ++m) rsv[ai][m] = ss ? rsqrtf(rsv_[ai * 4 + m] * (1.f / 2048.f) + EPS) : 1.f;
#pragma unroll
        for (int ai = 0; ai < 2; ++ai)
#pragma unroll
            for (int m = 0; m < 4; ++m) { bf16_t* rowp = base + (size_t)(row0 + ai * HALF + m * 16) * ldc + col0;
                const float rs = rsv[ai][m];
#pragma unroll
                for (int bj = 0; bj < 2; ++bj) { f32x4 v0 = acc[ai][bj][m][0] * rs, v1 = acc[ai][bj][m][1] * rs;
                    if (ACT == 1) {
#pragma unroll
                        for (int j = 0; j < 4; ++j) { const float a = fmaxf(v0[j], 0.f), b = fmaxf(v1[j], 0.f); v0[j] = a * a; v1[j] = b * b; } }
                    if (ACT == 2) { if (act2) {
#pragma unroll
                        for (int j = 0; j < 4; ++j) { float x = v0[j]; float z = 0.7978845608028654f * (x + 0.044715f * x * x * x); v0[j] = x / (1.f + __expf(-2.f * z));
                                                      x = v1[j]; z = 0.7978845608028654f * (x + 0.044715f * x * x * x); v1[j] = x / (1.f + __expf(-2.f * z)); } } }
                    u32x4 w; w.x = cvt_pk_bf16(v0[0], v0[1]); w.y = cvt_pk_bf16(v0[2], v0[3]); w.z = cvt_pk_bf16(v1[0], v1[1]); w.w = cvt_pk_bf16(v1[2], v1[3]);
                    { u32x4* dp_ = (u32x4*)(rowp + bj * HALF); asm volatile("global_store_dwordx4 %0, %1, off sc1\n\ts_nop 1" :: "v"(dp_), "v"(w) : "memory"); } } }
    }
};
struct EpiRes {
    static constexpr bool PERM = true;
    const float* basef; const bf16_t* baseb; float* outf; bf16_t* outb; float* ss; int ldc;
    __device__ __forceinline__ void pre(const Unit&, int, int, float (&)[8]) const {}
    __device__ __forceinline__ void post(int, const float (&)[8]) const {}
    __device__ __forceinline__ void operator()(const f32x4 (&acc)[2][2][4][2], const Unit& u, int wr, int wc, int fr, int fq, int, const float (&)[8]) const {
        const int col0 = u.pn * BM + wc * 32 + 8 * fq; const int row0 = u.pm * BM + wr * 64 + fr;
        float part[2][4];
        f32x4 c0[2], c1[2], n0[2], n1[2];
#define ER_LOAD(d0_, d1_, aim_) do { _Pragma("unroll") for (int bj = 0; bj < 2; ++bj) { const size_t off_ = (size_t)(row0 + ((aim_) >> 2) * HALF + ((aim_) & 3) * 16) * ldc + col0 + bj * HALF; \
            if (basef) { d0_[bj] = *(const f32x4*)(basef + off_); d1_[bj] = *(const f32x4*)(basef + off_ + 4); } \
            else if (baseb) { const u32x4 bw = *(const u32x4*)(baseb + off_); d0_[bj] = (f32x4){bflo(bw.x), bfhi(bw.x), bflo(bw.y), bfhi(bw.y)}; d1_[bj] = (f32x4){bflo(bw.z), bfhi(bw.z), bflo(bw.w), bfhi(bw.w)}; } \
            else { d0_[bj] = (f32x4){0.f, 0.f, 0.f, 0.f}; d1_[bj] = (f32x4){0.f, 0.f, 0.f, 0.f}; } } } while (0)
        ER_LOAD(c0, c1, 0);
#pragma unroll
        for (int aim = 0; aim < 8; ++aim) { const int ai = aim >> 2, m = aim & 3;
            if (aim < 7) ER_LOAD(n0, n1, aim + 1);
            asm volatile("" ::: "memory");
            float pp = 0.f;
#pragma unroll
            for (int bj = 0; bj < 2; ++bj) { const size_t off = (size_t)(row0 + ai * HALF + m * 16) * ldc + col0 + bj * HALF;
                const f32x4 v0 = acc[ai][bj][m][0] + c0[bj], v1 = acc[ai][bj][m][1] + c1[bj];
                if (outf) { *(f32x4*)(outf + off) = v0; *(f32x4*)(outf + off + 4) = v1; }
                if (outb) { u32x4 w; w.x = cvt_pk_bf16(v0[0], v0[1]); w.y = cvt_pk_bf16(v0[2], v0[3]); w.z = cvt_pk_bf16(v1[0], v1[1]); w.w = cvt_pk_bf16(v1[2], v1[3]); *(u32x4*)(outb + off) = w; }
                pp += (v0[0] * v0[0] + v0[1] * v0[1]) + (v0[2] * v0[2] + v0[3] * v0[3]) + (v1[0] * v1[0] + v1[1] * v1[1]) + (v1[2] * v1[2] + v1[3] * v1[3]); }
            part[ai][m] = pp;
            asm volatile("" ::: "memory");
#pragma unroll
            for (int bj = 0; bj < 2; ++bj) { c0[bj] = n0[bj]; c1[bj] = n1[bj]; } }
#undef ER_LOAD
        if (ss) {
#pragma unroll
            for (int ai = 0; ai < 2; ++ai)
#pragma unroll
                for (int m = 0; m < 4; ++m) { float pp = part[ai][m]; pp += __shfl_xor(pp, 16); pp += __shfl_xor(pp, 32); if (fq == 0) unsafeAtomicAdd(ss + row0 + ai * HALF + m * 16, pp); } }
    }
};
struct EpiGates {
    static constexpr bool PERM = false;
    const float* ba; const float* bi; const float* cl; bf16_t* Aout; bf16_t* Bout; LAS float* cbuf;
    __device__ __forceinline__ void pre(const Unit& u, int, int, float (&r)[8]) const { const int t = my_tid();
        unsigned long long p0 = (unsigned long long)cl, p1 = (unsigned long long)ba, p2 = (unsigned long long)bi;
        asm volatile("" : "+s"(p0), "+s"(p1), "+s"(p2));
        const unsigned long long ps = t < 128 ? p0 : (t < 256 ? p1 : p2); const float v = ((const float*)ps)[u.pn * 128 + (t & 127)];
#pragma unroll
        for (int i = 0; i < 8; ++i) r[i] = v; }
    __device__ __forceinline__ void post(int ui, const float (&r)[8]) const { const int t = my_tid(); if (t < 384) cbuf[(ui & 1) * 384 + t] = r[0]; }
    __device__ __forceinline__ void operator()(const f32x4 (&acc)[2][2][4][2], const Unit& u, int wr, int wc, int fr, int fq, int ui, const float (&)[8]) const {
        const int cc = wc * 32 + 4 * fq; const int ch0 = u.pn * 128 + cc; const int row0 = u.pm * BM + wr * 64 + fr; const LAS float* cb = cbuf + (ui & 1) * 384 + cc;
#pragma unroll
        for (int ai = 0; ai < 2; ++ai)
#pragma unroll
            for (int m = 0; m < 4; ++m) { const size_t off = (size_t)(row0 + ai * HALF + m * 16) * LRU_W + ch0;
#pragma unroll
                for (int n = 0; n < 2; ++n) { const f32x4 vcl = *(const LAS f32x4*)(cb + n * 16), vba = *(const LAS f32x4*)(cb + 128 + n * 16), vbi = *(const LAS f32x4*)(cb + 256 + n * 16);
                    const f32x4 va = acc[ai][0][m][n] + vba, vi = acc[ai][1][m][n] + vbi;
                    float a4[4]; float b4[4];
#pragma unroll
                    for (int j = 0; j < 4; ++j) { const float r = sigmoidf_(va[j]), ig = sigmoidf_(vi[j]); const float la = vcl[j] * r; a4[j] = 1.f - __expf(la); b4[j] = __builtin_amdgcn_sqrtf(a4[j] * (2.f - a4[j])) * ig; }
                    { u32x2 aw; aw.x = cvt_pk_bf16(a4[0], a4[1]); aw.y = cvt_pk_bf16(a4[2], a4[3]); *(u32x2*)(Aout + off + n * 16) = aw; }
                    u32x2 bw; bw.x = cvt_pk_bf16(b4[0], b4[1]); bw.y = cvt_pk_bf16(b4[2], b4[3]); *(u32x2*)(Bout + off + n * 16) = bw;
                    __builtin_amdgcn_sched_barrier(0); } }
    }
};
}

namespace att {
constexpr int NW = 8, QBLK = 32, KVBLK = 64, QB = 256;
constexpr int SHM_V = 16384, SHM_KN = 16384, SHM_KR = 8192, SHM_K = SHM_KN + SHM_KR;
constexpr int OFF_K = 3 * SHM_V, OFF_WS = OFF_K + 2 * SHM_K, OFF_QR = OFF_WS + NW * 64 * 4, LDS_BYTES = OFF_QR + NW * 4096;
constexpr float THR = 8.f;
#define KSWZF(row) ((((row) & 3) << 2) | (((row) >> 2) & 3))
#define KSWZ(row, colB) ((row) * 256 + ((colB) ^ (KSWZF(row) << 4)))
#define KRSWZ(row, colB) (SHM_KN + (row) * 128 + ((colB) ^ ((((row) >> 1) & 7) << 4)))
#define SBAR() __builtin_amdgcn_sched_barrier(0)
__device__ __forceinline__ int v_st(int k, int c) { const int kk = (k & ~0xC) | ((k & 4) << 1) | ((k & 8) >> 1); return ((kk >> 3) * 4 + (c >> 5)) * 512 + ((kk & 7) * 32 + (c & 31)) * 2; }
__device__ __forceinline__ int v_rd_base(int lane) { return ((lane & 3) << 3) | (((lane >> 2) & 3) << 6) | (((lane >> 4) & 1) << 5) | (((lane >> 5) & 1) << 8); }
constexpr int v_rd_off(int d0, int ks, int half) { return d0 * 512 + ks * 4096 + half * 2048; }
__device__ __forceinline__ int crow(int r, int hi) { return (r & 3) + 8 * (r >> 2) + 4 * hi; }
__device__ __forceinline__ void mask_tile(f32x16& p0, f32x16& p1, int dq) {
    const float NEG = -__builtin_inff();
#pragma unroll
    for (int r = 0; r < 16; ++r) { const int c = (r & 3) + 8 * (r >> 2); if (dq - c < 0) p0[r] = NEG; if (dq - c - 32 < 0) p1[r] = NEG; }
}
__device__ __forceinline__ void partialSM(f32x16& p0, f32x16& p1, float& m_reg, float& mn, float& alpha, float SCALE, float C2) {
    float pmax = p0[0];
#pragma unroll
    for (int r = 1; r < 16; ++r) pmax = fmaxf(pmax, p0[r]);
#pragma unroll
    for (int r = 0; r < 16; ++r) pmax = fmaxf(pmax, p1[r]);
    { auto rr = __builtin_amdgcn_permlane32_swap(__float_as_uint(pmax), __float_as_uint(pmax), false, false); pmax = fmaxf(__uint_as_float(rr[0]), __uint_as_float(rr[1])); }
    if (__builtin_expect(__all((pmax - m_reg) * SCALE <= THR), 1)) { mn = m_reg; alpha = 1.f; }
    else { mn = fmaxf(m_reg, pmax); alpha = __builtin_amdgcn_exp2f((m_reg - mn) * C2); m_reg = mn; }
    const float mnL = -mn * C2;
#pragma unroll
    for (int r = 0; r < 16; ++r) p0[r] = fmaf(p0[r], C2, mnL);
#pragma unroll
    for (int r = 0; r < 16; ++r) p1[r] = fmaf(p1[r], C2, mnL);
#pragma unroll
    for (int r = 0; r < 16; ++r) p0[r] = __builtin_amdgcn_exp2f(p0[r]);
}
__device__ __forceinline__ void finishSM(f32x16& p0, f32x16& p1, float alpha, float& l_reg, bf16x8& pa0, bf16x8& pa1, bf16x8& pa2, bf16x8& pa3) {
#pragma unroll
    for (int r = 0; r < 16; ++r) p1[r] = __builtin_amdgcn_exp2f(p1[r]);
    float ps = 0;
#pragma unroll
    for (int r = 0; r < 16; ++r) ps += p0[r];
#pragma unroll
    for (int r = 0; r < 16; ++r) ps += p1[r];
    { auto rr = __builtin_amdgcn_permlane32_swap(__float_as_uint(ps), __float_as_uint(ps), false, false); ps = __uint_as_float(rr[0]) + __uint_as_float(rr[1]); }
    l_reg = l_reg * alpha + ps;
#define PK4(P, B_, OUT) do { unsigned a0 = cvt_pk_bf16(P[B_+0], P[B_+1]), a1 = cvt_pk_bf16(P[B_+2], P[B_+3]);                          \
        unsigned b0 = cvt_pk_bf16(P[B_+4], P[B_+5]), b1 = cvt_pk_bf16(P[B_+6], P[B_+7]);                                             \
        auto r0 = __builtin_amdgcn_permlane32_swap(a0, b0, false, false); auto r1 = __builtin_amdgcn_permlane32_swap(a1, b1, false, false); \
        u32x4 w = {r0[0], r1[0], r0[1], r1[1]}; OUT = __builtin_bit_cast(bf16x8, w); } while (0)
    PK4(p0, 0, pa0); PK4(p0, 8, pa1); PK4(p1, 0, pa2); PK4(p1, 8, pa3);
#undef PK4
}
template <int DQ>
__device__ __forceinline__ void qkt(f32x16& p0, f32x16& p1, const LAS char* Kt, int r32, int hi, const bf16x8* qr, const LAS char* qrl) {
    constexpr int ND = DQ / 16, PF = 8;
    p0 = f32x16{}; p1 = f32x16{};
    const LAS char* kb[4]; const LAS char* kr[4];
#pragma unroll
    for (int dd = 0; dd < 4; ++dd) { kb[dd] = Kt + KSWZ(r32, (dd * 16 + hi * 8) * 2); kr[dd] = Kt + KRSWZ(r32, (dd * 16 + hi * 8) * 2); }
    const int koff = (r32 & 2) ? -128 : 128;
#define RDK(d, half) (*reinterpret_cast<const LAS bf16x8*>((d) < 8 ? kb[(d) & 3] + ((d) >> 2) * koff + (half) * 32 * 256 : kr[((d) - 8) & 3] + (half) * 32 * 128))
    bf16x8 k0[PF], k1[PF], qf[4];
    if constexpr (DQ == 192) {
#pragma unroll
        for (int dd = 0; dd < 4; ++dd) qf[dd] = *reinterpret_cast<const LAS bf16x8*>(qrl + dd * 1024);
    }
#pragma unroll
    for (int d = 0; d < PF; ++d) { k0[d] = RDK(d, 0); k1[d] = RDK(d, 1); }
    SBAR();
#pragma unroll
    for (int d = 0; d < ND; ++d) { const bf16x8 q = d < 8 ? qr[d & 7] : qf[(d - 8) & 3];
        p0 = __builtin_amdgcn_mfma_f32_32x32x16_bf16(k0[d % PF], q, p0, 0, 0, 0);
        p1 = __builtin_amdgcn_mfma_f32_32x32x16_bf16(k1[d % PF], q, p1, 0, 0, 0);
        if (d + PF < ND) { k0[d % PF] = RDK(d + PF, 0); k1[d % PF] = RDK(d + PF, 1); }
        SBAR(); }
#undef RDK
}
__device__ __forceinline__ void pv_tile(f32x16* o, int vb, bf16x8 pa0, bf16x8 pa1, bf16x8 pa2, bf16x8 pa3) {
#define TRRD(dst, off) asm volatile("ds_read_b64_tr_b16 %0, %1 offset:%2" : "=&v"(dst) : "v"(vb), "i"(off) : "memory")
#define RD8(L, H, d0) do { constexpr int b_ = v_rd_off(d0, 0, 0); TRRD(L[0], b_); TRRD(H[0], b_ + 2048); TRRD(L[1], b_ + 4096); TRRD(H[1], b_ + 6144); TRRD(L[2], b_ + 8192); TRRD(H[2], b_ + 10240); TRRD(L[3], b_ + 12288); TRRD(H[3], b_ + 14336); } while (0)
#define MM4(L, H, d0) do { \
        o[d0] = __builtin_amdgcn_mfma_f32_32x32x16_bf16(pa0, (bf16x8){L[0][0], L[0][1], L[0][2], L[0][3], H[0][0], H[0][1], H[0][2], H[0][3]}, o[d0], 0, 0, 0);   \
        o[d0] = __builtin_amdgcn_mfma_f32_32x32x16_bf16(pa1, (bf16x8){L[1][0], L[1][1], L[1][2], L[1][3], H[1][0], H[1][1], H[1][2], H[1][3]}, o[d0], 0, 0, 0);   \
        o[d0] = __builtin_amdgcn_mfma_f32_32x32x16_bf16(pa2, (bf16x8){L[2][0], L[2][1], L[2][2], L[2][3], H[2][0], H[2][1], H[2][2], H[2][3]}, o[d0], 0, 0, 0);   \
        o[d0] = __builtin_amdgcn_mfma_f32_32x32x16_bf16(pa3, (bf16x8){L[3][0], L[3][1], L[3][2], L[3][3], H[3][0], H[3][1], H[3][2], H[3][3]}, o[d0], 0, 0, 0); } while (0)
    s16x4 la[4], ha[4], lb[4], hb[4];
    RD8(la, ha, 0); RD8(lb, hb, 1);
    asm volatile("s_waitcnt lgkmcnt(8)" ::: "memory"); SBAR(); MM4(la, ha, 0); SBAR();
    RD8(la, ha, 2);
    asm volatile("s_waitcnt lgkmcnt(8)" ::: "memory"); SBAR(); MM4(lb, hb, 1); SBAR();
    RD8(lb, hb, 3);
    asm volatile("s_waitcnt lgkmcnt(8)" ::: "memory"); SBAR(); MM4(la, ha, 2); SBAR();
    asm volatile("s_waitcnt lgkmcnt(0)" ::: "memory"); SBAR(); MM4(lb, hb, 3);
#undef MM4
#undef RD8
#undef TRRD
}

template <int DQ, bool CAUSAL>
__device__ __forceinline__ void attn_block(const bf16_t* Q, int ldq, const bf16_t* Kh, int ldk, const bf16_t* Vh, int ldv, bf16_t* O, int ldo, int P0, int NT, float SCALE, LAS char* lds) {
    const float C2 = 1.4426950408889634f * SCALE;
    const int tid = my_tid(), wid = __builtin_amdgcn_readfirstlane(tid >> 6), lane = tid & 63, r32 = lane & 31, hi = lane >> 5;
    const int qlo = P0 + wid * QBLK, qm = qlo + r32 - 4 * hi;
    LAS char* V_lds = lds; LAS char* K_lds = lds + OFF_K;
    LAS float* ws = (LAS float*)(lds + OFF_WS) + wid * 64; LAS float* li_l = ws; LAS float* al_l = ws + 32;
    float m_reg = -1e30f, l_reg = 0; f32x16 o[4] = {};
    const int krow = 4 * wid + (lane >> 4);
    const unsigned goffK = (unsigned)krow * (unsigned)ldk + (unsigned)(((lane & 15) ^ KSWZF(krow)) * 8);
    const int rrow = 8 * wid + (lane >> 3);
    const unsigned goffR = (unsigned)rrow * (unsigned)ldk + 128u + (unsigned)(((lane & 7) ^ ((rrow >> 1) & 7)) * 8);
    const int vsub = 2 * wid + (lane >> 5), vkk = (vsub >> 2) * 8 + ((lane & 31) >> 2), vk = (vkk & ~0xC) | ((vkk & 4) << 1) | ((vkk & 8) >> 1);
    const unsigned goffV = (unsigned)vk * (unsigned)ldv + (unsigned)((vsub & 3) * 32 + (lane & 3) * 8);
    const int vb0 = (int)(uintptr_t)V_lds + v_rd_base(lane);
#define GLDS(gp, lp) __builtin_amdgcn_global_load_lds((const unsigned*)(gp), (LAS unsigned*)(lp), 16, 0, 0)
#define DMA_TILE(t, kslot, vslot) do { const bf16_t* kt_ = Kh + (size_t)(t) * KVBLK * ldk; const bf16_t* vt_ = Vh + (size_t)(t) * KVBLK * ldv; \
        LAS char* kd_ = K_lds + (kslot) * SHM_K + wid * 1024; LAS char* vd_ = V_lds + (vslot) * SHM_V + wid * 1024; \
        GLDS(kt_ + goffK, kd_); GLDS(kt_ + goffK + (size_t)32 * ldk, kd_ + 8192); \
        if constexpr (DQ == 192) GLDS(kt_ + goffR, kd_ + SHM_KN); \
        GLDS(vt_ + goffV, vd_); GLDS(vt_ + goffV + (size_t)32 * ldv, vd_ + 8192); } while (0)
#define RESC(a) do { if (__any((a) < 1.f)) { if (hi == 0) al_l[r32] = (a); asm volatile("s_waitcnt lgkmcnt(0)" ::: "memory");              \
                     _Pragma("unroll") for (int d_ = 0; d_ < 4; ++d_) _Pragma("unroll") for (int r = 0; r < 16; ++r) o[d_][r] *= al_l[crow(r, hi)]; } } while (0)
#define KBASE(t) ((t) * KVBLK)
#define MASKT(P0_, P1_, t) do { if constexpr (CAUSAL) { const int kb_ = KBASE(t); if (kb_ + KVBLK - 1 > qlo) mask_tile(P0_, P1_, qm - kb_); } } while (0)
    DMA_TILE(0, 0, 0);
    bf16x8 qr[8];
#pragma unroll
    for (int d0 = 0; d0 < 8; ++d0) qr[d0] = *(const bf16x8*)(Q + (size_t)(wid * QBLK + r32) * ldq + d0 * 16 + hi * 8);
    LAS char* qrl = lds + OFF_QR + wid * 4096 + lane * 16;
    if constexpr (DQ == 192) {
#pragma unroll
        for (int dd = 0; dd < 4; ++dd) *(LAS bf16x8*)(qrl + dd * 1024) = *(const bf16x8*)(Q + (size_t)(wid * QBLK + r32) * ldq + (8 + dd) * 16 + hi * 8);
    }
    __syncthreads();
    int vs_cur = 0, vs_next = 1;
#pragma unroll 1
    for (int t = 0; t < NT; ++t) {
        if (t + 1 < NT) DMA_TILE(t + 1, (t + 1) & 1, vs_next);
        f32x16 p0, p1; float mn, al; bf16x8 pa0, pa1, pa2, pa3;
        SBAR(); qkt<DQ>(p0, p1, K_lds + (t & 1) * SHM_K, r32, hi, qr, qrl);
        MASKT(p0, p1, t); partialSM(p0, p1, m_reg, mn, al, SCALE, C2);
        RESC(al);
        finishSM(p0, p1, al, l_reg, pa0, pa1, pa2, pa3); SBAR();
        pv_tile(o, vb0 + vs_cur * SHM_V, pa0, pa1, pa2, pa3);
        __syncthreads();
        { const int t_ = vs_cur; vs_cur = vs_next; vs_next = t_; }
    }
    SBAR();
    if (hi == 0) li_l[r32] = l_reg; asm volatile("s_waitcnt lgkmcnt(0)" ::: "memory");
    float rli[16];
#pragma unroll
    for (int r = 0; r < 16; ++r) rli[r] = __builtin_amdgcn_rcpf(li_l[crow(r, hi)]);
    { LAS bf16_t* stg = (LAS bf16_t*)(lds + wid * 8192);
#pragma unroll
      for (int r = 0; r < 16; ++r) { const int orow = crow(r, hi);
#pragma unroll
          for (int d0 = 0; d0 < 4; ++d0) stg[orow * 128 + d0 * 32 + r32] = f2bf(o[d0][r] * rli[r]); }
      asm volatile("s_waitcnt lgkmcnt(0)" ::: "memory");
      bf16_t* Ow = O + (size_t)(wid * QBLK) * ldo;
#pragma unroll
      for (int i = 0; i < 8; ++i) { const int c = i * 64 + lane, row = c >> 4, ch = c & 15;
          const u32x4 v = *(const LAS u32x4*)(stg + row * 128 + ch * 8);
          *(u32x4*)(Ow + (size_t)row * ldo + ch * 8) = v; } }
    __syncthreads();
#undef GLDS
#undef DMA_TILE
#undef RESC
#undef KBASE
#undef MASKT
#undef HALF_STEP
}
}

struct Params {
    const float* x; const float* mem; const int* pos;
    const float *mix_norm, *mlp_norm, *w_out, *w_mlp_in, *w_mlp_out, *mem_norm, *w_mem_kv, *mem_k_norm, *mem_q_norm, *w_in_mla, *q_lat_norm, *w_q_up, *kv_lat_norm, *w_kv_up,
        *q_norm, *k_norm, *w_in_lru, *conv_w, *conv_b, *w_gate_a, *b_gate_a, *w_gate_i, *b_gate_i, *lru_lambda;
    float* out; unsigned char* ws; int ph_lo, ph_hi;
};
constexpr int LDS_MISC = 135168, LDS_TOTAL = LDS_MISC + 256 + 3072;
constexpr int NPHASE = 20;

constexpr int TR_STRIDE = 65, TR_SCR_BYTES = 64 * TR_STRIDE * 4;
struct TrSel { const float* W; bf16_t* WT; const float* gain; int N, ldt; };
__device__ __forceinline__ void tr_load(const TrSel& t, int lane, f32x4 (&v)[16], float (&g)[16]) {
#pragma unroll
    for (int i = 0; i < 16; ++i) { v[i] = *(const f32x4*)(t.W + (size_t)(4 * i + (lane >> 4)) * t.N + (lane & 15) * 4); g[i] = t.gain ? t.gain[4 * i + (lane >> 4)] : 1.f; }
}
__device__ __forceinline__ void tr_store(const TrSel& t, const f32x4 (&v)[16], const float (&g)[16], LAS float* scr, int lane) {
#pragma unroll
    for (int i = 0; i < 16; ++i) { const int kk = 4 * i + (lane >> 4); LAS float* d = scr + kk * TR_STRIDE + (lane & 15) * 4;
        d[0] = v[i].x * g[i]; d[1] = v[i].y * g[i]; d[2] = v[i].z * g[i]; d[3] = v[i].w * g[i]; }
    asm volatile("s_waitcnt lgkmcnt(0)" ::: "memory");
    const int c = lane & 7;
#pragma unroll
    for (int j = 0; j < 8; ++j) { const int n = (lane >> 3) + 8 * j; const LAS float* sp = scr + (8 * c) * TR_STRIDE + n;
        u32x4 o; o.x = cvt_pk_bf16(sp[0 * TR_STRIDE], sp[1 * TR_STRIDE]); o.y = cvt_pk_bf16(sp[2 * TR_STRIDE], sp[3 * TR_STRIDE]); o.z = cvt_pk_bf16(sp[4 * TR_STRIDE], sp[5 * TR_STRIDE]); o.w = cvt_pk_bf16(sp[6 * TR_STRIDE], sp[7 * TR_STRIDE]);
        *(u32x4*)(t.WT + (size_t)n * t.ldt + 8 * c) = o; }
    asm volatile("s_waitcnt lgkmcnt(0)" ::: "memory");
}
__device__ __forceinline__ bool tr_job(int& r, const float* W, int K, int N, bf16_t* WT, const float* gain, TrSel& t) {
    const int nblk = N / 64, items = (K / 64) * nblk;
    if (r >= items) { r -= items; return false; }
    const int kb = r / nblk, nb = r % nblk;
    t.W = W + (size_t)(64 * kb) * N + 64 * nb; t.N = N; t.WT = WT + (size_t)(64 * nb) * K + 64 * kb; t.ldt = K; t.gain = gain ? gain + 64 * kb : nullptr;
    return true;
}
__device__ __forceinline__ bool tr_gate_job(int& r, const float* W, int row_off, bf16_t* WT, TrSel& t) {
    const int items = 12 * 2 * 2;
    if (r >= items) { r -= items; return false; }
    const int blk = r / 4, kb = (r % 4) / 2, nb = r % 2;
    t.W = W + (size_t)blk * 16384 + (size_t)(64 * kb) * 128 + 64 * nb; t.N = 128; t.WT = WT + (size_t)blk * 32768 + (size_t)(row_off + 64 * nb) * 128 + 64 * kb; t.ldt = 128; t.gain = nullptr;
    return true;
}
__device__ __forceinline__ void cvt_rows(const float* X, bf16_t* out, float* ss, int rows, int gw, int NGW, int lane) {
    f32x4 v[8], nv[8]; int m = gw;
    if (m < rows) {
#pragma unroll
        for (int j = 0; j < 8; ++j) v[j] = ((const f32x4*)(X + (size_t)m * DM) + lane)[64 * j]; }
    for (; m < rows; m += NGW) {
        if (m + NGW < rows) {
#pragma unroll
            for (int j = 0; j < 8; ++j) nv[j] = ((const f32x4*)(X + (size_t)(m + NGW) * DM) + lane)[64 * j]; }
        asm volatile("" ::: "memory");
        float s = 0.f;
#pragma unroll
        for (int j = 0; j < 8; ++j) s += (v[j].x * v[j].x + v[j].y * v[j].y) + (v[j].z * v[j].z + v[j].w * v[j].w);
        s = wave_sum(s); if (lane == 0) ss[m] = s;
        u32x2* o8 = (u32x2*)(out + (size_t)m * DM) + lane;
#pragma unroll
        for (int j = 0; j < 8; ++j) { u32x2 w; w.x = cvt_pk_bf16(v[j].x, v[j].y); w.y = cvt_pk_bf16(v[j].z, v[j].w); o8[64 * j] = w; }
        asm volatile("" ::: "memory");
#pragma unroll
        for (int j = 0; j < 8; ++j) v[j] = nv[j];
    }
}

__device__ __forceinline__ void norm_rows(const float* X, const float* g, bf16_t* out, int rows, int gw, int NGW, int lane) {
    f32x4 gv[8];
#pragma unroll
    for (int j = 0; j < 8; ++j) gv[j] = ((const f32x4*)g)[lane + 64 * j];
    for (int m = gw; m < rows; m += NGW) {
        const f32x4* xr = (const f32x4*)(X + (size_t)m * DM) + lane; f32x4 v[8]; float s = 0.f;
#pragma unroll
        for (int j = 0; j < 8; ++j) { v[j] = xr[64 * j]; s += (v[j].x * v[j].x + v[j].y * v[j].y) + (v[j].z * v[j].z + v[j].w * v[j].w); }
        const float rstd = rsqrtf(wave_sum(s) * (1.f / DM) + EPS);
        u32x2* o8 = (u32x2*)(out + (size_t)m * DM) + lane;
#pragma unroll
        for (int j = 0; j < 8; ++j) { u32x2 w; w.x = cvt_pk_bf16(v[j].x * rstd * gv[j].x, v[j].y * rstd * gv[j].y); w.y = cvt_pk_bf16(v[j].z * rstd * gv[j].z, v[j].w * rstd * gv[j].w); o8[64 * j] = w; }
    }
}
template <int NJ, bool HEADS>
__device__ __forceinline__ void seg_norm(bf16_t* seg, const float* g, int n, int lane) {
    u32x2 w[NJ]; float s[NJ]; float tot = 0.f;
#pragma unroll
    for (int j = 0; j < NJ; ++j) { w[j] = ((const u32x2*)seg)[lane + 64 * j]; const float a = bflo(w[j].x), b = bfhi(w[j].x), c = bflo(w[j].y), d = bfhi(w[j].y); s[j] = (a * a + b * b) + (c * c + d * d); tot += s[j]; }
    float rs[NJ];
    if (HEADS) {
#pragma unroll
        for (int j = 0; j < NJ; ++j) rs[j] = rsqrtf(half_sum(s[j]) * (1.f / 128.f) + EPS);
    } else { const float r = rsqrtf(wave_sum(tot) / (float)n + EPS);
#pragma unroll
        for (int j = 0; j < NJ; ++j) rs[j] = r; }
#pragma unroll
    for (int j = 0; j < NJ; ++j) { const int gi = HEADS ? ((lane & 31) * 4) : (lane + 64 * j) * 4; const f32x4 gv = *(const f32x4*)(g + gi);
        u32x2 o; o.x = cvt_pk_bf16(bflo(w[j].x) * rs[j] * gv.x, bfhi(w[j].x) * rs[j] * gv.y); o.y = cvt_pk_bf16(bflo(w[j].y) * rs[j] * gv.z, bfhi(w[j].y) * rs[j] * gv.w);
        ((u32x2*)seg)[lane + 64 * j] = o; }
}

__device__ __forceinline__ u32x4 qk_head(u32x4 w, const float (&g)[8], bool r1, bool r2, int partner, const float (&cs)[8], const float (&sn)[8]) {
    float x[8] = {bflo(w.x), bfhi(w.x), bflo(w.y), bfhi(w.y), bflo(w.z), bfhi(w.z), bflo(w.w), bfhi(w.w)};
    float ss = 0.f;
#pragma unroll
    for (int j = 0; j < 8; ++j) ss += x[j] * x[j];
    const float rstd = rsqrtf(half_sum(ss) * (1.f / 192.f) + EPS);
#pragma unroll
    for (int j = 0; j < 8; ++j) x[j] = x[j] * rstd * g[j];
#pragma unroll
    for (int j = 0; j < 8; ++j) { const float pj = __shfl(x[j], partner); if (r1) x[j] = x[j] * cs[j] - pj * sn[j]; else if (r2) x[j] = x[j] * cs[j] + pj * sn[j]; }
    u32x4 o; o.x = cvt_pk_bf16(x[0], x[1]); o.y = cvt_pk_bf16(x[2], x[3]); o.z = cvt_pk_bf16(x[4], x[5]); o.w = cvt_pk_bf16(x[6], x[7]);
    return o;
}

#define XB_TMO      128
#define XB_XCNT(j)  (256  + 64 * (j))
#define XB_XSUB(j)  (1280 + 64 * (j))
#define XB_XGEN(j)  (2304 + 64 * (j))
#define XB_TOP      3328
#define XB_TOPGEN   3392
#define XCD_BAR_WORDS 3456
#define XB_SPIN_CAP (1u << 18)
__device__ __forceinline__ unsigned xb_ld(unsigned* p)              { return __hip_atomic_load(p, __ATOMIC_RELAXED, __HIP_MEMORY_SCOPE_AGENT); }
__device__ __forceinline__ unsigned xb_add(unsigned* p, unsigned v) { return __hip_atomic_fetch_add(p, v, __ATOMIC_RELAXED, __HIP_MEMORY_SCOPE_AGENT); }
__device__ __forceinline__ unsigned xb_xcc_id() { return (unsigned)__builtin_amdgcn_s_getreg((3 << 11) | 20) & 0xFu; }
#define XB_SPIN(cond, bar) do { unsigned _sp = 0; while (cond) { __builtin_amdgcn_s_sleep(1); \
    if ((++_sp & 255u) == 0u) { if (xb_ld(&(bar)[XB_TMO])) break; if (_sp > XB_SPIN_CAP) { atomicAdd(&(bar)[XB_TMO], 1u); break; } } } } while (0)
struct XcdBarrier { unsigned* bar; unsigned x; volatile LAS unsigned* st; };
__device__ __forceinline__ void xcd_barrier_complete(unsigned* bar, unsigned x, unsigned& nloc, unsigned& nx) {
    const unsigned G = gridDim.x * gridDim.y * gridDim.z;
    unsigned sum, cnt, mine, sp = 0u;
    for (;;) {
        sum = 0u; cnt = 0u; mine = 0u;
#pragma unroll
        for (unsigned j = 0; j < 16; ++j) { const unsigned c = xb_ld(&bar[XB_XCNT(j)]); sum += c; cnt += (c > 0u) ? 1u : 0u; mine = (j == x) ? c : mine; }
        if (sum == G) break;
        __builtin_amdgcn_s_sleep(1);
        if ((++sp & 255u) == 0u) { if (xb_ld(&bar[XB_TMO])) break; if (sp > XB_SPIN_CAP) { atomicAdd(&bar[XB_TMO], 1u); break; } }
    }
    nloc = mine > 0u ? mine : 1u; nx = cnt > 0u ? cnt : 1u;
}
__device__ __forceinline__ void xcd_barrier(const XcdBarrier& b) {
    asm volatile("s_waitcnt vmcnt(0)" ::: "memory");
    __syncthreads();
    if (threadIdx.x == 0) {
        unsigned* bar = b.bar;
        __builtin_amdgcn_s_waitcnt(0);
        unsigned nloc = b.st[0], nx = b.st[1];
        if (nloc == 0u) { xcd_barrier_complete(bar, b.x, nloc, nx); b.st[0] = nloc; b.st[1] = nx; }
        const unsigned old = xb_add(&bar[XB_XSUB(b.x)], 1u);
        const unsigned gen = old / nloc;
        if (old + 1u == (gen + 1u) * nloc) {
            __builtin_amdgcn_fence(__ATOMIC_RELEASE, "agent");
            asm volatile("s_waitcnt vmcnt(0)" ::: "memory");
            const unsigned og = xb_add(&bar[XB_TOP], 1u);
            const unsigned tg = og / nx;
            if (og + 1u == (tg + 1u) * nx) xb_add(&bar[XB_TOPGEN], 1u);
            else XB_SPIN(xb_ld(&bar[XB_TOPGEN]) == tg, bar);
            __builtin_amdgcn_fence(__ATOMIC_ACQUIRE, "agent");
            xb_add(&bar[XB_XGEN(b.x)], 1u);
            asm volatile("s_waitcnt vmcnt(0)" ::: "memory");
        } else {
            XB_SPIN(xb_ld(&bar[XB_XGEN(b.x)]) == gen, bar);
            __builtin_amdgcn_fence(__ATOMIC_ACQUIRE, "agent");
            asm volatile("s_waitcnt vmcnt(0)" ::: "memory");
        }
    }
    __syncthreads();
}
typedef __attribute__((address_space(4))) const Params CParams;
#define PHASE_BEGIN \
    CParams* P = (CParams*)__builtin_amdgcn_kernarg_segment_ptr(); asm volatile("" : "+s"(P)); \
    const int tid = my_tid(), lane = tid & 63, wave = __builtin_amdgcn_readfirstlane(tid >> 6); \
    const int G = gridDim.x, bx = blockIdx.x; const int gw = bx * 8 + wave, NGW = G * 8; \
    (void)lane; (void)gw; (void)NGW; \
    unsigned char* ws = P->ws; \
    unsigned* ctl = (unsigned*)(ws + WS_CTL); \
    bf16_t* Win0_t = (bf16_t*)(ws + WS_WIN0); bf16_t* Wqup_t = (bf16_t*)(ws + WS_WQUP); bf16_t* Wkvup_t = (bf16_t*)(ws + WS_WKVUP); bf16_t* Wout_t = (bf16_t*)(ws + WS_WOUT); \
    bf16_t* Wmi0_t = (bf16_t*)(ws + WS_A0); bf16_t* Wmo0_t = (bf16_t*)(ws + WS_A0 + 32 * MiB); bf16_t* Wmi1_t = (bf16_t*)(ws + WS_A1); bf16_t* Wmo1_t = (bf16_t*)(ws + WS_A1 + 32 * MiB); bf16_t* Wlru_t = (bf16_t*)(ws + WS_WLRU); bf16_t* Wmkv_t = (bf16_t*)(ws + WS_WMKV); bf16_t* Wg_t = (bf16_t*)(ws + WS_WG); \
    bf16_t* memn = (bf16_t*)(ws + WS_MEMN); float* mkv = (float*)(ws + WS_MKV); bf16_t* memK = (bf16_t*)(ws + WS_MEMK); bf16_t* memV = (bf16_t*)(ws + WS_MEMV); \
    float* rope = (float*)(ws + WS_ROPE); float* carryP = (float*)(ws + WS_CARRY); float* carryH = carryP + NB * NCHUNK * LRU_W; \
    bf16_t* xb = (bf16_t*)(ws + WS_S1); bf16_t* mixed0 = (bf16_t*)(ws + WS_A1); bf16_t* mixed1 = (bf16_t*)(ws + WS_A0); \
    float* ss0 = (float*)(ws + WS_SS); float* ss1 = ss0 + T; float* ss2 = ss1 + T; float* ss3 = ss2 + T; \
    bf16_t* proj0 = (bf16_t*)(ws + U_PROJ0); bf16_t* kvb = (bf16_t*)(ws + U_KV); bf16_t* Kb = (bf16_t*)(ws + U_K); bf16_t* Qb = (bf16_t*)P->out; \
    bf16_t* gateb = (bf16_t*)(ws + U_GATE); bf16_t* xinb = (bf16_t*)(ws + U_XIN); bf16_t* bscan = xinb; bf16_t* mqb = (bf16_t*)(ws + U_MQ); bf16_t* xcb = (bf16_t*)(ws + U_XC); bf16_t* ascan = (bf16_t*)(ws + U_A); \
    bf16_t* ub = (bf16_t*)(ws + WS_U); \
    float* clam = (float*)(ws + WS_CTL + 8192); \
    (void)0
__global__ void __launch_bounds__(512, 2) fwd_kernel(Params p) {
    extern __shared__ __attribute__((aligned(16))) unsigned char lds_raw[];
    LAS unsigned char* lds = (LAS unsigned char*)lds_raw;
    LAS int* s_item = (LAS int*)(lds + LDS_MISC);
    if (threadIdx.x < 64) ((LAS unsigned*)(lds + LDS_MISC))[threadIdx.x] = 0u;
    __syncthreads();
    cg::grid_group grid = cg::this_grid();
    const int lo = p.ph_lo, hi = p.ph_hi;
    if (hi > NPHASE + 7) grid.sync();
    if (hi - lo > 1 && threadIdx.x == 0) (void)xb_add((unsigned*)(p.ws + WS_CTL) + 4096 + XB_XCNT(xb_xcc_id()), 1u);
#ifndef PHMASK
#define PHMASK 0xFFFFF
#endif
#ifndef REPMASK
#define REPMASK 0
#endif
#define PH(k) if (((PHMASK >> (k)) & 1) && lo <= (k) && (k) < hi) for (int rep_ = 0; rep_ < 1 + ((REPMASK >> (k)) & 1); ++rep_)
#define SEAM(k) do { if (lo <= (k) && (k) + 1 < hi) { CParams* P_ = (CParams*)__builtin_amdgcn_kernarg_segment_ptr(); asm volatile("" : "+s"(P_)); \
        XcdBarrier b_; b_.bar = (unsigned*)(P_->ws + WS_CTL) + 4096; b_.x = xb_xcc_id(); b_.st = (volatile LAS unsigned*)(lds + LDS_MISC + 32); xcd_barrier(b_); } } while (0)

    PH(0) { PHASE_BEGIN; if (rep_) grid.sync();
        if (bx == 0 && tid < 64) ctl[tid] = 0u;
        if (bx == 1) for (int c = tid; c < LRU_W; c += 512) clam[c] = -8.0f * log1pf(expf(-P->lru_lambda[c]));
        LAS float* scr = (LAS float*)(lds + wave * TR_SCR_BYTES);
        constexpr int NITEMS = 2 * (2048 / 64) * (8192 / 64) + (2048 / 64) * (1856 / 64) + (768 / 64) * (2304 / 64) + (512 / 64) * (3072 / 64) + 2 * (2048 / 64) * (2048 / 64)
                             + (2048 / 64) * (3584 / 64) + (2048 / 64) * (1024 / 64) + 2 * 48;
#define P0_SELECT(it_, t) do { int r = (it_); \
            if (tr_job(r, P->w_mlp_in, 2048, 8192, Wmi0_t, P->mlp_norm, t)) {} \
            else if (tr_job(r, P->w_mlp_out, 8192, 2048, Wmo0_t, nullptr, t)) {} \
            else if (tr_job(r, P->w_in_mla, 2048, 1856, Win0_t, P->mix_norm, t)) {} \
            else if (tr_job(r, P->w_q_up, 768, 2304, Wqup_t, nullptr, t)) {} \
            else if (tr_job(r, P->w_kv_up, 512, 3072, Wkvup_t, nullptr, t)) {} \
            else if (tr_job(r, P->w_out, 2048, 2048, Wout_t, nullptr, t)) {} \
            else if (tr_job(r, P->w_out + (size_t)2048 * 2048, 2048, 2048, Wout_t + (size_t)2048 * 2048, nullptr, t)) {} \
            else if (tr_job(r, P->w_in_lru, 2048, 3584, Wlru_t, P->mix_norm + DM, t)) {} \
            else if (tr_job(r, P->w_mem_kv, 2048, 1024, Wmkv_t, nullptr, t)) {} \
            else if (tr_gate_job(r, P->w_gate_a, 0, Wg_t, t)) {} \
            else tr_gate_job(r, P->w_gate_i, 128, Wg_t, t); } while (0)
        { int it = gw; TrSel cur, nx; f32x4 v[16], nv[16]; float gg[16], ng[16];
          if (it < NITEMS) { P0_SELECT(it, cur); tr_load(cur, lane, v, gg); }
          while (it < NITEMS) { const int nit = it + NGW;
              if (nit < NITEMS) { P0_SELECT(nit, nx); tr_load(nx, lane, nv, ng); }
              asm volatile("" ::: "memory");
              tr_store(cur, v, gg, scr, lane);
              asm volatile("" ::: "memory");
              cur = nx; it = nit;
#pragma unroll
              for (int i = 0; i < 16; ++i) { v[i] = nv[i]; gg[i] = ng[i]; } } }
#undef P0_SELECT
        { u32x4* z = (u32x4*)(Win0_t + (size_t)MLA_IN * 2048); const int n16 = (MLA_INP - MLA_IN) * 2048 * 2 / 16;
          for (int i = bx * 512 + tid; i < n16; i += G * 512) z[i] = (u32x4){0u, 0u, 0u, 0u}; }
        for (int i = bx * 512 + tid; i < 3 * T; i += G * 512) ss1[i] = 0.f;
        cvt_rows(P->x, xb, ss0, T, gw, NGW, lane);
        norm_rows(P->mem, P->mem_norm, memn, NB * MEML, gw, NGW, lane);
        for (int i = bx * 512 + tid; i < T * 32; i += G * 512) { const int m = i >> 5, f = i & 31; const float inv = powf(10000.f, -(float)f / 32.f); const float ang = (float)P->pos[m] * inv;
            rope[(size_t)m * 64 + f] = cosf(ang); rope[(size_t)m * 64 + 32 + f] = sinf(ang); }
    }
    SEAM(0);
    PH(1) { PHASE_BEGIN;
        pg8::Gemm g{xb, Win0_t, T, MLA_INP, 2048, 2048, 2048, 0}; pg8::StaticOrder S; S.init(T, MLA_INP, G, bx);
        pg8::EpiBf16<0> E{proj0, proj0, proj0, 2048, 2048, 2048, 1 << 20, 1 << 20, ss0};
        pg8::gemm_phase<pg8::EpiBf16<0>, true>(lds, g, S, E);
    }
    SEAM(1);
    PH(2) { PHASE_BEGIN;
        f32x4 gq_[3], gkv_[2]; const f32x4 gm_ = *(const f32x4*)(P->mem_q_norm + (lane & 31) * 4);
#pragma unroll
        for (int j = 0; j < 3; ++j) gq_[j] = *(const f32x4*)(P->q_lat_norm + (lane + 64 * j) * 4);
#pragma unroll
        for (int j = 0; j < 2; ++j) gkv_[j] = *(const f32x4*)(P->kv_lat_norm + (lane + 64 * j) * 4);
        u32x2 w[7], nw[7]; int m = gw;
#define P2_LOAD(dst, mm) do { const u32x2* r_ = (const u32x2*)(proj0 + (size_t)(mm) * 2048); \
            dst[0] = r_[lane]; dst[1] = r_[lane + 64]; dst[2] = r_[lane + 128]; dst[3] = r_[192 + lane]; dst[4] = r_[192 + lane + 64]; dst[5] = r_[336 + lane]; dst[6] = r_[336 + lane + 64]; } while (0)
        if (m < T) P2_LOAD(w, m);
        for (; m < T; m += NGW) {
            if (m + NGW < T) P2_LOAD(nw, m + NGW);
            asm volatile("" ::: "memory");
            float sq[7];
#pragma unroll
            for (int j = 0; j < 7; ++j) { const float a = bflo(w[j].x), b = bfhi(w[j].x), c = bflo(w[j].y), d = bfhi(w[j].y); sq[j] = (a * a + b * b) + (c * c + d * d); }
            const float rq = rsqrtf(wave_sum(sq[0] + sq[1] + sq[2]) * (1.f / 768.f) + EPS), rkv = rsqrtf(wave_sum(sq[3] + sq[4]) * (1.f / 512.f) + EPS);
            const float rm0 = rsqrtf(half_sum(sq[5]) * (1.f / 128.f) + EPS), rm1 = rsqrtf(half_sum(sq[6]) * (1.f / 128.f) + EPS);
            u32x2* r_ = (u32x2*)(proj0 + (size_t)m * 2048);
#define P2_ST(idx, j, rs, gv) do { u32x2 o_; o_.x = cvt_pk_bf16(bflo(w[j].x) * (rs) * (gv).x, bfhi(w[j].x) * (rs) * (gv).y); o_.y = cvt_pk_bf16(bflo(w[j].y) * (rs) * (gv).z, bfhi(w[j].y) * (rs) * (gv).w); r_[idx] = o_; } while (0)
            P2_ST(lane, 0, rq, gq_[0]); P2_ST(lane + 64, 1, rq, gq_[1]); P2_ST(lane + 128, 2, rq, gq_[2]);
            P2_ST(192 + lane, 3, rkv, gkv_[0]); P2_ST(192 + lane + 64, 4, rkv, gkv_[1]);
            P2_ST(336 + lane, 5, rm0, gm_); P2_ST(336 + lane + 64, 6, rm1, gm_);
            asm volatile("" ::: "memory");
#pragma unroll
            for (int j = 0; j < 7; ++j) w[j] = nw[j];
        }
#undef P2_LOAD
#undef P2_ST
    }
    SEAM(2);
    PH(3) { PHASE_BEGIN;
        { pg8::Gemm g{proj0 + QLORA, Wkvup_t, T, KVW, KVLORA, 2048, KVLORA, 0}; pg8::StaticOrder S; S.init(T, KVW, G, bx);
          pg8::EpiBf16<0> E{kvb, kvb, kvb, KVW, KVW, KVW, 1 << 20, 1 << 20, nullptr}; pg8::gemm_phase<pg8::EpiBf16<0>, true>(lds, g, S, E); }
        { pg8::Gemm g{proj0, Wqup_t, T, QW, QLORA, 2048, QLORA, 0}; pg8::StaticOrder S; S.init(T, QW, G, bx);
          pg8::EpiBf16<0> E{Qb, Qb, Qb, QW, QW, QW, 1 << 20, 1 << 20, nullptr}; pg8::gemm_phase<pg8::EpiBf16<0>, true>(lds, g, S, E); }
        { pg8::Gemm g{memn, Wmkv_t, NB * MEML, 1024, 2048, 2048, 2048, 0}; pg8::StaticOrder S; S.init(NB * MEML, 1024, G, (bx + G - 64) % G);
          pg8::EpiRes E{nullptr, nullptr, mkv, nullptr, nullptr, 1024}; pg8::gemm_phase<pg8::EpiRes, true>(lds, g, S, E); }
    }
    SEAM(3);
    PH(4) { PHASE_BEGIN;
        const int half = lane >> 5, L = lane & 31; const bool act = L < 24, r1 = (L >= 16 && L < 20), r2 = (L >= 20 && L < 24);
        const int partner = r1 ? lane + 4 : (r2 ? lane - 4 : lane);
        float gq[8], gk[8];
#pragma unroll
        for (int j = 0; j < 8; ++j) { gq[j] = act ? P->q_norm[L * 8 + j] : 0.f; gk[j] = act ? P->k_norm[L * 8 + j] : 0.f; }
        for (int m = gw; m < T; m += NGW) {
            float cs[8], sn[8];
            { const int i0 = ((L - 16) & 3) * 8;
#pragma unroll
              for (int j = 0; j < 8; ++j) { cs[j] = rope[(size_t)m * 64 + i0 + j]; sn[j] = rope[(size_t)m * 64 + 32 + i0 + j]; } }
            bf16_t* qrow = Qb + (size_t)m * QW + L * 8; bf16_t* krow = Kb + (size_t)m * QW + L * 8;
            const bf16_t* ksrc = (L < 16) ? kvb + (size_t)m * KVW + L * 8 : proj0 + (size_t)m * 2048 + 1280 + (L - 16) * 8; const int kstep = (L < 16) ? 256 : 0;
            const u32x4 zero4 = {0u, 0u, 0u, 0u};
            u32x4 wq = act ? *(const u32x4*)(qrow + half * QKD) : zero4, wk = act ? *(const u32x4*)(ksrc + half * kstep) : zero4;
#pragma unroll 1
            for (int i = 0; i < 6; ++i) { const int h = 2 * i + half; u32x4 nq = zero4, nk = zero4;
                if (i < 5 && act) { nq = *(const u32x4*)(qrow + (h + 2) * QKD); nk = *(const u32x4*)(ksrc + (h + 2) * kstep); }
                asm volatile("" ::: "memory");
                const u32x4 oq = qk_head(wq, gq, r1, r2, partner, cs, sn), ok = qk_head(wk, gk, r1, r2, partner, cs, sn);
                if (act) { *(u32x4*)(qrow + h * QKD) = oq; *(u32x4*)(krow + h * QKD) = ok; }
                asm volatile("" ::: "memory");
                wq = nq; wk = nk; }
        }
        for (int m = gw; m < NB * MEML; m += NGW) { const float* r = mkv + (size_t)m * 1024;
            const f32x4 k0 = *(const f32x4*)(r + lane * 8), k1 = *(const f32x4*)(r + lane * 8 + 4), v0 = *(const f32x4*)(r + 512 + lane * 8), v1 = *(const f32x4*)(r + 512 + lane * 8 + 4);
            float ss = (k0.x * k0.x + k0.y * k0.y) + (k0.z * k0.z + k0.w * k0.w) + (k1.x * k1.x + k1.y * k1.y) + (k1.z * k1.z + k1.w * k1.w);
#pragma unroll
            for (int o = 1; o < 16; o <<= 1) ss += __shfl_xor(ss, o);
            const float rstd = rsqrtf(ss * (1.f / 128.f) + EPS); const float* gk2 = P->mem_k_norm + (lane & 15) * 8;
            u32x4 ok, ov; ok.x = cvt_pk_bf16(k0.x * rstd * gk2[0], k0.y * rstd * gk2[1]); ok.y = cvt_pk_bf16(k0.z * rstd * gk2[2], k0.w * rstd * gk2[3]);
            ok.z = cvt_pk_bf16(k1.x * rstd * gk2[4], k1.y * rstd * gk2[5]); ok.w = cvt_pk_bf16(k1.z * rstd * gk2[6], k1.w * rstd * gk2[7]);
            ov.x = cvt_pk_bf16(v0.x, v0.y); ov.y = cvt_pk_bf16(v0.z, v0.w); ov.z = cvt_pk_bf16(v1.x, v1.y); ov.w = cvt_pk_bf16(v1.z, v1.w);
            *(u32x4*)(memK + (size_t)m * 512 + lane * 8) = ok; *(u32x4*)(memV + (size_t)m * 512 + lane * 8) = ov; }
    }
    SEAM(4);
    PH(5) { PHASE_BEGIN; if (rep_) grid.sync();
        const int x0 = (int)(xb_xcc_id() & 7u);
        for (int qi = 0; qi < 8; ++qi) { const int q = (x0 + qi) & 7;
            for (;;) {
                if (tid == 0) *s_item = (int)atomicAdd(ctl + 8 * q, 1u);
                __syncthreads(); const int li = *s_item; __syncthreads();
                if (li >= 128) break;
                if (li < 96) { const int qb = 31 - li / 3, bh = q + 8 * (li % 3), b = bh / NHEAD, h = bh % NHEAD; const size_t r0 = (size_t)b * SEQ;
                    att::attn_block<192, true>(Qb + (r0 + qb * 256) * QW + h * QKD, QW, Kb + r0 * QW + h * QKD, QW, kvb + r0 * KVW + h * 256 + 128, KVW,
                                               mixed0 + (r0 + qb * 256) * DM + h * 128, DM, qb * 256, 4 * (qb + 1), 0.07216878364870322f, (LAS char*)lds);
                } else { const int i2 = q * 32 + (li - 96), qb = i2 & 31, mh = (i2 >> 5) & 3, b = i2 >> 7; const size_t r0 = (size_t)b * SEQ;
                    att::attn_block<128, false>(proj0 + (r0 + qb * 256) * 2048 + 1344 + mh * 128, 2048, memK + (size_t)b * MEML * 512 + mh * 128, 512, memV + (size_t)b * MEML * 512 + mh * 128, 512,
                                                mixed0 + (r0 + qb * 256) * DM + LRU_W + mh * 128, DM, 0, 4, 0.08838834764831845f, (LAS char*)lds); }
            } }
    }
    SEAM(5);
    PH(6) { PHASE_BEGIN;
        pg8::Gemm g{mixed0, Wout_t, T, DM, DM, DM, DM, 0}; pg8::StaticOrder S; S.init(T, DM, G, bx);
        pg8::EpiRes E{P->x, nullptr, nullptr, xb, ss1, DM}; pg8::gemm_phase<pg8::EpiRes, true>(lds, g, S, E);
    }
    SEAM(6);
    PH(8) { PHASE_BEGIN; if (rep_) grid.sync();
        pg8::Gemm g{xb, Wmi0_t, T, DFF, DM, DM, DM, 0}; pg8::StaticOrder S; S.init(T, DFF, G, bx);
        pg8::EpiBf16<1> E{ub, ub, ub, DFF, DFF, DFF, 1 << 20, 1 << 20, ss1}; pg8::gemm_phase<pg8::EpiBf16<1>, true>(lds, g, S, E);
    }
    SEAM(8);
    PH(9) { PHASE_BEGIN;
        pg8::Gemm g{ub, Wmo0_t, T, DM, DFF, DFF, DFF, 0}; pg8::StaticOrder S; S.init(T, DM, G, bx);
        pg8::EpiRes E{nullptr, xb, nullptr, xb, ss2, DM}; pg8::gemm_phase<pg8::EpiRes, true>(lds, g, S, E);
    }
    SEAM(9);
    PH(11) { PHASE_BEGIN;
        pg8::Gemm g{xb, Wlru_t, T, LRU_IN, DM, DM, DM, 0}; pg8::StaticOrder S; S.init(T, LRU_IN, G, bx);
        pg8::EpiBf16<2> E{gateb, xinb, mqb, LRU_W, LRU_W, 512, 6, 12, ss2}; pg8::gemm_phase<pg8::EpiBf16<2>, true>(lds, g, S, E);
    }
    SEAM(11);
    PH(12) { PHASE_BEGIN;
        { LAS float* scr = (LAS float*)(lds + wave * TR_SCR_BYTES); constexpr int NIT1 = 2 * (2048 / 64) * (8192 / 64);
#define P12_SELECT(it_, t) do { int r = (it_); if (tr_job(r, P->w_mlp_in + (size_t)2048 * 8192, 2048, 8192, Wmi1_t, P->mlp_norm + DM, t)) {} \
              else tr_job(r, P->w_mlp_out + (size_t)2048 * 8192, 8192, 2048, Wmo1_t, nullptr, t); } while (0)
          int it = gw; TrSel cur, nx; f32x4 v[16], nv[16]; float gg[16], ng[16];
          if (it < NIT1) { P12_SELECT(it, cur); tr_load(cur, lane, v, gg); }
          while (it < NIT1) { const int nit = it + NGW;
              if (nit < NIT1) { P12_SELECT(nit, nx); tr_load(nx, lane, nv, ng); }
              asm volatile("" ::: "memory");
              tr_store(cur, v, gg, scr, lane);
              asm volatile("" ::: "memory");
              cur = nx; it = nit;
#pragma unroll
              for (int i = 0; i < 16; ++i) { v[i] = nv[i]; gg[i] = ng[i]; } } }
#undef P12_SELECT
        for (int item = gw; item < (T / 32) * 3; item += NGW) { const int third = item % 3, m0 = (item / 3) * 32; const int c0 = third * 512 + lane * 8;
            float wt[4][8], bs[8];
#pragma unroll
            for (int k = 0; k < 4; ++k) { const f32x4 w0 = *(const f32x4*)(P->conv_w + k * LRU_W + c0), w1 = *(const f32x4*)(P->conv_w + k * LRU_W + c0 + 4);
                wt[k][0] = w0.x; wt[k][1] = w0.y; wt[k][2] = w0.z; wt[k][3] = w0.w; wt[k][4] = w1.x; wt[k][5] = w1.y; wt[k][6] = w1.z; wt[k][7] = w1.w; }
            { const f32x4 b0 = *(const f32x4*)(P->conv_b + c0), b1 = *(const f32x4*)(P->conv_b + c0 + 4); bs[0] = b0.x; bs[1] = b0.y; bs[2] = b0.z; bs[3] = b0.w; bs[4] = b1.x; bs[5] = b1.y; bs[6] = b1.z; bs[7] = b1.w; }
            const bf16_t* xp = xinb + c0; u32x4 win[3], cur[4], nxt[4];
#pragma unroll
            for (int k = 0; k < 3; ++k) { const int mm = m0 - 3 + k; win[k] = *(const u32x4*)(xp + (size_t)(mm < 0 ? 0 : mm) * LRU_W); }
#pragma unroll
            for (int k = 0; k < 4; ++k) cur[k] = *(const u32x4*)(xp + (size_t)(m0 + k) * LRU_W);
#pragma unroll 1
            for (int g = 0; g < 8; ++g) { const int mg = m0 + 4 * g;
                if (g < 7) {
#pragma unroll
                    for (int k = 0; k < 4; ++k) nxt[k] = *(const u32x4*)(xp + (size_t)(mg + 4 + k) * LRU_W); }
                asm volatile("" ::: "memory");
                u32x4 outv[4];
#pragma unroll
                for (int r = 0; r < 4; ++r) { const int sidx = (mg + r) & (SEQ - 1); float acc[8];
#pragma unroll
                    for (int e = 0; e < 8; ++e) acc[e] = bs[e];
#pragma unroll
                    for (int k = 0; k < 4; ++k) { const int wi = r + k; const u32x4 xv = wi < 3 ? win[wi] : cur[wi - 3];
                        if (sidx - 3 + k >= 0) { acc[0] += wt[k][0] * bflo(xv.x); acc[1] += wt[k][1] * bfhi(xv.x); acc[2] += wt[k][2] * bflo(xv.y); acc[3] += wt[k][3] * bfhi(xv.y);
                                                 acc[4] += wt[k][4] * bflo(xv.z); acc[5] += wt[k][5] * bfhi(xv.z); acc[6] += wt[k][6] * bflo(xv.w); acc[7] += wt[k][7] * bfhi(xv.w); } }
                    outv[r].x = cvt_pk_bf16(acc[0], acc[1]); outv[r].y = cvt_pk_bf16(acc[2], acc[3]); outv[r].z = cvt_pk_bf16(acc[4], acc[5]); outv[r].w = cvt_pk_bf16(acc[6], acc[7]); }
#pragma unroll
                for (int r = 0; r < 4; ++r) *(u32x4*)(xcb + (size_t)(mg + r) * LRU_W + c0) = outv[r];
                asm volatile("" ::: "memory");
                win[0] = cur[1]; win[1] = cur[2]; win[2] = cur[3];
#pragma unroll
                for (int k = 0; k < 4; ++k) cur[k] = nxt[k]; } }
        { const f32x4 gm_ = *(const f32x4*)(P->mem_q_norm + 128 + (lane & 31) * 4); u32x2 w0, w1, n0, n1; int m = gw;
          if (m < T) { const u32x2* r_ = (const u32x2*)(mqb + (size_t)m * 512); w0 = r_[lane]; w1 = r_[lane + 64]; }
          for (; m < T; m += NGW) {
              if (m + NGW < T) { const u32x2* r_ = (const u32x2*)(mqb + (size_t)(m + NGW) * 512); n0 = r_[lane]; n1 = r_[lane + 64]; }
              asm volatile("" ::: "memory");
              float s0, s1; { const float a = bflo(w0.x), b = bfhi(w0.x), c = bflo(w0.y), d = bfhi(w0.y); s0 = (a * a + b * b) + (c * c + d * d); }
              { const float a = bflo(w1.x), b = bfhi(w1.x), c = bflo(w1.y), d = bfhi(w1.y); s1 = (a * a + b * b) + (c * c + d * d); }
              const float r0 = rsqrtf(half_sum(s0) * (1.f / 128.f) + EPS), r1 = rsqrtf(half_sum(s1) * (1.f / 128.f) + EPS);
              u32x2* r_ = (u32x2*)(mqb + (size_t)m * 512); u32x2 o;
              o.x = cvt_pk_bf16(bflo(w0.x) * r0 * gm_.x, bfhi(w0.x) * r0 * gm_.y); o.y = cvt_pk_bf16(bflo(w0.y) * r0 * gm_.z, bfhi(w0.y) * r0 * gm_.w); r_[lane] = o;
              o.x = cvt_pk_bf16(bflo(w1.x) * r1 * gm_.x, bfhi(w1.x) * r1 * gm_.y); o.y = cvt_pk_bf16(bflo(w1.y) * r1 * gm_.z, bfhi(w1.y) * r1 * gm_.w); r_[lane + 64] = o;
              asm volatile("" ::: "memory");
              w0 = n0; w1 = n1; } }
    }
    SEAM(12);
    PH(13) { PHASE_BEGIN;
        pg8::Gemm g{xcb, Wg_t, T, 12 * 256, 128, LRU_W, 128, 256}; pg8::StaticOrder S; S.init(T, 12 * 256, G, bx);
        pg8::EpiGates E{P->b_gate_a, P->b_gate_i, clam, ascan, bscan, (LAS float*)(lds + LDS_MISC + 256)}; pg8::gemm_phase<pg8::EpiGates, true>(lds, g, S, E);
    }
    SEAM(13);
    PH(14) { PHASE_BEGIN;
        for (int it = bx; it < NB * NCHUNK; it += G) { const int ch = it % NCHUNK, b = it / NCHUNK;
            if (tid < LRU_W / 4) { const int c = tid * 4; const size_t base = ((size_t)b * SEQ + (size_t)ch * CHL) * LRU_W + c; float h[4] = {0.f, 0.f, 0.f, 0.f}, Pp[4] = {1.f, 1.f, 1.f, 1.f};
#pragma unroll 8
                for (int s = 0; s < CHL; ++s) { const u32x2 aw = *(const u32x2*)(ascan + base + (size_t)s * LRU_W), bw = *(const u32x2*)(bscan + base + (size_t)s * LRU_W), xw = *(const u32x2*)(xcb + base + (size_t)s * LRU_W);
                    const float av[4] = {1.f - bflo(aw.x), 1.f - bfhi(aw.x), 1.f - bflo(aw.y), 1.f - bfhi(aw.y)}, bv[4] = {bflo(bw.x) * bflo(xw.x), bfhi(bw.x) * bfhi(xw.x), bflo(bw.y) * bflo(xw.y), bfhi(bw.y) * bfhi(xw.y)};
#pragma unroll
                    for (int j = 0; j < 4; ++j) { h[j] = av[j] * h[j] + bv[j]; Pp[j] *= av[j]; } }
                *(f32x4*)(carryP + ((size_t)b * NCHUNK + ch) * LRU_W + c) = (f32x4){Pp[0], Pp[1], Pp[2], Pp[3]}; *(f32x4*)(carryH + ((size_t)b * NCHUNK + ch) * LRU_W + c) = (f32x4){h[0], h[1], h[2], h[3]}; } }
        for (int i2 = bx; i2 < NB * 4 * 32; i2 += G) { const int qb = i2 & 31, mh = (i2 >> 5) & 3, b = i2 >> 7; const size_t r0 = (size_t)b * SEQ;
            att::attn_block<128, false>(mqb + (r0 + qb * 256) * 512 + mh * 128, 512, memK + (size_t)b * MEML * 512 + mh * 128, 512, memV + (size_t)b * MEML * 512 + mh * 128, 512,
                                        mixed1 + (r0 + qb * 256) * DM + LRU_W + mh * 128, DM, 0, 4, 0.08838834764831845f, (LAS char*)lds); }
    }
    SEAM(14);
    PH(15) { PHASE_BEGIN;
        for (int it = bx; it < NB * NCHUNK; it += G) { const int ch = it % NCHUNK, b = it / NCHUNK;
            if (tid < LRU_W / 4) { const int c = tid * 4; float h[4] = {0.f, 0.f, 0.f, 0.f};
#pragma unroll 4
                for (int j = 0; j < ch; ++j) { const size_t ci = ((size_t)b * NCHUNK + j) * LRU_W + c; const f32x4 cp = *(const f32x4*)(carryP + ci), chh = *(const f32x4*)(carryH + ci);
                    h[0] = cp.x * h[0] + chh.x; h[1] = cp.y * h[1] + chh.y; h[2] = cp.z * h[2] + chh.z; h[3] = cp.w * h[3] + chh.w; }
                const size_t row0 = (size_t)b * SEQ + (size_t)ch * CHL;
                u32x2 ca[8], cb[8], cg_[8], cx[8], na[8], nb[8], ng[8], nx_[8];
#pragma unroll
                for (int j = 0; j < 8; ++j) { const size_t off = (row0 + j) * LRU_W + c; ca[j] = *(const u32x2*)(ascan + off); cb[j] = *(const u32x2*)(bscan + off); cg_[j] = *(const u32x2*)(gateb + off); cx[j] = *(const u32x2*)(xcb + off); }
#pragma unroll 1
                for (int s0 = 0; s0 < CHL; s0 += 8) {
                    if (s0 + 8 < CHL) {
#pragma unroll
                        for (int j = 0; j < 8; ++j) { const size_t off = (row0 + s0 + 8 + j) * LRU_W + c; na[j] = *(const u32x2*)(ascan + off); nb[j] = *(const u32x2*)(bscan + off); ng[j] = *(const u32x2*)(gateb + off); nx_[j] = *(const u32x2*)(xcb + off); } }
                    asm volatile("" ::: "memory");
                    u32x2 y[8];
#pragma unroll
                    for (int j = 0; j < 8; ++j) { h[0] = (1.f - bflo(ca[j].x)) * h[0] + bflo(cb[j].x) * bflo(cx[j].x); h[1] = (1.f - bfhi(ca[j].x)) * h[1] + bfhi(cb[j].x) * bfhi(cx[j].x);
                        h[2] = (1.f - bflo(ca[j].y)) * h[2] + bflo(cb[j].y) * bflo(cx[j].y); h[3] = (1.f - bfhi(ca[j].y)) * h[3] + bfhi(cb[j].y) * bfhi(cx[j].y);
                        y[j].x = cvt_pk_bf16(h[0] * bflo(cg_[j].x), h[1] * bfhi(cg_[j].x)); y[j].y = cvt_pk_bf16(h[2] * bflo(cg_[j].y), h[3] * bfhi(cg_[j].y)); }
#pragma unroll
                    for (int j = 0; j < 8; ++j) *(u32x2*)(mixed1 + (row0 + s0 + j) * DM + c) = y[j];
                    asm volatile("" ::: "memory");
#pragma unroll
                    for (int j = 0; j < 8; ++j) { ca[j] = na[j]; cb[j] = nb[j]; cg_[j] = ng[j]; cx[j] = nx_[j]; }
                } } }
    }
    SEAM(15);
    PH(16) { PHASE_BEGIN;
        pg8::Gemm g{mixed1, Wout_t + (size_t)DM * DM, T, DM, DM, DM, DM, 0}; pg8::StaticOrder S; S.init(T, DM, G, bx);
        pg8::EpiRes E{nullptr, xb, nullptr, xb, ss3, DM}; pg8::gemm_phase<pg8::EpiRes, true>(lds, g, S, E);
    }
    SEAM(16);
    PH(18) { PHASE_BEGIN;
        pg8::Gemm g{xb, Wmi1_t, T, DFF, DM, DM, DM, 0}; pg8::StaticOrder S; S.init(T, DFF, G, bx);
        pg8::EpiBf16<1> E{ub, ub, ub, DFF, DFF, DFF, 1 << 20, 1 << 20, ss3}; pg8::gemm_phase<pg8::EpiBf16<1>, true>(lds, g, S, E);
    }
    SEAM(18);
    PH(19) { PHASE_BEGIN;
        pg8::Gemm g{ub, Wmo1_t, T, DM, DFF, DFF, DFF, 0}; pg8::StaticOrder S; S.init(T, DM, G, bx);
        pg8::EpiRes E{nullptr, xb, P->out, nullptr, nullptr, DM}; pg8::gemm_phase<pg8::EpiRes, true>(lds, g, S, E);
    }
#undef PH
#undef SEAM
}

#ifndef ONE_LAUNCH
#define ONE_LAUNCH 1
#endif
extern "C" void kernel_launch(void* const* d_in, const int* in_sizes, int n_in, void* d_out, int out_size, void* d_ws, size_t ws_size, hipStream_t stream) {
    static int grid = 0;
    if (grid == 0) {
        if (n_in != 27 || ws_size < WS_END) { fprintf(stderr, "kernel_launch: unexpected n_in %d / ws_size %zu\n", n_in, ws_size); grid = -1; return; }
        int dev = 0, cus = 0, per_cu = 0;
        hipGetDevice(&dev); hipDeviceGetAttribute(&cus, hipDeviceAttributeMultiprocessorCount, dev);
        hipFuncSetAttribute((const void*)fwd_kernel, hipFuncAttributeMaxDynamicSharedMemorySize, LDS_TOTAL);
        hipOccupancyMaxActiveBlocksPerMultiprocessor(&per_cu, (const void*)fwd_kernel, 512, LDS_TOTAL);
        if (per_cu < 1) { fprintf(stderr, "kernel_launch: occupancy query says %d blocks per CU\n", per_cu); per_cu = 1; }
        (void)hipGetLastError();
        grid = cus;
    }
    if (grid < 0) return;
    Params p{};
    p.x = (const float*)d_in[0]; p.mem = (const float*)d_in[1]; p.pos = (const int*)d_in[2];
    p.mix_norm = (const float*)d_in[3]; p.mlp_norm = (const float*)d_in[4]; p.w_out = (const float*)d_in[5]; p.w_mlp_in = (const float*)d_in[6]; p.w_mlp_out = (const float*)d_in[7];
    p.mem_norm = (const float*)d_in[8]; p.w_mem_kv = (const float*)d_in[9]; p.mem_k_norm = (const float*)d_in[10]; p.mem_q_norm = (const float*)d_in[11]; p.w_in_mla = (const float*)d_in[12];
    p.q_lat_norm = (const float*)d_in[13]; p.w_q_up = (const float*)d_in[14]; p.kv_lat_norm = (const float*)d_in[15]; p.w_kv_up = (const float*)d_in[16]; p.q_norm = (const float*)d_in[17];
    p.k_norm = (const float*)d_in[18]; p.w_in_lru = (const float*)d_in[19]; p.conv_w = (const float*)d_in[20]; p.conv_b = (const float*)d_in[21]; p.w_gate_a = (const float*)d_in[22];
    p.b_gate_a = (const float*)d_in[23]; p.w_gate_i = (const float*)d_in[24]; p.b_gate_i = (const float*)d_in[25]; p.lru_lambda = (const float*)d_in[26];
    p.out = (float*)d_out; p.ws = (unsigned char*)d_ws;
#if ONE_LAUNCH
    (void)hipMemsetAsync((char*)d_ws + WS_CTL + 16384, 0, 16384, stream);
    p.ph_lo = 0; p.ph_hi = NPHASE;
    void* args[] = {&p};
    hipError_t e = hipLaunchCooperativeKernel((const void*)fwd_kernel, dim3(grid), dim3(512), args, LDS_TOTAL, stream);
    if (e != hipSuccess) fprintf(stderr, "cooperative launch failed: %s (grid %d)\n", hipGetErrorString(e), grid);
#else
    for (int k = 0; k < NPHASE; ++k) { p.ph_lo = k; p.ph_hi = k + 1; hipLaunchKernelGGL(fwd_kernel, dim3(grid), dim3(512), LDS_TOTAL, stream, p); }
#endif
}
```

```cpp
#include <hip/hip_runtime.h>
#include <hip/hip_cooperative_groups.h>
#include <cstdio>
#include <cstdint>
namespace cg = cooperative_groups;

#define LAS __attribute__((address_space(3)))
typedef unsigned short bf16_t;
typedef short bf16x8 __attribute__((ext_vector_type(8)));
typedef short s16x4 __attribute__((ext_vector_type(4)));
typedef float f32x4 __attribute__((ext_vector_type(4)));
typedef float f32x16 __attribute__((ext_vector_type(16)));
typedef unsigned u32x4 __attribute__((ext_vector_type(4)));
typedef unsigned u32x2 __attribute__((ext_vector_type(2)));

constexpr int DM = 2048, SEQ = 8192, NB = 2, T = NB * SEQ, MEML = 256;
constexpr int MLA_IN = 1856, MLA_INP = 2048, QLORA = 768, KVLORA = 512, NHEAD = 12, QKD = 192, LRU_W = 1536, LRU_IN = 3584, DFF = 8192;
constexpr int QW = NHEAD * QKD  , KVW = NHEAD * 256  ;
constexpr float EPS = 1e-6f;
constexpr int NCHUNK = 128, CHL = 64;

constexpr size_t MiB = 1u << 20;
constexpr size_t WS_CTL = 0;
constexpr size_t WS_SS = 256 * 1024;
constexpr size_t WS_WIN0 = 1 * MiB;
constexpr size_t WS_WQUP = WS_WIN0 + 8 * MiB;
constexpr size_t WS_WKVUP = WS_WQUP + 3456 * 1024;
constexpr size_t WS_WOUT = WS_WKVUP + 3 * MiB;
constexpr size_t WS_WLRU = WS_WOUT + 16 * MiB;
constexpr size_t WS_WMKV = WS_WLRU + 14 * MiB;
constexpr size_t WS_WG = WS_WMKV + 4 * MiB;
constexpr size_t WS_MEMN = WS_WG + 1 * MiB;
constexpr size_t WS_MKV = WS_MEMN + 2 * MiB;
constexpr size_t WS_MEMK = WS_MKV + 2 * MiB;
constexpr size_t WS_MEMV = WS_MEMK + 512 * 1024;
constexpr size_t WS_ROPE = WS_MEMV + 512 * 1024;
constexpr size_t WS_CARRY = WS_ROPE + 4 * MiB;
constexpr size_t WS_A0 = 64 * MiB;
constexpr size_t WS_A1 = 128 * MiB;
constexpr size_t WS_S1 = 192 * MiB;
static_assert(WS_CARRY + 3 * MiB <= WS_A0, "ws map");
constexpr size_t WS_U = 256 * MiB;
constexpr size_t WS_END = 512 * MiB;
constexpr size_t U_PROJ0 = WS_U;
constexpr size_t U_KV = WS_U + 64 * MiB;
constexpr size_t U_K = WS_U + 160 * MiB;
constexpr size_t U_GATE = WS_U;
constexpr size_t U_XIN = WS_U + 48 * MiB;
constexpr size_t U_MQ = WS_U + 96 * MiB;
constexpr size_t U_XC = WS_U + 112 * MiB;
constexpr size_t U_A = WS_U + 160 * MiB;

__device__ __forceinline__ unsigned cvt_pk_bf16(float lo, float hi) { unsigned r; asm volatile("v_cvt_pk_bf16_f32 %0, %1, %2" : "=v"(r) : "v"(lo), "v"(hi)); return r; }
__device__ __forceinline__ float bflo(unsigned u) { return __uint_as_float(u << 16); }
__device__ __forceinline__ float bfhi(unsigned u) { return __uint_as_float(u & 0xffff0000u); }
__device__ __forceinline__ float bf1(bf16_t u) { return __uint_as_float(((unsigned)u) << 16); }
__device__ __forceinline__ bf16_t f2bf(float f) { return (bf16_t)(cvt_pk_bf16(f, 0.f) & 0xffffu); }
__device__ __forceinline__ float wave_sum(float v) {
#pragma unroll
    for (int o = 1; o < 64; o <<= 1) v += __shfl_xor(v, o);
    return v;
}
__device__ __forceinline__ float half_sum(float v) {
#pragma unroll
    for (int o = 1; o < 32; o <<= 1) v += __shfl_xor(v, o);
    return v;
}
__device__ __forceinline__ int my_tid() { int t = threadIdx.x; asm volatile("" : "+v"(t)); return t; }
__device__ __forceinline__ float sigmoidf_(float x) { return __builtin_amdgcn_rcpf(1.f + __expf(-x)); }

namespace pg8 {
constexpr int BM = 256, BK = 64, HALF = 128, HTB = HALF * BK * 2, STAGE_BYTES = 8 * HTB, NXCD = 8, WGM = 4;
__host__ __device__ __forceinline__ int lds_byte(int r, int c) { const int st = (r >> 4) * 2 + (c >> 5), rr = r & 15, cc = c & 31, ob = rr * 64 + cc * 2; return st * 1024 + (ob ^ (((ob >> 9) & 1) << 5)); }
__host__ __device__ __forceinline__ void stage_rc(int b, int& R, int& C) { const int st = b / 1024, sb = b % 1024, swz = sb ^ (((sb >> 9) & 1) << 5); R = (st >> 1) * 16 + swz / 64; C = (st & 1) * 32 + (swz % 64) / 2; }
__host__ __device__ __forceinline__ int perm32(int rho) { const int n = rho >> 4, i = rho & 15; return 8 * (i >> 2) + 4 * n + (i & 3); }
struct Unit { int pm, pn; };
struct Gemm { const bf16_t* A; const bf16_t* Bt; int M, N, K, lda, ldb, acol; };
struct StaticOrder {
    int nM, nN, nwg, G, c;
    __host__ __device__ void init(int M, int N, int G_, int c_) { nM = M / BM; nN = N / BM; nwg = nM * nN; G = G_; c = c_; }
    __host__ __device__ bool next(int i, Unit& u) const {
        const long L = (long)i * G + c; if (L >= nwg) return false;
        int wgid = (int)L; { const int q = nwg / NXCD, r = nwg % NXCD, xcd = wgid % NXCD, off = wgid / NXCD; wgid = (xcd < r ? xcd * (q + 1) : r * (q + 1) + (xcd - r) * q) + off; }
        const int nig = WGM * nN, gid = wgid / nig, fm = gid * WGM, gsz = (nM - fm) < WGM ? (nM - fm) : WGM;
        u.pm = fm + ((wgid % nig) % gsz); u.pn = (wgid % nig) / gsz; return true;
    }
};
template <class Epi, bool ALIGN_EPI>
__device__ __forceinline__ void gemm_phase(LAS unsigned char* lds, const Gemm g, const StaticOrder& S, const Epi& E) {
    const int tid = my_tid(), wid = __builtin_amdgcn_readfirstlane(tid >> 6), lane = tid & 63, wr = wid >> 2, wc = wid & 3, fr = lane & 15, fq = lane >> 4;
    const int nt = g.K / BK;
    unsigned voffA[2], voffB[2];
#pragma unroll
    for (int i = 0; i < 2; ++i) { int R, C; stage_rc(tid * 16 + i * 8192, R, C); const int Rb = Epi::PERM ? ((R & ~31) + perm32(R & 31)) : R;
        voffA[i] = (unsigned)(R * g.lda + C) * 2u; voffB[i] = (unsigned)(Rb * g.ldb + C) * 2u; }
    const size_t kstep = (size_t)(BK * 2);
    const size_t hA = (size_t)HALF * g.lda * 2, hB = (size_t)HALF * g.ldb * 2;
    const size_t tA = 2 * hA, tB = 2 * hB;
    const unsigned ldsw = (unsigned)wid * 1024u;
    const int aoff = lds_byte(wr * 64 + fr, fq * 8), boff = lds_byte(wc * 32 + fr, fq * 8);
#define PG8_SA(b, h) (((b) * 2 + (h)) * HTB)
#define PG8_SB(b, h) ((4 + (b) * 2 + (h)) * HTB)
#define PG8_STAGE(bufoff, gbase, voff) do { _Pragma("unroll") for (int _i = 0; _i < 2; ++_i) \
        __builtin_amdgcn_global_load_lds((const unsigned*)((const char*)(gbase) + (voff)[_i]), (LAS unsigned*)(lds + (bufoff) + ldsw + _i * 8192), 16, 0, 0); } while (0)
#define PG8_LDA(dst, b, h) do { _Pragma("unroll") for (int m = 0; m < 4; ++m) _Pragma("unroll") for (int k = 0; k < 2; ++k) dst[m][k] = *(const LAS bf16x8*)(lds + PG8_SA(b, h) + aoff + m * 2048 + k * 1024); } while (0)
#define PG8_LDB(dst, b, h) do { _Pragma("unroll") for (int n = 0; n < 2; ++n) _Pragma("unroll") for (int k = 0; k < 2; ++k) dst[n][k] = *(const LAS bf16x8*)(lds + PG8_SB(b, h) + boff + n * 2048 + k * 1024); } while (0)
#define PG8_MMA(ai, bj, At, Bt) do { __builtin_amdgcn_s_setprio(1); _Pragma("unroll") for (int m = 0; m < 4; ++m) _Pragma("unroll") for (int n = 0; n < 2; ++n) _Pragma("unroll") for (int k = 0; k < 2; ++k) \
        acc[ai][bj][m][n] = __builtin_amdgcn_mfma_f32_16x16x32_bf16(Bt[n][k], At[m][k], acc[ai][bj][m][n], 0, 0, 0); __builtin_amdgcn_s_setprio(0); } while (0)
#define PG8_WAIT_V(n) asm volatile("s_waitcnt vmcnt(" #n ")" ::: "memory")
#define PG8_WAIT_L(n) asm volatile("s_waitcnt lgkmcnt(" #n ")" ::: "memory")
#define PG8_BAR __builtin_amdgcn_s_barrier()
#define PG8_SCHED __builtin_amdgcn_sched_barrier(0)
    Unit cur, nxt; int ui = 0;
    if (!S.next(0, cur)) return;
    float rsv[8], rsn[8];
    E.pre(cur, wr, fr, rsv); E.post(0, rsv);
    f32x4 acc[2][2][4][2];
#pragma unroll
    for (int a = 0; a < 2; ++a)
#pragma unroll
        for (int b = 0; b < 2; ++b)
#pragma unroll
            for (int m = 0; m < 4; ++m)
#pragma unroll
                for (int n = 0; n < 2; ++n) acc[a][b][m][n] = (f32x4){0.f, 0.f, 0.f, 0.f};
    bf16x8 At[4][2], B0[2][2], B1[2][2];
    const char* cA = (const char*)g.A + (size_t)cur.pm * tA + (size_t)cur.pn * g.acol; const char* cB = (const char*)g.Bt + (size_t)cur.pn * tB;
    PG8_STAGE(PG8_SB(0, 0), cB, voffB); PG8_STAGE(PG8_SB(0, 1), cB + hB, voffB); PG8_STAGE(PG8_SA(0, 0), cA, voffA); PG8_STAGE(PG8_SA(0, 1), cA + hA, voffA);
    if (wr == 1) PG8_BAR;
    PG8_WAIT_V(2); PG8_BAR;
    PG8_STAGE(PG8_SB(1, 0), cB + kstep, voffB); PG8_STAGE(PG8_SA(1, 0), cA + kstep, voffA); PG8_STAGE(PG8_SB(1, 1), cB + hB + kstep, voffB);
    PG8_WAIT_V(6); PG8_BAR;
    for (;;) {
        const bool has_next = S.next(ui + 1, nxt);
        const char* nA = has_next ? (const char*)g.A + (size_t)nxt.pm * tA + (size_t)nxt.pn * g.acol : cA; const char* nB = has_next ? (const char*)g.Bt + (size_t)nxt.pn * tB : cB;
        for (int t = 0; t < nt; t += 2) {
            const bool last = (t == nt - 2);
            const char* a1 = cA + (size_t)(t + 1) * kstep;
            const char* a2 = last ? nA : cA + (size_t)(t + 2) * kstep; const char* b2 = last ? nB : cB + (size_t)(t + 2) * kstep;
            const char* a3 = a2 + kstep; const char* b3 = b2 + kstep;
            PG8_LDB(B0, 0, 0); PG8_LDB(B1, 0, 1); PG8_SCHED; PG8_LDA(At, 0, 0); PG8_STAGE(PG8_SA(1, 1), a1 + hA, voffA);
            PG8_WAIT_V(8); PG8_WAIT_L(0); PG8_BAR; PG8_MMA(0, 0, At, B0); PG8_MMA(0, 1, At, B1); PG8_BAR; PG8_SCHED;
            PG8_LDA(At, 0, 1); PG8_STAGE(PG8_SB(0, 0), b2, voffB); PG8_STAGE(PG8_SB(0, 1), b2 + hB, voffB); PG8_STAGE(PG8_SA(0, 0), a2, voffA);
            PG8_WAIT_V(8); PG8_WAIT_L(0); PG8_BAR; PG8_MMA(1, 0, At, B0); PG8_MMA(1, 1, At, B1); PG8_BAR; PG8_SCHED;
            PG8_LDB(B0, 1, 0); PG8_LDB(B1, 1, 1); PG8_SCHED; PG8_LDA(At, 1, 0); PG8_STAGE(PG8_SA(0, 1), a2 + hA, voffA);
            PG8_WAIT_V(8); PG8_WAIT_L(0); PG8_BAR; PG8_MMA(0, 0, At, B0); PG8_MMA(0, 1, At, B1); PG8_BAR; PG8_SCHED;
            PG8_LDA(At, 1, 1); PG8_STAGE(PG8_SB(1, 0), b3, voffB); PG8_STAGE(PG8_SB(1, 1), b3 + hB, voffB); PG8_STAGE(PG8_SA(1, 0), a3, voffA);
            PG8_WAIT_V(8); PG8_WAIT_L(0); PG8_BAR; PG8_MMA(1, 0, At, B0); PG8_MMA(1, 1, At, B1); PG8_BAR; PG8_SCHED;
        }
        if constexpr (ALIGN_EPI) { if (wr == 0) PG8_BAR; }
        if (has_next) E.pre(nxt, wr, fr, rsn);
        E(acc, cur, wr, wc, fr, fq, ui, rsv);
        if (!has_next) break;
        E.post(ui + 1, rsn);
#pragma unroll
        for (int a = 0; a < 2; ++a)
#pragma unroll
            for (int b = 0; b < 2; ++b)
#pragma unroll
                for (int m = 0; m < 4; ++m)
#pragma unroll
                    for (int n = 0; n < 2; ++n) acc[a][b][m][n] = (f32x4){0.f, 0.f, 0.f, 0.f};
        cur = nxt; cA = nA; cB = nB; ++ui;
#pragma unroll
        for (int i_ = 0; i_ < 8; ++i_) rsv[i_] = rsn[i_];
        if constexpr (ALIGN_EPI) { if (wr == 1) PG8_BAR; }
    }
    PG8_WAIT_V(0);
    if constexpr (!ALIGN_EPI) { if (wr == 0) PG8_BAR; }
    PG8_BAR;
#undef PG8_SA
#undef PG8_SB
#undef PG8_STAGE
#undef PG8_LDA
#undef PG8_LDB
#undef PG8_MMA
#undef PG8_WAIT_V
#undef PG8_WAIT_L
#undef PG8_BAR
#undef PG8_SCHED
}

template <int ACT> struct EpiBf16 {
    static constexpr bool PERM = true;
    bf16_t* O0; bf16_t* O1; bf16_t* O2; int ld0, ld1, ld2, pn1, pn2; const float* ss;
    __device__ __forceinline__ void pre(const Unit& u, int wr, int fr, float (&rsv)[8]) const {
        const int row0 = u.pm * BM + wr * 64 + fr;
#pragma unroll
        for (int i = 0; i < 8; ++i) rsv[i] = ss ? ss[row0 + (i >> 2) * HALF + (i & 3) * 16] : 0.f;
    }
    __device__ __forceinline__ void post(int, const float (&)[8]) const {}
    __device__ __forceinline__ void operator()(const f32x4 (&acc)[2][2][4][2], const Unit& u, int wr, int wc, int fr, int fq, int, const float (&rsv_)[8]) const {
        bf16_t* base; int ldc, pnl; bool act2 = false;
        if (u.pn < pn1) { base = O0; ldc = ld0; pnl = u.pn; act2 = true; } else if (u.pn < pn2) { base = O1; ldc = ld1; pnl = u.pn - pn1; } else { base = O2; ldc = ld2; pnl = u.pn - pn2; }
        const int row0 = u.pm * BM + wr * 64 + fr; const int col0 = pnl * BM + wc * 32 + 8 * fq;
        float rsv[2][4];
#pragma unroll
        for (int ai = 0; ai < 2; ++ai)
#pragma unroll
            for (int m = 0; m < 4; ++m) rsv[ai][m] = ss ? rsqrtf(rsv_[ai * 4 + m] * (1.f / 2048.f) + EPS) : 1.f;
#pragma unroll
        for (int ai = 0; ai < 2; ++ai)
#pragma unroll
            for (int m = 0; m < 4; ++m) { bf16_t* rowp = base + (size_t)(row0 + ai * HALF + m * 16) * ldc + col0;
                const float rs = rsv[ai][m];
#pragma unroll
                for (int bj = 0; bj < 2; ++bj) { f32x4 v0 = acc[ai][bj][m][0] * rs, v1 = acc[ai][bj][m][1] * rs;
                    if (ACT == 1) {
#pragma unroll
                        for (int j = 0; j < 4; ++j) { const float a = fmaxf(v0[j], 0.f), b = fmaxf(v1[j], 0.f); v0[j] = a * a; v1[j] = b * b; } }
                    if (ACT == 2) { if (act2) {
#pragma unroll
                        for (int j = 0; j < 4; ++j) { float x = v0[j]; float z = 0.7978845608028654f * (x + 0.044715f * x * x * x); v0[j] = x / (1.f + __expf(-2.f * z));
                                                      x = v1[j]; z = 0.7978845608028654f * (x + 0.044715f * x * x * x); v1[j] = x / (1.f + __expf(-2.f * z)); } } }
                    u32x4 w; w.x = cvt_pk_bf16(v0[0], v0[1]); w.y = cvt_pk_bf16(v0[2], v0[3]); w.z = cvt_pk_bf16(v1[0], v1[1]); w.w = cvt_pk_bf16(v1[2], v1[3]);
                    { u32x4* dp_ = (u32x4*)(rowp + bj * HALF); asm volatile("global_store_dwordx4 %0, %1, off sc1\n\ts_nop 1" :: "v"(dp_), "v"(w) : "memory"); } } }
    }
};
struct EpiRes {
    static constexpr bool PERM = true;
    const float* basef; const bf16_t* baseb; float* outf; bf16_t* outb; float* ss; int ldc;
    __device__ __forceinline__ void pre(const Unit&, int, int, float (&)[8]) const {}
    __device__ __forceinline__ void post(int, const float (&)[8]) const {}
    __device__ __forceinline__ void operator()(const f32x4 (&acc)[2][2][4][2], const Unit& u, int wr, int wc, int fr, int fq, int, const float (&)[8]) const {
        const int col0 = u.pn * BM + wc * 32 + 8 * fq; const int row0 = u.pm * BM + wr * 64 + fr;
        float part[2][4];
        f32x4 c0[2], c1[2], n0[2], n1[2];
#define ER_LOAD(d0_, d1_, aim_) do { _Pragma("unroll") for (int bj = 0; bj < 2; ++bj) { const size_t off_ = (size_t)(row0 + ((aim_) >> 2) * HALF + ((aim_) & 3) * 16) * ldc + col0 + bj * HALF; \
            if (basef) { d0_[bj] = *(const f32x4*)(basef + off_); d1_[bj] = *(const f32x4*)(basef + off_ + 4); } \
            else if (baseb) { const u32x4 bw = *(const u32x4*)(baseb + off_); d0_[bj] = (f32x4){bflo(bw.x), bfhi(bw.x), bflo(bw.y), bfhi(bw.y)}; d1_[bj] = (f32x4){bflo(bw.z), bfhi(bw.z), bflo(bw.w), bfhi(bw.w)}; } \
            else { d0_[bj] = (f32x4){0.f, 0.f, 0.f, 0.f}; d1_[bj] = (f32x4){0.f, 0.f, 0.f, 0.f}; } } } while (0)
        ER_LOAD(c0, c1, 0);
#pragma unroll
        for (int aim = 0; aim < 8; ++aim) { const int ai = aim >> 2, m = aim & 3;
            if (aim < 7) ER_LOAD(n0, n1, aim + 1);
            asm volatile("" ::: "memory");
            float pp = 0.f;
#pragma unroll
            for (int bj = 0; bj < 2; ++bj) { const size_t off = (size_t)(row0 + ai * HALF + m * 16) * ldc + col0 + bj * HALF;
                const f32x4 v0 = acc[ai][bj][m][0] + c0[bj], v1 = acc[ai][bj][m][1] + c1[bj];
                if (outf) { *(f32x4*)(outf + off) = v0; *(f32x4*)(outf + off + 4) = v1; }
                if (outb) { u32x4 w; w.x = cvt_pk_bf16(v0[0], v0[1]); w.y = cvt_pk_bf16(v0[2], v0[3]); w.z = cvt_pk_bf16(v1[0], v1[1]); w.w = cvt_pk_bf16(v1[2], v1[3]); *(u32x4*)(outb + off) = w; }
                pp += (v0[0] * v0[0] + v0[1] * v0[1]) + (v0[2] * v0[2] + v0[3] * v0[3]) + (v1[0] * v1[0] + v1[1] * v1[1]) + (v1[2] * v1[2] + v1[3] * v1[3]); }
            part[ai][m] = pp;
            asm volatile("" ::: "memory");
#pragma unroll
            for (int bj = 0; bj < 2; ++bj) { c0[bj] = n0[bj]; c1[bj] = n1[bj]; } }
#undef ER_LOAD
        if (ss) {
#pragma unroll
            for (int ai = 0; ai < 2; ++ai)
#pragma unroll
                for (int m = 0; m < 4; ++m) { float pp = part[ai][m]; pp += __shfl_xor(pp, 16); pp += __shfl_xor(pp, 32); if (fq == 0) unsafeAtomicAdd(ss + row0 + ai * HALF + m * 16, pp); } }
    }
};
struct EpiGates {
    static constexpr bool PERM = false;
    const float* ba; const float* bi; const float* cl; bf16_t* Aout; bf16_t* Bout; LAS float* cbuf;
    __device__ __forceinline__ void pre(const Unit& u, int, int, float (&r)[8]) const { const int t = my_tid();
        unsigned long long p0 = (unsigned long long)cl, p1 = (unsigned long long)ba, p2 = (unsigned long long)bi;
        asm volatile("" : "+s"(p0), "+s"(p1), "+s"(p2));
        const unsigned long long ps = t < 128 ? p0 : (t < 256 ? p1 : p2); const float v = ((const float*)ps)[u.pn * 128 + (t & 127)];
#pragma unroll
        for (int i = 0; i < 8; ++i) r[i] = v; }
    __device__ __forceinline__ void post(int ui, const float (&r)[8]) const { const int t = my_tid(); if (t < 384) cbuf[(ui & 1) * 384 + t] = r[0]; }
    __device__ __forceinline__ void operator()(const f32x4 (&acc)[2][2][4][2], const Unit& u, int wr, int wc, int fr, int fq, int ui, const float (&)[8]) const {
        const int cc = wc * 32 + 4 * fq; const int ch0 = u.pn * 128 + cc; const int row0 = u.pm * BM + wr * 64 + fr; const LAS float* cb = cbuf + (ui & 1) * 384 + cc;
#pragma unroll
        for (int ai = 0; ai < 2; ++ai)
#pragma unroll
            for (int m = 0; m < 4; ++m) { const size_t off = (size_t)(row0 + ai * HALF + m * 16) * LRU_W + ch0;
#pragma unroll
                for (int n = 0; n < 2; ++n) { const f32x4 vcl = *(const LAS f32x4*)(cb + n * 16), vba = *(const LAS f32x4*)(cb + 128 + n * 16), vbi = *(const LAS f32x4*)(cb + 256 + n * 16);
                    const f32x4 va = acc[ai][0][m][n] + vba, vi = acc[ai][1][m][n] + vbi;
                    float a4[4]; float b4[4];
#pragma unroll
                    for (int j = 0; j < 4; ++j) { const float r = sigmoidf_(va[j]), ig = sigmoidf_(vi[j]); const float la = vcl[j] * r; a4[j] = 1.f - __expf(la); b4[j] = __builtin_amdgcn_sqrtf(a4[j] * (2.f - a4[j])) * ig; }
                    { u32x2 aw; aw.x = cvt_pk_bf16(a4[0], a4[1]); aw.y = cvt_pk_bf16(a4[2], a4[3]); *(u32x2*)(Aout + off + n * 16) = aw; }
                    u32x2 bw; bw.x = cvt_pk_bf16(b4[0], b4[1]); bw.y = cvt_pk_bf16(b4[2], b4[3]); *(u32x2*)(Bout + off + n * 16) = bw;
                    __builtin_amdgcn_sched_barrier(0); } }
    }
};
}

namespace att {
constexpr int NW = 8, QBLK = 32, KVBLK = 64, QB = 256;
constexpr int SHM_V = 16384, SHM_KN = 16384, SHM_KR = 8192, SHM_K = SHM_KN + SHM_KR;
constexpr int OFF_K = 3 * SHM_V, OFF_WS = OFF_K + 2 * SHM_K, OFF_QR = OFF_WS + NW * 64 * 4, LDS_BYTES = OFF_QR + NW * 4096;
constexpr float THR = 8.f;
#define KSWZF(row) ((((row) & 3) << 2) | (((row) >> 2) & 3))
#define KSWZ(row, colB) ((row) * 256 + ((colB) ^ (KSWZF(row) << 4)))
#define KRSWZ(row, colB) (SHM_KN + (row) * 128 + ((colB) ^ ((((row) >> 1) & 7) << 4)))
#define SBAR() __builtin_amdgcn_sched_barrier(0)
__device__ __forceinline__ int v_st(int k, int c) { const int kk = (k & ~0xC) | ((k & 4) << 1) | ((k & 8) >> 1); return ((kk >> 3) * 4 + (c >> 5)) * 512 + ((kk & 7) * 32 + (c & 31)) * 2; }
__device__ __forceinline__ int v_rd_base(int lane) { return ((lane & 3) << 3) | (((lane >> 2) & 3) << 6) | (((lane >> 4) & 1) << 5) | (((lane >> 5) & 1) << 8); }
constexpr int v_rd_off(int d0, int ks, int half) { return d0 * 512 + ks * 4096 + half * 2048; }
__device__ __forceinline__ int crow(int r, int hi) { return (r & 3) + 8 * (r >> 2) + 4 * hi; }
__device__ __forceinline__ void mask_tile(f32x16& p0, f32x16& p1, int dq) {
    const float NEG = -__builtin_inff();
#pragma unroll
    for (int r = 0; r < 16; ++r) { const int c = (r & 3) + 8 * (r >> 2); if (dq - c < 0) p0[r] = NEG; if (dq - c - 32 < 0) p1[r] = NEG; }
}
__device__ __forceinline__ void partialSM(f32x16& p0, f32x16& p1, float& m_reg, float& mn, float& alpha, float SCALE, float C2) {
    float pmax = p0[0];
#pragma unroll
    for (int r = 1; r < 16; ++r) pmax = fmaxf(pmax, p0[r]);
#pragma unroll
    for (int r = 0; r < 16; ++r) pmax = fmaxf(pmax, p1[r]);
    { auto rr = __builtin_amdgcn_permlane32_swap(__float_as_uint(pmax), __float_as_uint(pmax), false, false); pmax = fmaxf(__uint_as_float(rr[0]), __uint_as_float(rr[1])); }
    if (__builtin_expect(__all((pmax - m_reg) * SCALE <= THR), 1)) { mn = m_reg; alpha = 1.f; }
    else { mn = fmaxf(m_reg, pmax); alpha = __builtin_amdgcn_exp2f((m_reg - mn) * C2); m_reg = mn; }
    const float mnL = -mn * C2;
#pragma unroll
    for (int r = 0; r < 16; ++r) p0[r] = fmaf(p0[r], C2, mnL);
#pragma unroll
    for (int r = 0; r < 16; ++r) p1[r] = fmaf(p1[r], C2, mnL);
#pragma unroll
    for (int r = 0; r < 16; ++r) p0[r] = __builtin_amdgcn_exp2f(p0[r]);
}
__device__ __forceinline__ void finishSM(f32x16& p0, f32x16& p1, float alpha, float& l_reg, bf16x8& pa0, bf16x8& pa1, bf16x8& pa2, bf16x8& pa3) {
#pragma unroll
    for (int r = 0; r < 16; ++r) p1[r] = __builtin_amdgcn_exp2f(p1[r]);
    float ps = 0;
#pragma unroll
    for (int r = 0; r < 16; ++r) ps += p0[r];
#pragma unroll
    for (int r = 0; r < 16; ++r) ps += p1[r];
    { auto rr = __builtin_amdgcn_permlane32_swap(__float_as_uint(ps), __float_as_uint(ps), false, false); ps = __uint_as_float(rr[0]) + __uint_as_float(rr[1]); }
    l_reg = l_reg * alpha + ps;
#define PK4(P, B_, OUT) do { unsigned a0 = cvt_pk_bf16(P[B_+0], P[B_+1]), a1 = cvt_pk_bf16(P[B_+2], P[B_+3]);                          \
        unsigned b0 = cvt_pk_bf16(P[B_+4], P[B_+5]), b1 = cvt_pk_bf16(P[B_+6], P[B_+7]);                                             \
        auto r0 = __builtin_amdgcn_permlane32_swap(a0, b0, false, false); auto r1 = __builtin_amdgcn_permlane32_swap(a1, b1, false, false); \
        u32x4 w = {r0[0], r1[0], r0[1], r1[1]}; OUT = __builtin_bit_cast(bf16x8, w); } while (0)
    PK4(p0, 0, pa0); PK4(p0, 8, pa1); PK4(p1, 0, pa2); PK4(p1, 8, pa3);
#undef PK4
}
template <int DQ>
__device__ __forceinline__ void qkt(f32x16& p0, f32x16& p1, const LAS char* Kt, int r32, int hi, const bf16x8* qr, const LAS char* qrl) {
    constexpr int ND = DQ / 16, PF = 6;
    p0 = f32x16{}; p1 = f32x16{};
    const LAS char* kb[4]; const LAS char* kr[4];
#pragma unroll
    for (int dd = 0; dd < 4; ++dd) { kb[dd] = Kt + KSWZ(r32, (dd * 16 + hi * 8) * 2); kr[dd] = Kt + KRSWZ(r32, (dd * 16 + hi * 8) * 2); }
    const int koff = (r32 & 2) ? -128 : 128;
#define RDK(d, half) (*reinterpret_cast<const LAS bf16x8*>((d) < 8 ? kb[(d) & 3] + ((d) >> 2) * koff + (half) * 32 * 256 : kr[((d) - 8) & 3] + (half) * 32 * 128))
    bf16x8 k0[PF], k1[PF], qf[4];
    if constexpr (DQ == 192) {
#pragma unroll
        for (int dd = 0; dd < 4; ++dd) qf[dd] = *reinterpret_cast<const LAS bf16x8*>(qrl + dd * 1024);
    }
#pragma unroll
    for (int d = 0; d < PF; ++d) { k0[d] = RDK(d, 0); k1[d] = RDK(d, 1); }
    SBAR();
#pragma unroll
    for (int d = 0; d < ND; ++d) { const bf16x8 q = d < 8 ? qr[d & 7] : qf[(d - 8) & 3];
        p0 = __builtin_amdgcn_mfma_f32_32x32x16_bf16(k0[d % PF], q, p0, 0, 0, 0);
        p1 = __builtin_amdgcn_mfma_f32_32x32x16_bf16(k1[d % PF], q, p1, 0, 0, 0);
        if (d + PF < ND) { k0[d % PF] = RDK(d + PF, 0); k1[d % PF] = RDK(d + PF, 1); }
        SBAR(); }
#undef RDK
}
__device__ __forceinline__ void pv_tile(f32x16* o, int vb, bf16x8 pa0, bf16x8 pa1, bf16x8 pa2, bf16x8 pa3) {
#define TRRD(dst, off) asm volatile("ds_read_b64_tr_b16 %0, %1 offset:%2" : "=&v"(dst) : "v"(vb), "i"(off) : "memory")
#define RD8(L, H, d0) do { constexpr int b_ = v_rd_off(d0, 0, 0); TRRD(L[0], b_); TRRD(H[0], b_ + 2048); TRRD(L[1], b_ + 4096); TRRD(H[1], b_ + 6144); TRRD(L[2], b_ + 8192); TRRD(H[2], b_ + 10240); TRRD(L[3], b_ + 12288); TRRD(H[3], b_ + 14336); } while (0)
#define MM4(L, H, d0) do { \
        o[d0] = __builtin_amdgcn_mfma_f32_32x32x16_bf16(pa0, (bf16x8){L[0][0], L[0][1], L[0][2], L[0][3], H[0][0], H[0][1], H[0][2], H[0][3]}, o[d0], 0, 0, 0);   \
        o[d0] = __builtin_amdgcn_mfma_f32_32x32x16_bf16(pa1, (bf16x8){L[1][0], L[1][1], L[1][2], L[1][3], H[1][0], H[1][1], H[1][2], H[1][3]}, o[d0], 0, 0, 0);   \
        o[d0] = __builtin_amdgcn_mfma_f32_32x32x16_bf16(pa2, (bf16x8){L[2][0], L[2][1], L[2][2], L[2][3], H[2][0], H[2][1], H[2][2], H[2][3]}, o[d0], 0, 0, 0);   \
        o[d0] = __builtin_amdgcn_mfma_f32_32x32x16_bf16(pa3, (bf16x8){L[3][0], L[3][1], L[3][2], L[3][3], H[3][0], H[3][1], H[3][2], H[3][3]}, o[d0], 0, 0, 0); } while (0)
    s16x4 la[4], ha[4], lb[4], hb[4];
    RD8(la, ha, 0); RD8(lb, hb, 1);
    asm volatile("s_waitcnt lgkmcnt(8)" ::: "memory"); SBAR(); MM4(la, ha, 0); SBAR();
    RD8(la, ha, 2);
    asm volatile("s_waitcnt lgkmcnt(8)" ::: "memory"); SBAR(); MM4(lb, hb, 1); SBAR();
    RD8(lb, hb, 3);
    asm volatile("s_waitcnt lgkmcnt(8)" ::: "memory"); SBAR(); MM4(la, ha, 2); SBAR();
    asm volatile("s_waitcnt lgkmcnt(0)" ::: "memory"); SBAR(); MM4(lb, hb, 3);
#undef MM4
#undef RD8
#undef TRRD
}

template <int DQ, bool CAUSAL>
__device__ __forceinline__ void attn_block(const bf16_t* Q, int ldq, const bf16_t* Kh, int ldk, const bf16_t* Vh, int ldv, bf16_t* O, int ldo, int P0, int NT, float SCALE, LAS char* lds) {
    const float C2 = 1.4426950408889634f * SCALE;
    const int tid = my_tid(), wid = __builtin_amdgcn_readfirstlane(tid >> 6), lane = tid & 63, r32 = lane & 31, hi = lane >> 5;
    const int qlo = P0 + wid * QBLK, qm = qlo + r32 - 4 * hi;
    LAS char* V_lds = lds; LAS char* K_lds = lds + OFF_K;
    LAS float* ws = (LAS float*)(lds + OFF_WS) + wid * 64; LAS float* li_l = ws; LAS float* al_l = ws + 32;
    float m_reg = -1e30f, l_reg = 0; f32x16 o[4] = {};
    const int krow = 4 * wid + (lane >> 4);
    const unsigned goffK = (unsigned)krow * (unsigned)ldk + (unsigned)(((lane & 15) ^ KSWZF(krow)) * 8);
    const int rrow = 8 * wid + (lane >> 3);
    const unsigned goffR = (unsigned)rrow * (unsigned)ldk + 128u + (unsigned)(((lane & 7) ^ ((rrow >> 1) & 7)) * 8);
    const int vsub = 2 * wid + (lane >> 5), vkk = (vsub >> 2) * 8 + ((lane & 31) >> 2), vk = (vkk & ~0xC) | ((vkk & 4) << 1) | ((vkk & 8) >> 1);
    const unsigned goffV = (unsigned)vk * (unsigned)ldv + (unsigned)((vsub & 3) * 32 + (lane & 3) * 8);
    const int vb0 = (int)(uintptr_t)V_lds + v_rd_base(lane);
#define GLDS(gp, lp) __builtin_amdgcn_global_load_lds((const unsigned*)(gp), (LAS unsigned*)(lp), 16, 0, 0)
#define DMA_TILE(t, kslot, vslot) do { const bf16_t* kt_ = Kh + (size_t)(t) * KVBLK * ldk; const bf16_t* vt_ = Vh + (size_t)(t) * KVBLK * ldv; \
        LAS char* kd_ = K_lds + (kslot) * SHM_K + wid * 1024; LAS char* vd_ = V_lds + (vslot) * SHM_V + wid * 1024; \
        GLDS(kt_ + goffK, kd_); GLDS(kt_ + goffK + (size_t)32 * ldk, kd_ + 8192); \
        if constexpr (DQ == 192) GLDS(kt_ + goffR, kd_ + SHM_KN); \
        GLDS(vt_ + goffV, vd_); GLDS(vt_ + goffV + (size_t)32 * ldv, vd_ + 8192); } while (0)
#define RESC(a) do { if (__any((a) < 1.f)) { if (hi == 0) al_l[r32] = (a); asm volatile("s_waitcnt lgkmcnt(0)" ::: "memory");              \
                     _Pragma("unroll") for (int d_ = 0; d_ < 4; ++d_) _Pragma("unroll") for (int r = 0; r < 16; ++r) o[d_][r] *= al_l[crow(r, hi)]; } } while (0)
#define KBASE(t) ((t) * KVBLK)
#define MASKT(P0_, P1_, t) do { if constexpr (CAUSAL) { const int kb_ = KBASE(t); if (kb_ + KVBLK - 1 > qlo) mask_tile(P0_, P1_, qm - kb_); } } while (0)
    DMA_TILE(0, 0, 0);
    bf16x8 qr[8];
#pragma unroll
    for (int d0 = 0; d0 < 8; ++d0) qr[d0] = *(const bf16x8*)(Q + (size_t)(wid * QBLK + r32) * ldq + d0 * 16 + hi * 8);
    LAS char* qrl = lds + OFF_QR + wid * 4096 + lane * 16;
    if constexpr (DQ == 192) {
#pragma unroll
        for (int dd = 0; dd < 4; ++dd) *(LAS bf16x8*)(qrl + dd * 1024) = *(const bf16x8*)(Q + (size_t)(wid * QBLK + r32) * ldq + (8 + dd) * 16 + hi * 8);
    }
    __syncthreads();
    int vs_cur = 0, vs_next = 1;
#pragma unroll 1
    for (int t = 0; t < NT; ++t) {
        if (t + 1 < NT) DMA_TILE(t + 1, (t + 1) & 1, vs_next);
        f32x16 p0, p1; float mn, al; bf16x8 pa0, pa1, pa2, pa3;
        SBAR(); qkt<DQ>(p0, p1, K_lds + (t & 1) * SHM_K, r32, hi, qr, qrl);
        MASKT(p0, p1, t); partialSM(p0, p1, m_reg, mn, al, SCALE, C2);
        RESC(al);
        finishSM(p0, p1, al, l_reg, pa0, pa1, pa2, pa3); SBAR();
        pv_tile(o, vb0 + vs_cur * SHM_V, pa0, pa1, pa2, pa3);
        __syncthreads();
        { const int t_ = vs_cur; vs_cur = vs_next; vs_next = t_; }
    }
    SBAR();
    if (hi == 0) li_l[r32] = l_reg; asm volatile("s_waitcnt lgkmcnt(0)" ::: "memory");
    float rli[16];
#pragma unroll
    for (int r = 0; r < 16; ++r) rli[r] = __builtin_amdgcn_rcpf(li_l[crow(r, hi)]);
    { LAS bf16_t* stg = (LAS bf16_t*)(lds + wid * 8192);
#pragma unroll
      for (int r = 0; r < 16; ++r) { const int orow = crow(r, hi);
#pragma unroll
          for (int d0 = 0; d0 < 4; ++d0) stg[orow * 128 + d0 * 32 + r32] = f2bf(o[d0][r] * rli[r]); }
      asm volatile("s_waitcnt lgkmcnt(0)" ::: "memory");
      bf16_t* Ow = O + (size_t)(wid * QBLK) * ldo;
#pragma unroll
      for (int i = 0; i < 8; ++i) { const int c = i * 64 + lane, row = c >> 4, ch = c & 15;
          const u32x4 v = *(const LAS u32x4*)(stg + row * 128 + ch * 8);
          *(u32x4*)(Ow + (size_t)row * ldo + ch * 8) = v; } }
    __syncthreads();
#undef GLDS
#undef DMA_TILE
#undef RESC
#undef KBASE
#undef MASKT
#undef HALF_STEP
}
}

struct Params {
    const float* x; const float* mem; const int* pos;
    const float *mix_norm, *mlp_norm, *w_out, *w_mlp_in, *w_mlp_out, *mem_norm, *w_mem_kv, *mem_k_norm, *mem_q_norm, *w_in_mla, *q_lat_norm, *w_q_up, *kv_lat_norm, *w_kv_up,
        *q_norm, *k_norm, *w_in_lru, *conv_w, *conv_b, *w_gate_a, *b_gate_a, *w_gate_i, *b_gate_i, *lru_lambda;
    float* out; unsigned char* ws; int ph_lo, ph_hi;
};
constexpr int LDS_MISC = 135168, LDS_TOTAL = LDS_MISC + 256 + 3072;
constexpr int NPHASE = 20;

constexpr int TR_STRIDE = 65, TR_SCR_BYTES = 64 * TR_STRIDE * 4;
struct TrSel { const float* W; bf16_t* WT; const float* gain; int N, ldt; };
__device__ __forceinline__ void tr_load(const TrSel& t, int lane, f32x4 (&v)[16], float (&g)[16]) {
#pragma unroll
    for (int i = 0; i < 16; ++i) { v[i] = *(const f32x4*)(t.W + (size_t)(4 * i + (lane >> 4)) * t.N + (lane & 15) * 4); g[i] = t.gain ? t.gain[4 * i + (lane >> 4)] : 1.f; }
}
__device__ __forceinline__ void tr_store(const TrSel& t, const f32x4 (&v)[16], const float (&g)[16], LAS float* scr, int lane) {
#pragma unroll
    for (int i = 0; i < 16; ++i) { const int kk = 4 * i + (lane >> 4); LAS float* d = scr + kk * TR_STRIDE + (lane & 15) * 4;
        d[0] = v[i].x * g[i]; d[1] = v[i].y * g[i]; d[2] = v[i].z * g[i]; d[3] = v[i].w * g[i]; }
    asm volatile("s_waitcnt lgkmcnt(0)" ::: "memory");
    const int c = lane & 7;
#pragma unroll
    for (int j = 0; j < 8; ++j) { const int n = (lane >> 3) + 8 * j; const LAS float* sp = scr + (8 * c) * TR_STRIDE + n;
        u32x4 o; o.x = cvt_pk_bf16(sp[0 * TR_STRIDE], sp[1 * TR_STRIDE]); o.y = cvt_pk_bf16(sp[2 * TR_STRIDE], sp[3 * TR_STRIDE]); o.z = cvt_pk_bf16(sp[4 * TR_STRIDE], sp[5 * TR_STRIDE]); o.w = cvt_pk_bf16(sp[6 * TR_STRIDE], sp[7 * TR_STRIDE]);
        *(u32x4*)(t.WT + (size_t)n * t.ldt + 8 * c) = o; }
    asm volatile("s_waitcnt lgkmcnt(0)" ::: "memory");
}
__device__ __forceinline__ bool tr_job(int& r, const float* W, int K, int N, bf16_t* WT, const float* gain, TrSel& t) {
    const int nblk = N / 64, items = (K / 64) * nblk;
    if (r >= items) { r -= items; return false; }
    const int kb = r / nblk, nb = r % nblk;
    t.W = W + (size_t)(64 * kb) * N + 64 * nb; t.N = N; t.WT = WT + (size_t)(64 * nb) * K + 64 * kb; t.ldt = K; t.gain = gain ? gain + 64 * kb : nullptr;
    return true;
}
__device__ __forceinline__ bool tr_gate_job(int& r, const float* W, int row_off, bf16_t* WT, TrSel& t) {
    const int items = 12 * 2 * 2;
    if (r >= items) { r -= items; return false; }
    const int blk = r / 4, kb = (r % 4) / 2, nb = r % 2;
    t.W = W + (size_t)blk * 16384 + (size_t)(64 * kb) * 128 + 64 * nb; t.N = 128; t.WT = WT + (size_t)blk * 32768 + (size_t)(row_off + 64 * nb) * 128 + 64 * kb; t.ldt = 128; t.gain = nullptr;
    return true;
}
__device__ __forceinline__ void cvt_rows(const float* X, bf16_t* out, float* ss, int rows, int gw, int NGW, int lane) {
    f32x4 v[8], nv[8]; int m = gw;
    if (m < rows) {
#pragma unroll
        for (int j = 0; j < 8; ++j) v[j] = ((const f32x4*)(X + (size_t)m * DM) + lane)[64 * j]; }
    for (; m < rows; m += NGW) {
        if (m + NGW < rows) {
#pragma unroll
            for (int j = 0; j < 8; ++j) nv[j] = ((const f32x4*)(X + (size_t)(m + NGW) * DM) + lane)[64 * j]; }
        asm volatile("" ::: "memory");
        float s = 0.f;
#pragma unroll
        for (int j = 0; j < 8; ++j) s += (v[j].x * v[j].x + v[j].y * v[j].y) + (v[j].z * v[j].z + v[j].w * v[j].w);
        s = wave_sum(s); if (lane == 0) ss[m] = s;
        u32x2* o8 = (u32x2*)(out + (size_t)m * DM) + lane;
#pragma unroll
        for (int j = 0; j < 8; ++j) { u32x2 w; w.x = cvt_pk_bf16(v[j].x, v[j].y); w.y = cvt_pk_bf16(v[j].z, v[j].w); o8[64 * j] = w; }
        asm volatile("" ::: "memory");
#pragma unroll
        for (int j = 0; j < 8; ++j) v[j] = nv[j];
    }
}

__device__ __forceinline__ void norm_rows(const float* X, const float* g, bf16_t* out, int rows, int gw, int NGW, int lane) {
    f32x4 gv[8];
#pragma unroll
    for (int j = 0; j < 8; ++j) gv[j] = ((const f32x4*)g)[lane + 64 * j];
    for (int m = gw; m < rows; m += NGW) {
        const f32x4* xr = (const f32x4*)(X + (size_t)m * DM) + lane; f32x4 v[8]; float s = 0.f;
#pragma unroll
        for (int j = 0; j < 8; ++j) { v[j] = xr[64 * j]; s += (v[j].x * v[j].x + v[j].y * v[j].y) + (v[j].z * v[j].z + v[j].w * v[j].w); }
        const float rstd = rsqrtf(wave_sum(s) * (1.f / DM) + EPS);
        u32x2* o8 = (u32x2*)(out + (size_t)m * DM) + lane;
#pragma unroll
        for (int j = 0; j < 8; ++j) { u32x2 w; w.x = cvt_pk_bf16(v[j].x * rstd * gv[j].x, v[j].y * rstd * gv[j].y); w.y = cvt_pk_bf16(v[j].z * rstd * gv[j].z, v[j].w * rstd * gv[j].w); o8[64 * j] = w; }
    }
}
template <int NJ, bool HEADS>
__device__ __forceinline__ void seg_norm(bf16_t* seg, const float* g, int n, int lane) {
    u32x2 w[NJ]; float s[NJ]; float tot = 0.f;
#pragma unroll
    for (int j = 0; j < NJ; ++j) { w[j] = ((const u32x2*)seg)[lane + 64 * j]; const float a = bflo(w[j].x), b = bfhi(w[j].x), c = bflo(w[j].y), d = bfhi(w[j].y); s[j] = (a * a + b * b) + (c * c + d * d); tot += s[j]; }
    float rs[NJ];
    if (HEADS) {
#pragma unroll
        for (int j = 0; j < NJ; ++j) rs[j] = rsqrtf(half_sum(s[j]) * (1.f / 128.f) + EPS);
    } else { const float r = rsqrtf(wave_sum(tot) / (float)n + EPS);
#pragma unroll
        for (int j = 0; j < NJ; ++j) rs[j] = r; }
#pragma unroll
    for (int j = 0; j < NJ; ++j) { const int gi = HEADS ? ((lane & 31) * 4) : (lane + 64 * j) * 4; const f32x4 gv = *(const f32x4*)(g + gi);
        u32x2 o; o.x = cvt_pk_bf16(bflo(w[j].x) * rs[j] * gv.x, bfhi(w[j].x) * rs[j] * gv.y); o.y = cvt_pk_bf16(bflo(w[j].y) * rs[j] * gv.z, bfhi(w[j].y) * rs[j] * gv.w);
        ((u32x2*)seg)[lane + 64 * j] = o; }
}

__device__ __forceinline__ u32x4 qk_head(u32x4 w, const float (&g)[8], bool r1, bool r2, int partner, const float (&cs)[8], const float (&sn)[8]) {
    float x[8] = {bflo(w.x), bfhi(w.x), bflo(w.y), bfhi(w.y), bflo(w.z), bfhi(w.z), bflo(w.w), bfhi(w.w)};
    float ss = 0.f;
#pragma unroll
    for (int j = 0; j < 8; ++j) ss += x[j] * x[j];
    const float rstd = rsqrtf(half_sum(ss) * (1.f / 192.f) + EPS);
#pragma unroll
    for (int j = 0; j < 8; ++j) x[j] = x[j] * rstd * g[j];
#pragma unroll
    for (int j = 0; j < 8; ++j) { const float pj = __shfl(x[j], partner); if (r1) x[j] = x[j] * cs[j] - pj * sn[j]; else if (r2) x[j] = x[j] * cs[j] + pj * sn[j]; }
    u32x4 o; o.x = cvt_pk_bf16(x[0], x[1]); o.y = cvt_pk_bf16(x[2], x[3]); o.z = cvt_pk_bf16(x[4], x[5]); o.w = cvt_pk_bf16(x[6], x[7]);
    return o;
}

#define XB_TMO      128
#define XB_XCNT(j)  (256  + 64 * (j))
#define XB_XSUB(j)  (1280 + 64 * (j))
#define XB_XGEN(j)  (2304 + 64 * (j))
#define XB_TOP      3328
#define XB_TOPGEN   3392
#define XCD_BAR_WORDS 3456
#define XB_SPIN_CAP (1u << 18)
__device__ __forceinline__ unsigned xb_ld(unsigned* p)              { return __hip_atomic_load(p, __ATOMIC_RELAXED, __HIP_MEMORY_SCOPE_AGENT); }
__device__ __forceinline__ unsigned xb_add(unsigned* p, unsigned v) { return __hip_atomic_fetch_add(p, v, __ATOMIC_RELAXED, __HIP_MEMORY_SCOPE_AGENT); }
__device__ __forceinline__ unsigned xb_xcc_id() { return (unsigned)__builtin_amdgcn_s_getreg((3 << 11) | 20) & 0xFu; }
#define XB_SPIN(cond, bar) do { unsigned _sp = 0; while (cond) { __builtin_amdgcn_s_sleep(1); \
    if ((++_sp & 255u) == 0u) { if (xb_ld(&(bar)[XB_TMO])) break; if (_sp > XB_SPIN_CAP) { atomicAdd(&(bar)[XB_TMO], 1u); break; } } } } while (0)
struct XcdBarrier { unsigned* bar; unsigned x; volatile LAS unsigned* st; };
__device__ __forceinline__ void xcd_barrier_complete(unsigned* bar, unsigned x, unsigned& nloc, unsigned& nx) {
    const unsigned G = gridDim.x * gridDim.y * gridDim.z;
    unsigned sum, cnt, mine, sp = 0u;
    for (;;) {
        sum = 0u; cnt = 0u; mine = 0u;
#pragma unroll
        for (unsigned j = 0; j < 16; ++j) { const unsigned c = xb_ld(&bar[XB_XCNT(j)]); sum += c; cnt += (c > 0u) ? 1u : 0u; mine = (j == x) ? c : mine; }
        if (sum == G) break;
        __builtin_amdgcn_s_sleep(1);
        if ((++sp & 255u) == 0u) { if (xb_ld(&bar[XB_TMO])) break; if (sp > XB_SPIN_CAP) { atomicAdd(&bar[XB_TMO], 1u); break; } }
    }
    nloc = mine > 0u ? mine : 1u; nx = cnt > 0u ? cnt : 1u;
}
__device__ __forceinline__ void xcd_barrier(const XcdBarrier& b) {
    asm volatile("s_waitcnt vmcnt(0)" ::: "memory");
    __syncthreads();
    if (threadIdx.x == 0) {
        unsigned* bar = b.bar;
        __builtin_amdgcn_s_waitcnt(0);
        unsigned nloc = b.st[0], nx = b.st[1];
        if (nloc == 0u) { xcd_barrier_complete(bar, b.x, nloc, nx); b.st[0] = nloc; b.st[1] = nx; }
        const unsigned old = xb_add(&bar[XB_XSUB(b.x)], 1u);
        const unsigned gen = old / nloc;
        if (old + 1u == (gen + 1u) * nloc) {
            __builtin_amdgcn_fence(__ATOMIC_RELEASE, "agent");
            asm volatile("s_waitcnt vmcnt(0)" ::: "memory");
            const unsigned og = xb_add(&bar[XB_TOP], 1u);
            const unsigned tg = og / nx;
            if (og + 1u == (tg + 1u) * nx) xb_add(&bar[XB_TOPGEN], 1u);
            else XB_SPIN(xb_ld(&bar[XB_TOPGEN]) == tg, bar);
            __builtin_amdgcn_fence(__ATOMIC_ACQUIRE, "agent");
            xb_add(&bar[XB_XGEN(b.x)], 1u);
            asm volatile("s_waitcnt vmcnt(0)" ::: "memory");
        } else {
            XB_SPIN(xb_ld(&bar[XB_XGEN(b.x)]) == gen, bar);
            __builtin_amdgcn_fence(__ATOMIC_ACQUIRE, "agent");
            asm volatile("s_waitcnt vmcnt(0)" ::: "memory");
        }
    }
    __syncthreads();
}
typedef __attribute__((address_space(4))) const Params CParams;
#define PHASE_BEGIN \
    CParams* P = (CParams*)__builtin_amdgcn_kernarg_segment_ptr(); asm volatile("" : "+s"(P)); \
    const int tid = my_tid(), lane = tid & 63, wave = __builtin_amdgcn_readfirstlane(tid >> 6); \
    const int G = gridDim.x, bx = blockIdx.x; const int gw = bx * 8 + wave, NGW = G * 8; \
    (void)lane; (void)gw; (void)NGW; \
    unsigned char* ws = P->ws; \
    unsigned* ctl = (unsigned*)(ws + WS_CTL); \
    bf16_t* Win0_t = (bf16_t*)(ws + WS_WIN0); bf16_t* Wqup_t = (bf16_t*)(ws + WS_WQUP); bf16_t* Wkvup_t = (bf16_t*)(ws + WS_WKVUP); bf16_t* Wout_t = (bf16_t*)(ws + WS_WOUT); \
    bf16_t* Wmi0_t = (bf16_t*)(ws + WS_A0); bf16_t* Wmo0_t = (bf16_t*)(ws + WS_A0 + 32 * MiB); bf16_t* Wmi1_t = (bf16_t*)(ws + WS_A1); bf16_t* Wmo1_t = (bf16_t*)(ws + WS_A1 + 32 * MiB); bf16_t* Wlru_t = (bf16_t*)(ws + WS_WLRU); bf16_t* Wmkv_t = (bf16_t*)(ws + WS_WMKV); bf16_t* Wg_t = (bf16_t*)(ws + WS_WG); \
    bf16_t* memn = (bf16_t*)(ws + WS_MEMN); float* mkv = (float*)(ws + WS_MKV); bf16_t* memK = (bf16_t*)(ws + WS_MEMK); bf16_t* memV = (bf16_t*)(ws + WS_MEMV); \
    float* rope = (float*)(ws + WS_ROPE); float* carryP = (float*)(ws + WS_CARRY); float* carryH = carryP + NB * NCHUNK * LRU_W; \
    bf16_t* xb = (bf16_t*)(ws + WS_S1); bf16_t* mixed0 = (bf16_t*)(ws + WS_A1); bf16_t* mixed1 = (bf16_t*)(ws + WS_A0); \
    float* ss0 = (float*)(ws + WS_SS); float* ss1 = ss0 + T; float* ss2 = ss1 + T; float* ss3 = ss2 + T; \
    bf16_t* proj0 = (bf16_t*)(ws + U_PROJ0); bf16_t* kvb = (bf16_t*)(ws + U_KV); bf16_t* Kb = (bf16_t*)(ws + U_K); bf16_t* Qb = (bf16_t*)P->out; \
    bf16_t* gateb = (bf16_t*)(ws + U_GATE); bf16_t* xinb = (bf16_t*)(ws + U_XIN); bf16_t* bscan = xinb; bf16_t* mqb = (bf16_t*)(ws + U_MQ); bf16_t* xcb = (bf16_t*)(ws + U_XC); bf16_t* ascan = (bf16_t*)(ws + U_A); \
    bf16_t* ub = (bf16_t*)(ws + WS_U); \
    float* clam = (float*)(ws + WS_CTL + 8192); \
    (void)0
__global__ void __launch_bounds__(512, 2) fwd_kernel(Params p) {
    extern __shared__ __attribute__((aligned(16))) unsigned char lds_raw[];
    LAS unsigned char* lds = (LAS unsigned char*)lds_raw;
    LAS int* s_item = (LAS int*)(lds + LDS_MISC);
    if (threadIdx.x < 64) ((LAS unsigned*)(lds + LDS_MISC))[threadIdx.x] = 0u;
    __syncthreads();
    cg::grid_group grid = cg::this_grid();
    const int lo = p.ph_lo, hi = p.ph_hi;
    if (hi > NPHASE + 7) grid.sync();
    if (hi - lo > 1 && threadIdx.x == 0) (void)xb_add((unsigned*)(p.ws + WS_CTL) + 4096 + XB_XCNT(xb_xcc_id()), 1u);
#ifndef PHMASK
#define PHMASK 0xFFFFF
#endif
#ifndef REPMASK
#define REPMASK 0
#endif
#define PH(k) if (((PHMASK >> (k)) & 1) && lo <= (k) && (k) < hi) for (int rep_ = 0; rep_ < 1 + ((REPMASK >> (k)) & 1); ++rep_)
#define SEAM(k) do { if (lo <= (k) && (k) + 1 < hi) { CParams* P_ = (CParams*)__builtin_amdgcn_kernarg_segment_ptr(); asm volatile("" : "+s"(P_)); \
        XcdBarrier b_; b_.bar = (unsigned*)(P_->ws + WS_CTL) + 4096; b_.x = xb_xcc_id(); b_.st = (volatile LAS unsigned*)(lds + LDS_MISC + 32); xcd_barrier(b_); } } while (0)

    PH(0) { PHASE_BEGIN; if (rep_) grid.sync();
        if (bx == 0 && tid < 64) ctl[tid] = 0u;
        if (bx == 1) for (int c = tid; c < LRU_W; c += 512) clam[c] = -8.0f * log1pf(expf(-P->lru_lambda[c]));
        LAS float* scr = (LAS float*)(lds + wave * TR_SCR_BYTES);
        constexpr int NITEMS = 2 * (2048 / 64) * (8192 / 64) + (2048 / 64) * (1856 / 64) + (768 / 64) * (2304 / 64) + (512 / 64) * (3072 / 64) + 2 * (2048 / 64) * (2048 / 64)
                             + (2048 / 64) * (3584 / 64) + (2048 / 64) * (1024 / 64) + 2 * 48;
#define P0_SELECT(it_, t) do { int r = (it_); \
            if (tr_job(r, P->w_mlp_in, 2048, 8192, Wmi0_t, P->mlp_norm, t)) {} \
            else if (tr_job(r, P->w_mlp_out, 8192, 2048, Wmo0_t, nullptr, t)) {} \
            else if (tr_job(r, P->w_in_mla, 2048, 1856, Win0_t, P->mix_norm, t)) {} \
            else if (tr_job(r, P->w_q_up, 768, 2304, Wqup_t, nullptr, t)) {} \
            else if (tr_job(r, P->w_kv_up, 512, 3072, Wkvup_t, nullptr, t)) {} \
            else if (tr_job(r, P->w_out, 2048, 2048, Wout_t, nullptr, t)) {} \
            else if (tr_job(r, P->w_out + (size_t)2048 * 2048, 2048, 2048, Wout_t + (size_t)2048 * 2048, nullptr, t)) {} \
            else if (tr_job(r, P->w_in_lru, 2048, 3584, Wlru_t, P->mix_norm + DM, t)) {} \
            else if (tr_job(r, P->w_mem_kv, 2048, 1024, Wmkv_t, nullptr, t)) {} \
            else if (tr_gate_job(r, P->w_gate_a, 0, Wg_t, t)) {} \
            else tr_gate_job(r, P->w_gate_i, 128, Wg_t, t); } while (0)
        { int it = gw; TrSel cur, nx; f32x4 v[16], nv[16]; float gg[16], ng[16];
          if (it < NITEMS) { P0_SELECT(it, cur); tr_load(cur, lane, v, gg); }
          while (it < NITEMS) { const int nit = it + NGW;
              if (nit < NITEMS) { P0_SELECT(nit, nx); tr_load(nx, lane, nv, ng); }
              asm volatile("" ::: "memory");
              tr_store(cur, v, gg, scr, lane);
              asm volatile("" ::: "memory");
              cur = nx; it = nit;
#pragma unroll
              for (int i = 0; i < 16; ++i) { v[i] = nv[i]; gg[i] = ng[i]; } } }
#undef P0_SELECT
        { u32x4* z = (u32x4*)(Win0_t + (size_t)MLA_IN * 2048); const int n16 = (MLA_INP - MLA_IN) * 2048 * 2 / 16;
          for (int i = bx * 512 + tid; i < n16; i += G * 512) z[i] = (u32x4){0u, 0u, 0u, 0u}; }
        for (int i = bx * 512 + tid; i < 3 * T; i += G * 512) ss1[i] = 0.f;
        cvt_rows(P->x, xb, ss0, T, gw, NGW, lane);
        norm_rows(P->mem, P->mem_norm, memn, NB * MEML, gw, NGW, lane);
        for (int i = bx * 512 + tid; i < T * 32; i += G * 512) { const int m = i >> 5, f = i & 31; const float inv = powf(10000.f, -(float)f / 32.f); const float ang = (float)P->pos[m] * inv;
            rope[(size_t)m * 64 + f] = cosf(ang); rope[(size_t)m * 64 + 32 + f] = sinf(ang); }
    }
    SEAM(0);
    PH(1) { PHASE_BEGIN;
        pg8::Gemm g{xb, Win0_t, T, MLA_INP, 2048, 2048, 2048, 0}; pg8::StaticOrder S; S.init(T, MLA_INP, G, bx);
        pg8::EpiBf16<0> E{proj0, proj0, proj0, 2048, 2048, 2048, 1 << 20, 1 << 20, ss0};
        pg8::gemm_phase<pg8::EpiBf16<0>, true>(lds, g, S, E);
    }
    SEAM(1);
    PH(2) { PHASE_BEGIN;
        f32x4 gq_[3], gkv_[2]; const f32x4 gm_ = *(const f32x4*)(P->mem_q_norm + (lane & 31) * 4);
#pragma unroll
        for (int j = 0; j < 3; ++j) gq_[j] = *(const f32x4*)(P->q_lat_norm + (lane + 64 * j) * 4);
#pragma unroll
        for (int j = 0; j < 2; ++j) gkv_[j] = *(const f32x4*)(P->kv_lat_norm + (lane + 64 * j) * 4);
        u32x2 w[7], nw[7]; int m = gw;
#define P2_LOAD(dst, mm) do { const u32x2* r_ = (const u32x2*)(proj0 + (size_t)(mm) * 2048); \
            dst[0] = r_[lane]; dst[1] = r_[lane + 64]; dst[2] = r_[lane + 128]; dst[3] = r_[192 + lane]; dst[4] = r_[192 + lane + 64]; dst[5] = r_[336 + lane]; dst[6] = r_[336 + lane + 64]; } while (0)
        if (m < T) P2_LOAD(w, m);
        for (; m < T; m += NGW) {
            if (m + NGW < T) P2_LOAD(nw, m + NGW);
            asm volatile("" ::: "memory");
            float sq[7];
#pragma unroll
            for (int j = 0; j < 7; ++j) { const float a = bflo(w[j].x), b = bfhi(w[j].x), c = bflo(w[j].y), d = bfhi(w[j].y); sq[j] = (a * a + b * b) + (c * c + d * d); }
            const float rq = rsqrtf(wave_sum(sq[0] + sq[1] + sq[2]) * (1.f / 768.f) + EPS), rkv = rsqrtf(wave_sum(sq[3] + sq[4]) * (1.f / 512.f) + EPS);
            const float rm0 = rsqrtf(half_sum(sq[5]) * (1.f / 128.f) + EPS), rm1 = rsqrtf(half_sum(sq[6]) * (1.f / 128.f) + EPS);
            u32x2* r_ = (u32x2*)(proj0 + (size_t)m * 2048);
#define P2_ST(idx, j, rs, gv) do { u32x2 o_; o_.x = cvt_pk_bf16(bflo(w[j].x) * (rs) * (gv).x, bfhi(w[j].x) * (rs) * (gv).y); o_.y = cvt_pk_bf16(bflo(w[j].y) * (rs) * (gv).z, bfhi(w[j].y) * (rs) * (gv).w); r_[idx] = o_; } while (0)
            P2_ST(lane, 0, rq, gq_[0]); P2_ST(lane + 64, 1, rq, gq_[1]); P2_ST(lane + 128, 2, rq, gq_[2]);
            P2_ST(192 + lane, 3, rkv, gkv_[0]); P2_ST(192 + lane + 64, 4, rkv, gkv_[1]);
            P2_ST(336 + lane, 5, rm0, gm_); P2_ST(336 + lane + 64, 6, rm1, gm_);
            asm volatile("" ::: "memory");
#pragma unroll
            for (int j = 0; j < 7; ++j) w[j] = nw[j];
        }
#undef P2_LOAD
#undef P2_ST
    }
    SEAM(2);
    PH(3) { PHASE_BEGIN;
        { pg8::Gemm g{proj0 + QLORA, Wkvup_t, T, KVW, KVLORA, 2048, KVLORA, 0}; pg8::StaticOrder S; S.init(T, KVW, G, bx);
          pg8::EpiBf16<0> E{kvb, kvb, kvb, KVW, KVW, KVW, 1 << 20, 1 << 20, nullptr}; pg8::gemm_phase<pg8::EpiBf16<0>, true>(lds, g, S, E); }
        { pg8::Gemm g{proj0, Wqup_t, T, QW, QLORA, 2048, QLORA, 0}; pg8::StaticOrder S; S.init(T, QW, G, bx);
          pg8::EpiBf16<0> E{Qb, Qb, Qb, QW, QW, QW, 1 << 20, 1 << 20, nullptr}; pg8::gemm_phase<pg8::EpiBf16<0>, true>(lds, g, S, E); }
        { pg8::Gemm g{memn, Wmkv_t, NB * MEML, 1024, 2048, 2048, 2048, 0}; pg8::StaticOrder S; S.init(NB * MEML, 1024, G, (bx + G - 64) % G);
          pg8::EpiRes E{nullptr, nullptr, mkv, nullptr, nullptr, 1024}; pg8::gemm_phase<pg8::EpiRes, true>(lds, g, S, E); }
    }
    SEAM(3);
    PH(4) { PHASE_BEGIN;
        const int half = lane >> 5, L = lane & 31; const bool act = L < 24, r1 = (L >= 16 && L < 20), r2 = (L >= 20 && L < 24);
        const int partner = r1 ? lane + 4 : (r2 ? lane - 4 : lane);
        float gq[8], gk[8];
#pragma unroll
        for (int j = 0; j < 8; ++j) { gq[j] = act ? P->q_norm[L * 8 + j] : 0.f; gk[j] = act ? P->k_norm[L * 8 + j] : 0.f; }
        for (int m = gw; m < T; m += NGW) {
            float cs[8], sn[8];
            { const int i0 = ((L - 16) & 3) * 8;
#pragma unroll
              for (int j = 0; j < 8; ++j) { cs[j] = rope[(size_t)m * 64 + i0 + j]; sn[j] = rope[(size_t)m * 64 + 32 + i0 + j]; } }
            bf16_t* qrow = Qb + (size_t)m * QW + L * 8; bf16_t* krow = Kb + (size_t)m * QW + L * 8;
            const bf16_t* ksrc = (L < 16) ? kvb + (size_t)m * KVW + L * 8 : proj0 + (size_t)m * 2048 + 1280 + (L - 16) * 8; const int kstep = (L < 16) ? 256 : 0;
            const u32x4 zero4 = {0u, 0u, 0u, 0u};
            u32x4 wq = act ? *(const u32x4*)(qrow + half * QKD) : zero4, wk = act ? *(const u32x4*)(ksrc + half * kstep) : zero4;
#pragma unroll 1
            for (int i = 0; i < 6; ++i) { const int h = 2 * i + half; u32x4 nq = zero4, nk = zero4;
                if (i < 5 && act) { nq = *(const u32x4*)(qrow + (h + 2) * QKD); nk = *(const u32x4*)(ksrc + (h + 2) * kstep); }
                asm volatile("" ::: "memory");
                const u32x4 oq = qk_head(wq, gq, r1, r2, partner, cs, sn), ok = qk_head(wk, gk, r1, r2, partner, cs, sn);
                if (act) { *(u32x4*)(qrow + h * QKD) = oq; *(u32x4*)(krow + h * QKD) = ok; }
                asm volatile("" ::: "memory");
                wq = nq; wk = nk; }
        }
        for (int m = gw; m < NB * MEML; m += NGW) { const float* r = mkv + (size_t)m * 1024;
            const f32x4 k0 = *(const f32x4*)(r + lane * 8), k1 = *(const f32x4*)(r + lane * 8 + 4), v0 = *(const f32x4*)(r + 512 + lane * 8), v1 = *(const f32x4*)(r + 512 + lane * 8 + 4);
            float ss = (k0.x * k0.x + k0.y * k0.y) + (k0.z * k0.z + k0.w * k0.w) + (k1.x * k1.x + k1.y * k1.y) + (k1.z * k1.z + k1.w * k1.w);
#pragma unroll
            for (int o = 1; o < 16; o <<= 1) ss += __shfl_xor(ss, o);
            const float rstd = rsqrtf(ss * (1.f / 128.f) + EPS); const float* gk2 = P->mem_k_norm + (lane & 15) * 8;
            u32x4 ok, ov; ok.x = cvt_pk_bf16(k0.x * rstd * gk2[0], k0.y * rstd * gk2[1]); ok.y = cvt_pk_bf16(k0.z * rstd * gk2[2], k0.w * rstd * gk2[3]);
            ok.z = cvt_pk_bf16(k1.x * rstd * gk2[4], k1.y * rstd * gk2[5]); ok.w = cvt_pk_bf16(k1.z * rstd * gk2[6], k1.w * rstd * gk2[7]);
            ov.x = cvt_pk_bf16(v0.x, v0.y); ov.y = cvt_pk_bf16(v0.z, v0.w); ov.z = cvt_pk_bf16(v1.x, v1.y); ov.w = cvt_pk_bf16(v1.z, v1.w);
            *(u32x4*)(memK + (size_t)m * 512 + lane * 8) = ok; *(u32x4*)(memV + (size_t)m * 512 + lane * 8) = ov; }
    }
    SEAM(4);
    PH(5) { PHASE_BEGIN; if (rep_) grid.sync();
        const int x0 = (int)(xb_xcc_id() & 7u);
        for (int qi = 0; qi < 8; ++qi) { const int q = (x0 + qi) & 7;
            for (;;) {
                if (tid == 0) *s_item = (int)atomicAdd(ctl + 8 * q, 1u);
                __syncthreads(); const int li = *s_item; __syncthreads();
                if (li >= 128) break;
                if (li < 96) { const int qb = 31 - li / 3, bh = q + 8 * (li % 3), b = bh / NHEAD, h = bh % NHEAD; const size_t r0 = (size_t)b * SEQ;
                    att::attn_block<192, true>(Qb + (r0 + qb * 256) * QW + h * QKD, QW, Kb + r0 * QW + h * QKD, QW, kvb + r0 * KVW + h * 256 + 128, KVW,
                                               mixed0 + (r0 + qb * 256) * DM + h * 128, DM, qb * 256, 4 * (qb + 1), 0.07216878364870322f, (LAS char*)lds);
                } else { const int i2 = q * 32 + (li - 96), qb = i2 & 31, mh = (i2 >> 5) & 3, b = i2 >> 7; const size_t r0 = (size_t)b * SEQ;
                    att::attn_block<128, false>(proj0 + (r0 + qb * 256) * 2048 + 1344 + mh * 128, 2048, memK + (size_t)b * MEML * 512 + mh * 128, 512, memV + (size_t)b * MEML * 512 + mh * 128, 512,
                                                mixed0 + (r0 + qb * 256) * DM + LRU_W + mh * 128, DM, 0, 4, 0.08838834764831845f, (LAS char*)lds); }
            } }
    }
    SEAM(5);
    PH(6) { PHASE_BEGIN;
        pg8::Gemm g{mixed0, Wout_t, T, DM, DM, DM, DM, 0}; pg8::StaticOrder S; S.init(T, DM, G, bx);
        pg8::EpiRes E{P->x, nullptr, nullptr, xb, ss1, DM}; pg8::gemm_phase<pg8::EpiRes, true>(lds, g, S, E);
    }
    SEAM(6);
    PH(8) { PHASE_BEGIN; if (rep_) grid.sync();
        pg8::Gemm g{xb, Wmi0_t, T, DFF, DM, DM, DM, 0}; pg8::StaticOrder S; S.init(T, DFF, G, bx);
        pg8::EpiBf16<1> E{ub, ub, ub, DFF, DFF, DFF, 1 << 20, 1 << 20, ss1}; pg8::gemm_phase<pg8::EpiBf16<1>, true>(lds, g, S, E);
    }
    SEAM(8);
    PH(9) { PHASE_BEGIN;
        pg8::Gemm g{ub, Wmo0_t, T, DM, DFF, DFF, DFF, 0}; pg8::StaticOrder S; S.init(T, DM, G, bx);
        pg8::EpiRes E{nullptr, xb, nullptr, xb, ss2, DM}; pg8::gemm_phase<pg8::EpiRes, true>(lds, g, S, E);
    }
    SEAM(9);
    PH(11) { PHASE_BEGIN;
        pg8::Gemm g{xb, Wlru_t, T, LRU_IN, DM, DM, DM, 0}; pg8::StaticOrder S; S.init(T, LRU_IN, G, bx);
        pg8::EpiBf16<2> E{gateb, xinb, mqb, LRU_W, LRU_W, 512, 6, 12, ss2}; pg8::gemm_phase<pg8::EpiBf16<2>, true>(lds, g, S, E);
    }
    SEAM(11);
    PH(12) { PHASE_BEGIN;
        { LAS float* scr = (LAS float*)(lds + wave * TR_SCR_BYTES); constexpr int NIT1 = 2 * (2048 / 64) * (8192 / 64);
#define P12_SELECT(it_, t) do { int r = (it_); if (tr_job(r, P->w_mlp_in + (size_t)2048 * 8192, 2048, 8192, Wmi1_t, P->mlp_norm + DM, t)) {} \
              else tr_job(r, P->w_mlp_out + (size_t)2048 * 8192, 8192, 2048, Wmo1_t, nullptr, t); } while (0)
          int it = gw; TrSel cur, nx; f32x4 v[16], nv[16]; float gg[16], ng[16];
          if (it < NIT1) { P12_SELECT(it, cur); tr_load(cur, lane, v, gg); }
          while (it < NIT1) { const int nit = it + NGW;
              if (nit < NIT1) { P12_SELECT(nit, nx); tr_load(nx, lane, nv, ng); }
              asm volatile("" ::: "memory");
              tr_store(cur, v, gg, scr, lane);
              asm volatile("" ::: "memory");
              cur = nx; it = nit;
#pragma unroll
              for (int i = 0; i < 16; ++i) { v[i] = nv[i]; gg[i] = ng[i]; } } }
#undef P12_SELECT
        for (int item = gw; item < (T / 32) * 3; item += NGW) { const int third = item % 3, m0 = (item / 3) * 32; const int c0 = third * 512 + lane * 8;
            float wt[4][8], bs[8];
#pragma unroll
            for (int k = 0; k < 4; ++k) { const f32x4 w0 = *(const f32x4*)(P->conv_w + k * LRU_W + c0), w1 = *(const f32x4*)(P->conv_w + k * LRU_W + c0 + 4);
                wt[k][0] = w0.x; wt[k][1] = w0.y; wt[k][2] = w0.z; wt[k][3] = w0.w; wt[k][4] = w1.x; wt[k][5] = w1.y; wt[k][6] = w1.z; wt[k][7] = w1.w; }
            { const f32x4 b0 = *(const f32x4*)(P->conv_b + c0), b1 = *(const f32x4*)(P->conv_b + c0 + 4); bs[0] = b0.x; bs[1] = b0.y; bs[2] = b0.z; bs[3] = b0.w; bs[4] = b1.x; bs[5] = b1.y; bs[6] = b1.z; bs[7] = b1.w; }
            const bf16_t* xp = xinb + c0; u32x4 win[3], cur[4], nxt[4];
#pragma unroll
            for (int k = 0; k < 3; ++k) { const int mm = m0 - 3 + k; win[k] = *(const u32x4*)(xp + (size_t)(mm < 0 ? 0 : mm) * LRU_W); }
#pragma unroll
            for (int k = 0; k < 4; ++k) cur[k] = *(const u32x4*)(xp + (size_t)(m0 + k) * LRU_W);
#pragma unroll 1
            for (int g = 0; g < 8; ++g) { const int mg = m0 + 4 * g;
                if (g < 7) {
#pragma unroll
                    for (int k = 0; k < 4; ++k) nxt[k] = *(const u32x4*)(xp + (size_t)(mg + 4 + k) * LRU_W); }
                asm volatile("" ::: "memory");
                u32x4 outv[4];
#pragma unroll
                for (int r = 0; r < 4; ++r) { const int sidx = (mg + r) & (SEQ - 1); float acc[8];
#pragma unroll
                    for (int e = 0; e < 8; ++e) acc[e] = bs[e];
#pragma unroll
                    for (int k = 0; k < 4; ++k) { const int wi = r + k; const u32x4 xv = wi < 3 ? win[wi] : cur[wi - 3];
                        if (sidx - 3 + k >= 0) { acc[0] += wt[k][0] * bflo(xv.x); acc[1] += wt[k][1] * bfhi(xv.x); acc[2] += wt[k][2] * bflo(xv.y); acc[3] += wt[k][3] * bfhi(xv.y);
                                                 acc[4] += wt[k][4] * bflo(xv.z); acc[5] += wt[k][5] * bfhi(xv.z); acc[6] += wt[k][6] * bflo(xv.w); acc[7] += wt[k][7] * bfhi(xv.w); } }
                    outv[r].x = cvt_pk_bf16(acc[0], acc[1]); outv[r].y = cvt_pk_bf16(acc[2], acc[3]); outv[r].z = cvt_pk_bf16(acc[4], acc[5]); outv[r].w = cvt_pk_bf16(acc[6], acc[7]); }
#pragma unroll
                for (int r = 0; r < 4; ++r) *(u32x4*)(xcb + (size_t)(mg + r) * LRU_W + c0) = outv[r];
                asm volatile("" ::: "memory");
                win[0] = cur[1]; win[1] = cur[2]; win[2] = cur[3];
#pragma unroll
                for (int k = 0; k < 4; ++k) cur[k] = nxt[k]; } }
        { const f32x4 gm_ = *(const f32x4*)(P->mem_q_norm + 128 + (lane & 31) * 4); u32x2 w0, w1, n0, n1; int m = gw;
          if (m < T) { const u32x2* r_ = (const u32x2*)(mqb + (size_t)m * 512); w0 = r_[lane]; w1 = r_[lane + 64]; }
          for (; m < T; m += NGW) {
              if (m + NGW < T) { const u32x2* r_ = (const u32x2*)(mqb + (size_t)(m + NGW) * 512); n0 = r_[lane]; n1 = r_[lane + 64]; }
              asm volatile("" ::: "memory");
              float s0, s1; { const float a = bflo(w0.x), b = bfhi(w0.x), c = bflo(w0.y), d = bfhi(w0.y); s0 = (a * a + b * b) + (c * c + d * d); }
              { const float a = bflo(w1.x), b = bfhi(w1.x), c = bflo(w1.y), d = bfhi(w1.y); s1 = (a * a + b * b) + (c * c + d * d); }
              const float r0 = rsqrtf(half_sum(s0) * (1.f / 128.f) + EPS), r1 = rsqrtf(half_sum(s1) * (1.f / 128.f) + EPS);
              u32x2* r_ = (u32x2*)(mqb + (size_t)m * 512); u32x2 o;
              o.x = cvt_pk_bf16(bflo(w0.x) * r0 * gm_.x, bfhi(w0.x) * r0 * gm_.y); o.y = cvt_pk_bf16(bflo(w0.y) * r0 * gm_.z, bfhi(w0.y) * r0 * gm_.w); r_[lane] = o;
              o.x = cvt_pk_bf16(bflo(w1.x) * r1 * gm_.x, bfhi(w1.x) * r1 * gm_.y); o.y = cvt_pk_bf16(bflo(w1.y) * r1 * gm_.z, bfhi(w1.y) * r1 * gm_.w); r_[lane + 64] = o;
              asm volatile("" ::: "memory");
              w0 = n0; w1 = n1; } }
    }
    SEAM(12);
    PH(13) { PHASE_BEGIN;
        pg8::Gemm g{xcb, Wg_t, T, 12 * 256, 128, LRU_W, 128, 256}; pg8::StaticOrder S; S.init(T, 12 * 256, G, bx);
        pg8::EpiGates E{P->b_gate_a, P->b_gate_i, clam, ascan, bscan, (LAS float*)(lds + LDS_MISC + 256)}; pg8::gemm_phase<pg8::EpiGates, true>(lds, g, S, E);
    }
    SEAM(13);
    PH(14) { PHASE_BEGIN;
        for (int it = bx; it < NB * NCHUNK; it += G) { const int ch = it % NCHUNK, b = it / NCHUNK;
            if (tid < LRU_W / 4) { const int c = tid * 4; const size_t base = ((size_t)b * SEQ + (size_t)ch * CHL) * LRU_W + c; float h[4] = {0.f, 0.f, 0.f, 0.f}, Pp[4] = {1.f, 1.f, 1.f, 1.f};
#pragma unroll 8
                for (int s = 0; s < CHL; ++s) { const u32x2 aw = *(const u32x2*)(ascan + base + (size_t)s * LRU_W), bw = *(const u32x2*)(bscan + base + (size_t)s * LRU_W), xw = *(const u32x2*)(xcb + base + (size_t)s * LRU_W);
                    const float av[4] = {1.f - bflo(aw.x), 1.f - bfhi(aw.x), 1.f - bflo(aw.y), 1.f - bfhi(aw.y)}, bv[4] = {bflo(bw.x) * bflo(xw.x), bfhi(bw.x) * bfhi(xw.x), bflo(bw.y) * bflo(xw.y), bfhi(bw.y) * bfhi(xw.y)};
#pragma unroll
                    for (int j = 0; j < 4; ++j) { h[j] = av[j] * h[j] + bv[j]; Pp[j] *= av[j]; } }
                *(f32x4*)(carryP + ((size_t)b * NCHUNK + ch) * LRU_W + c) = (f32x4){Pp[0], Pp[1], Pp[2], Pp[3]}; *(f32x4*)(carryH + ((size_t)b * NCHUNK + ch) * LRU_W + c) = (f32x4){h[0], h[1], h[2], h[3]}; } }
        for (int i2 = bx; i2 < NB * 4 * 32; i2 += G) { const int qb = i2 & 31, mh = (i2 >> 5) & 3, b = i2 >> 7; const size_t r0 = (size_t)b * SEQ;
            att::attn_block<128, false>(mqb + (r0 + qb * 256) * 512 + mh * 128, 512, memK + (size_t)b * MEML * 512 + mh * 128, 512, memV + (size_t)b * MEML * 512 + mh * 128, 512,
                                        mixed1 + (r0 + qb * 256) * DM + LRU_W + mh * 128, DM, 0, 4, 0.08838834764831845f, (LAS char*)lds); }
    }
    SEAM(14);
    PH(15) { PHASE_BEGIN;
        for (int it = bx; it < NB * NCHUNK; it += G) { const int ch = it % NCHUNK, b = it / NCHUNK;
            if (tid < LRU_W / 4) { const int c = tid * 4; float h[4] = {0.f, 0.f, 0.f, 0.f};
#pragma unroll 4
                for (int j = 0; j < ch; ++j) { const size_t ci = ((size_t)b * NCHUNK + j) * LRU_W + c; const f32x4 cp = *(const f32x4*)(carryP + ci), chh = *(const f32x4*)(carryH + ci);
                    h[0] = cp.x * h[0] + chh.x; h[1] = cp.y * h[1] + chh.y; h[2] = cp.z * h[2] + chh.z; h[3] = cp.w * h[3] + chh.w; }
                const size_t row0 = (size_t)b * SEQ + (size_t)ch * CHL;
                u32x2 ca[8], cb[8], cg_[8], cx[8], na[8], nb[8], ng[8], nx_[8];
#pragma unroll
                for (int j = 0; j < 8; ++j) { const size_t off = (row0 + j) * LRU_W + c; ca[j] = *(const u32x2*)(ascan + off); cb[j] = *(const u32x2*)(bscan + off); cg_[j] = *(const u32x2*)(gateb + off); cx[j] = *(const u32x2*)(xcb + off); }
#pragma unroll 1
                for (int s0 = 0; s0 < CHL; s0 += 8) {
                    if (s0 + 8 < CHL) {
#pragma unroll
                        for (int j = 0; j < 8; ++j) { const size_t off = (row0 + s0 + 8 + j) * LRU_W + c; na[j] = *(const u32x2*)(ascan + off); nb[j] = *(const u32x2*)(bscan + off); ng[j] = *(const u32x2*)(gateb + off); nx_[j] = *(const u32x2*)(xcb + off); } }
                    asm volatile("" ::: "memory");
                    u32x2 y[8];
#pragma unroll
                    for (int j = 0; j < 8; ++j) { h[0] = (1.f - bflo(ca[j].x)) * h[0] + bflo(cb[j].x) * bflo(cx[j].x); h[1] = (1.f - bfhi(ca[j].x)) * h[1] + bfhi(cb[j].x) * bfhi(cx[j].x);
                        h[2] = (1.f - bflo(ca[j].y)) * h[2] + bflo(cb[j].y) * bflo(cx[j].y); h[3] = (1.f - bfhi(ca[j].y)) * h[3] + bfhi(cb[j].y) * bfhi(cx[j].y);
                        y[j].x = cvt_pk_bf16(h[0] * bflo(cg_[j].x), h[1] * bfhi(cg_[j].x)); y[j].y = cvt_pk_bf16(h[2] * bflo(cg_[j].y), h[3] * bfhi(cg_[j].y)); }
#pragma unroll
                    for (int j = 0; j < 8; ++j) *(u32x2*)(mixed1 + (row0 + s0 + j) * DM + c) = y[j];
                    asm volatile("" ::: "memory");
#pragma unroll
                    for (int j = 0; j < 8; ++j) { ca[j] = na[j]; cb[j] = nb[j]; cg_[j] = ng[j]; cx[j] = nx_[j]; }
                } } }
    }
    SEAM(15);
    PH(16) { PHASE_BEGIN;
        pg8::Gemm g{mixed1, Wout_t + (size_t)DM * DM, T, DM, DM, DM, DM, 0}; pg8::StaticOrder S; S.init(T, DM, G, bx);
        pg8::EpiRes E{nullptr, xb, nullptr, xb, ss3, DM}; pg8::gemm_phase<pg8::EpiRes, true>(lds, g, S, E);
    }
    SEAM(16);
    PH(18) { PHASE_BEGIN;
        pg8::Gemm g{xb, Wmi1_t, T, DFF, DM, DM, DM, 0}; pg8::StaticOrder S; S.init(T, DFF, G, bx);
        pg8::EpiBf16<1> E{ub, ub, ub, DFF, DFF, DFF, 1 << 20, 1 << 20, ss3}; pg8::gemm_phase<pg8::EpiBf16<1>, true>(lds, g, S, E);
    }
    SEAM(18);
    PH(19) { PHASE_BEGIN;
        pg8::Gemm g{ub, Wmo1_t, T, DM, DFF, DFF, DFF, 0}; pg8::StaticOrder S; S.init(T, DM, G, bx);
        pg8::EpiRes E{nullptr, xb, P->out, nullptr, nullptr, DM}; pg8::gemm_phase<pg8::EpiRes, true>(lds, g, S, E);
    }
#undef PH
#undef SEAM
}

#ifndef ONE_LAUNCH
#define ONE_LAUNCH 1
#endif
extern "C" void kernel_launch(void* const* d_in, const int* in_sizes, int n_in, void* d_out, int out_size, void* d_ws, size_t ws_size, hipStream_t stream) {
    static int grid = 0;
    if (grid == 0) {
        if (n_in != 27 || ws_size < WS_END) { fprintf(stderr, "kernel_launch: unexpected n_in %d / ws_size %zu\n", n_in, ws_size); grid = -1; return; }
        int dev = 0, cus = 0, per_cu = 0;
        hipGetDevice(&dev); hipDeviceGetAttribute(&cus, hipDeviceAttributeMultiprocessorCount, dev);
        hipFuncSetAttribute((const void*)fwd_kernel, hipFuncAttributeMaxDynamicSharedMemorySize, LDS_TOTAL);
        hipOccupancyMaxActiveBlocksPerMultiprocessor(&per_cu, (const void*)fwd_kernel, 512, LDS_TOTAL);
        if (per_cu < 1) { fprintf(stderr, "kernel_launch: occupancy query says %d blocks per CU\n", per_cu); per_cu = 1; }
        (void)hipGetLastError();
        grid = cus;
    }
    if (grid < 0) return;
    Params p{};
    p.x = (const float*)d_in[0]; p.mem = (const float*)d_in[1]; p.pos = (const int*)d_in[2];
    p.mix_norm = (const float*)d_in[3]; p.mlp_norm = (const float*)d_in[4]; p.w_out = (const float*)d_in[5]; p.w_mlp_in = (const float*)d_in[6]; p.w_mlp_out = (const float*)d_in[7];
    p.mem_norm = (const float*)d_in[8]; p.w_mem_kv = (const float*)d_in[9]; p.mem_k_norm = (const float*)d_in[10]; p.mem_q_norm = (const float*)d_in[11]; p.w_in_mla = (const float*)d_in[12];
    p.q_lat_norm = (const float*)d_in[13]; p.w_q_up = (const float*)d_in[14]; p.kv_lat_norm = (const float*)d_in[15]; p.w_kv_up = (const float*)d_in[16]; p.q_norm = (const float*)d_in[17];
    p.k_norm = (const float*)d_in[18]; p.w_in_lru = (const float*)d_in[19]; p.conv_w = (const float*)d_in[20]; p.conv_b = (const float*)d_in[21]; p.w_gate_a = (const float*)d_in[22];
    p.b_gate_a = (const float*)d_in[23]; p.w_gate_i = (const float*)d_in[24]; p.b_gate_i = (const float*)d_in[25]; p.lru_lambda = (const float*)d_in[26];
    p.out = (float*)d_out; p.ws = (unsigned char*)d_ws;
#if ONE_LAUNCH
    (void)hipMemsetAsync((char*)d_ws + WS_CTL + 16384, 0, 16384, stream);
    p.ph_lo = 0; p.ph_hi = NPHASE;
    void* args[] = {&p};
    hipError_t e = hipLaunchCooperativeKernel((const void*)fwd_kernel, dim3(grid), dim3(512), args, LDS_TOTAL, stream);
    if (e != hipSuccess) fprintf(stderr, "cooperative launch failed: %s (grid %d)\n", hipGetErrorString(e), grid);
#else
    for (int k = 0; k < NPHASE; ++k) { p.ph_lo = k; p.ph_hi = k + 1; hipLaunchKernelGGL(fwd_kernel, dim3(grid), dim3(512), LDS_TOTAL, stream, p); }
#endif
}
```
